# Optimizing an MI355X kernel written in HIP

```python
import math
import numpy as np
import jax
import jax.numpy as jnp
from jax import lax

D_MODEL = 2048
BATCH = 32
SEQ = 256
DEPTH = 2
DEC_BATCH = 2
DEC_SEQ = 4096
PAST_LEN = 256

GRID_W = 64
D_MIX = D_MODEL // 2
N_MOD = 6
S5_CH = 16
S5_G = D_MIX // S5_CH
S5_P = 64
RET_H = 8
RET_DK = D_MIX // RET_H
RET_DV = D_MIX // RET_H
RET_CHUNK = 128
MLA_DN = 128
MLA_DR = 64
MLA_DV = 128
MLA_H = D_MIX // MLA_DV
MLA_Q_LORA = 768
MLA_KV_LORA = 512
ROPE_BASE = 10000.0
Q_BLOCK = 128
D_FF = 11 * D_MODEL // 4
NORM_EPS = 1e-6
IN_WIDTHS = (D_MIX, D_MIX, D_MIX, D_MIX, D_MIX, MLA_Q_LORA, MLA_KV_LORA, MLA_DR, D_MODEL, D_MODEL, D_MODEL)

kernel_name = 'hybrid_prefix_s5_retention_mla_trunk_step'


def rmsnorm(x, g):
    xf = x.astype(jnp.float32)
    y = xf * lax.rsqrt(jnp.mean(xf * xf, axis=-1, keepdims=True) + NORM_EPS)
    return (y * g.astype(jnp.float32)).astype(x.dtype)


def adaln(cvec, w_ada, b_ada):
    m = jax.nn.silu(cvec) @ w_ada + b_ada
    return jnp.split(m, N_MOD, axis=-1)


def s5_discretise(lam_re, lam_im, log_dt):
    f32 = jnp.float32
    dt = jnp.exp(log_dt.astype(f32))[:, None]
    lr, li = lam_re.astype(f32), lam_im.astype(f32)
    ar, ai = lr * dt, li * dt
    mag = jnp.exp(ar)
    abar_re, abar_im = mag * jnp.cos(ai), mag * jnp.sin(ai)
    nr, ni = abar_re - 1.0, abar_im
    den = lr * lr + li * li
    coef_re = (nr * lr + ni * li) / den
    coef_im = (ni * lr - nr * li) / den
    return ar, ai, abar_re, abar_im, coef_re, coef_im


def s5_scan(abar_re, abar_im, b_re, b_im, reverse):
    a_re = jnp.broadcast_to(abar_re, b_re.shape)
    a_im = jnp.broadcast_to(abar_im, b_re.shape)

    def combine(e1, e2):
        a1r, a1i, b1r, b1i = e1
        a2r, a2i, b2r, b2i = e2
        return (a2r * a1r - a2i * a1i,
                a2r * a1i + a2i * a1r,
                a2r * b1r - a2i * b1i + b2r,
                a2r * b1i + a2i * b1r + b2i)

    _, _, s_re, s_im = lax.associative_scan(combine, (a_re, a_im, b_re, b_im), reverse=reverse, axis=1)
    return s_re, s_im


def s5_branch(u, lp, ctx_state):
    f32 = jnp.float32
    B_, L, _ = u.shape
    uf = u.astype(f32)
    ug = uf.reshape(B_, L, S5_G, S5_CH)
    bu_re = jnp.einsum('blgc,gpc->blgp', ug, lp['s5_b_re'].astype(f32))
    bu_im = jnp.einsum('blgc,gpc->blgp', ug, lp['s5_b_im'].astype(f32))
    tot_re, tot_im, finals = None, None, []
    for d in range(2):
        ar, ai, abr, abi, cr, ci = s5_discretise(lp['s5_lam_re'][d], lp['s5_lam_im'][d], lp['s5_log_dt'][d])
        b_re = cr * bu_re - ci * bu_im
        b_im = cr * bu_im + ci * bu_re
        s_re, s_im = s5_scan(abr, abi, b_re, b_im, reverse=(d == 1))
        if ctx_state is None:
            edge = -1 if d == 0 else 0
            finals.append(jnp.stack([s_re[:, edge], s_im[:, edge]], axis=-1))
        else:
            s0 = ctx_state[d].astype(f32)
            kk = (jnp.arange(1, L + 1) if d == 0 else jnp.arange(L, 0, -1)).astype(f32)[:, None, None]
            mag = jnp.exp(kk * ar)
            p_re, p_im = mag * jnp.cos(kk * ai), mag * jnp.sin(kk * ai)
            s0r, s0i = s0[..., 0][:, None], s0[..., 1][:, None]
            s_re = s_re + p_re * s0r - p_im * s0i
            s_im = s_im + p_re * s0i + p_im * s0r
        tot_re = s_re if tot_re is None else tot_re + s_re
        tot_im = s_im if tot_im is None else tot_im + s_im
    y = (jnp.einsum('blgp,gcp->blgc', tot_re, lp['s5_c_re'].astype(f32))
         - jnp.einsum('blgp,gcp->blgc', tot_im, lp['s5_c_im'].astype(f32)))
    y = y.reshape(B_, L, D_MIX) + lp['s5_d'].astype(f32) * uf
    y = jax.nn.gelu(y)
    y = y * jax.nn.sigmoid(y @ lp['s5_glu_w'].astype(f32) + lp['s5_glu_b'].astype(f32))
    return y.astype(u.dtype), finals


def retention_scan(q, k, v, log_gamma, s0):
    f32 = jnp.float32
    B_, L, H, _ = q.shape
    DV = v.shape[-1]
    nc = L // RET_CHUNK

    def chunks(t):
        return t.reshape(B_, nc, RET_CHUNK, H, t.shape[-1]).transpose(1, 0, 3, 2, 4)

    idx = jnp.arange(RET_CHUNK, dtype=f32)
    lg = log_gamma[:, None]
    diff = idx[:, None] - idx[None, :]
    decay_in = jnp.where(diff >= 0, jnp.exp(lg[:, :, None] * jnp.maximum(diff, 0.0)), 0.0)
    decay_q = jnp.exp(lg * (idx + 1.0))[..., None]
    decay_k = jnp.exp(lg * (RET_CHUNK - 1.0 - idx))[..., None]
    decay_s = jnp.exp(lg * RET_CHUNK)[..., None]

    def step(S, blk):
        qc, kc, vc = blk
        att = jnp.einsum('bhid,bhjd->bhij', qc, kc) * decay_in
        o = jnp.einsum('bhij,bhje->bhie', att, vc) + jnp.einsum('bhid,bhde->bhie', qc * decay_q, S)
        S = decay_s * S + jnp.einsum('bhjd,bhje->bhde', kc * decay_k, vc)
        return S, o

    S, o = lax.scan(step, s0, (chunks(q), chunks(k), chunks(v)))
    o = o.transpose(1, 0, 3, 2, 4).reshape(B_, L, H, DV)
    return o, S


def retention_branch(q, k, v, g, lp, ctx_state):
    f32 = jnp.float32
    B_, L, _ = q.shape
    qf = q.astype(f32).reshape(B_, L, RET_H, RET_DK)
    kf = k.astype(f32).reshape(B_, L, RET_H, RET_DK) * (RET_DK ** -0.5)
    vf = v.astype(f32).reshape(B_, L, RET_H, RET_DV)
    o_tot, finals = None, []
    for d in range(2):
        log_gamma = -jnp.exp(lp['ret_decay'][d].astype(f32))
        if ctx_state is None:
            s0 = jnp.zeros((B_, RET_H, RET_DK, RET_DV), f32)
        else:
            s0 = ctx_state[d].astype(f32)
        if d == 0:
            o, S = retention_scan(qf, kf, vf, log_gamma, s0)
        else:
            o, S = retention_scan(qf[:, ::-1], kf[:, ::-1], vf[:, ::-1], log_gamma, s0)
            o = o[:, ::-1]
        if ctx_state is None:
            finals.append(S)
        o_tot = o if o_tot is None else o_tot + o
    mu = jnp.mean(o_tot, axis=-1, keepdims=True)
    var = jnp.mean(jnp.square(o_tot - mu), axis=-1, keepdims=True)
    on = ((o_tot - mu) * lax.rsqrt(var + NORM_EPS)).reshape(B_, L, D_MIX)
    y = jax.nn.silu(g.astype(f32)) * (on * lp['ret_norm_g'].astype(f32))
    return y.astype(g.dtype), finals


def axial_rope_tables(n_tokens):
    f32 = jnp.float32
    rows = n_tokens // GRID_W
    row = jnp.broadcast_to(jnp.arange(rows, dtype=f32)[:, None], (rows, GRID_W)).reshape(-1)
    col = jnp.broadcast_to(jnp.arange(GRID_W, dtype=f32)[None, :], (rows, GRID_W)).reshape(-1)
    nf = MLA_DR // 4
    inv = ROPE_BASE ** (-jnp.arange(nf, dtype=f32) / nf)
    ang = jnp.concatenate([row[:, None] * inv, col[:, None] * inv], axis=-1)
    return jnp.cos(ang), jnp.sin(ang)


def apply_rope(x, cos, sin):
    xf = x.astype(jnp.float32)
    xp = xf.reshape(xf.shape[:-1] + (MLA_DR // 2, 2))
    x1, x2 = xp[..., 0], xp[..., 1]
    out = jnp.stack([x1 * cos - x2 * sin, x1 * sin + x2 * cos], axis=-1)
    return out.reshape(x.shape).astype(x.dtype)


def block_attention(q_nope, q_rope, k_nope, k_rope, v):
    B_, L, H, _ = q_nope.shape
    nb = L // Q_BLOCK
    scale = (MLA_DN + MLA_DR) ** -0.5

    def blk(qs):
        qn, qr = qs
        s = jnp.einsum('bqhd,bkhd->bhqk', qn, k_nope) + jnp.einsum('bqhd,bkd->bhqk', qr, k_rope)
        p = jax.nn.softmax(s.astype(jnp.float32) * scale, axis=-1).astype(v.dtype)
        return jnp.einsum('bhqk,bkhd->bqhd', p, v)

    qn_b = q_nope.reshape(B_, nb, Q_BLOCK, H, MLA_DN).transpose(1, 0, 2, 3, 4)
    qr_b = q_rope.reshape(B_, nb, Q_BLOCK, H, MLA_DR).transpose(1, 0, 2, 3, 4)
    o = lax.map(blk, (qn_b, qr_b))
    return o.transpose(1, 0, 2, 3, 4).reshape(B_, L, H, MLA_DV)


def mla_branch(c_q, c_kv, k_rope, lp, ctx_cache):
    B_, L, _ = c_q.shape
    q = (rmsnorm(c_q, lp['mla_q_norm']) @ lp['mla_w_uq']).reshape(B_, L, MLA_H, MLA_DN + MLA_DR)
    q_nope, q_rope = q[..., :MLA_DN], q[..., MLA_DN:]
    ckv = rmsnorm(c_kv, lp['mla_kv_norm'])
    if ctx_cache is None:
        key_ckv, key_rope = ckv, k_rope
        new_cache = (ckv, k_rope)
    else:
        cos, sin = axial_rope_tables(L)
        q_rope = apply_rope(q_rope, cos[:, None], sin[:, None])
        key_ckv = jnp.concatenate([ckv, ctx_cache[0].astype(ckv.dtype)], axis=1)
        key_rope = jnp.concatenate([apply_rope(k_rope, cos, sin), ctx_cache[1].astype(k_rope.dtype)], axis=1)
        new_cache = None
    S_ = key_ckv.shape[1]
    k_nope = (key_ckv @ lp['mla_w_uk']).reshape(B_, S_, MLA_H, MLA_DN)
    v = (key_ckv @ lp['mla_w_uv']).reshape(B_, S_, MLA_H, MLA_DV)
    o = block_attention(q_nope, q_rope, k_nope, key_rope, v)
    return o.reshape(B_, L, D_MIX), new_cache


def token_mixer(h, lp, ctx):
    z = h @ lp['w_in']
    splits = np.cumsum(IN_WIDTHS)[:-1].tolist()
    u, q, k, v, g, c_q, c_kv, k_rope, gate_a, gate_b, gate_c = jnp.split(z, splits, axis=-1)
    ya, s5_st = s5_branch(u, lp, None if ctx is None else ctx['s5'])
    yb, ret_st = retention_branch(q, k, v, g, lp, None if ctx is None else ctx['ret'])
    yc, mla_st = mla_branch(c_q, c_kv, k_rope, lp, None if ctx is None else ctx['mla'])
    wb = lp['w_branch']
    merged = (jax.nn.sigmoid(gate_a) * (ya @ wb[0])
              + jax.nn.sigmoid(gate_b) * (yb @ wb[1])
              + jax.nn.sigmoid(gate_c) * (yc @ wb[2]))
    return merged @ lp['w_out'], (s5_st, ret_st, mla_st)


def conv_ffn(h, lp):
    u = h @ lp['ffn_w_up']
    w = lp['ffn_conv_w']
    up = jnp.pad(u, ((0, 0), (1, 1), (0, 0)))
    u = up[:, :-2] * w[0] + up[:, 1:-1] * w[1] + up[:, 2:] * w[2] + lp['ffn_conv_b']
    val, gate = jnp.split(u, 2, axis=-1)
    return (jax.nn.silu(gate) * val) @ lp['ffn_w_down']


def trunk_layer(x, mods, lp, ctx):
    sh1, sc1, g1, sh2, sc2, g2 = mods
    ng = lp['norm_g']
    h = rmsnorm(x, ng[0]) * (1.0 + sc1) + sh1
    mo, st = token_mixer(h, lp, ctx)
    x = x + g1 * rmsnorm(mo, ng[1])
    h = rmsnorm(x, ng[2]) * (1.0 + sc2) + sh2
    x = x + g2 * rmsnorm(conv_ffn(h, lp), ng[3])
    return x, st


def setup_inputs(seed: int = 0) -> dict:
    f32 = jnp.float32
    key = jax.random.key(seed)
    keys = jax.random.split(key, 48)

    def nrm(i, shape, scale):
        return scale * jax.random.normal(keys[i], shape, f32)

    x_prompt = nrm(0, (BATCH, SEQ, D_MODEL), 1.0)
    x_sample = nrm(1, (DEC_BATCH, DEC_SEQ, D_MODEL), 1.0)
    cache_mla_ckv = nrm(2, (DEC_BATCH, DEPTH, PAST_LEN, MLA_KV_LORA), 1.0)
    cache_mla_krope = nrm(3, (DEC_BATCH, DEPTH, PAST_LEN, MLA_DR), 1.0)
    state_ret_fwd = nrm(4, (DEC_BATCH, DEPTH, RET_H, RET_DK, RET_DV), 0.5)
    state_ret_bwd = nrm(5, (DEC_BATCH, DEPTH, RET_H, RET_DK, RET_DV), 0.5)
    state_s5_fwd = nrm(6, (DEC_BATCH, DEPTH, S5_G, S5_P, 2), 0.3)
    state_s5_bwd = nrm(7, (DEC_BATCH, DEPTH, S5_G, S5_P, 2), 0.3)
    c = nrm(8, (DEC_BATCH, D_MODEL), 1.0)
    c_ctx = nrm(9, (D_MODEL,), 1.0)
    ada_w = nrm(10, (DEPTH, D_MODEL, N_MOD * D_MODEL), 0.5 * D_MODEL ** -0.5)
    ada_b = nrm(11, (DEPTH, N_MOD * D_MODEL), 0.01)
    norm_g = 1.0 + nrm(12, (DEPTH, 4, D_MODEL), 0.01)
    w_in = nrm(13, (DEPTH, D_MODEL, sum(IN_WIDTHS)), D_MODEL ** -0.5)
    s5_lam_re = -0.5 + nrm(14, (DEPTH, 2, S5_G, S5_P), 0.01)
    s5_lam_im = math.pi * jnp.arange(S5_P, dtype=f32) + nrm(15, (DEPTH, 2, S5_G, S5_P), 0.01)
    s5_log_dt = jax.random.uniform(keys[16], (DEPTH, 2, S5_G), f32, math.log(0.001), math.log(0.1))
    s5_b_re = nrm(17, (DEPTH, S5_G, S5_P, S5_CH), (2 * S5_CH) ** -0.5)
    s5_b_im = nrm(18, (DEPTH, S5_G, S5_P, S5_CH), (2 * S5_CH) ** -0.5)
    s5_c_re = nrm(19, (DEPTH, S5_G, S5_CH, S5_P), (2 * S5_P) ** -0.5)
    s5_c_im = nrm(20, (DEPTH, S5_G, S5_CH, S5_P), (2 * S5_P) ** -0.5)
    s5_d = nrm(21, (DEPTH, D_MIX), 1.0)
    s5_glu_w = nrm(22, (DEPTH, D_MIX, D_MIX), D_MIX ** -0.5)
    s5_glu_b = nrm(23, (DEPTH, D_MIX), 0.01)
    ret_base = jnp.log(-jnp.log1p(-(2.0 ** (-5.0 - jnp.arange(RET_H, dtype=f32)))))
    ret_decay = ret_base + nrm(24, (DEPTH, 2, RET_H), 0.01)
    ret_norm_g = 1.0 + nrm(25, (DEPTH, D_MIX), 0.01)
    mla_q_norm = 1.0 + nrm(26, (DEPTH, MLA_Q_LORA), 0.01)
    mla_kv_norm = 1.0 + nrm(27, (DEPTH, MLA_KV_LORA), 0.01)
    mla_w_uq = nrm(28, (DEPTH, MLA_Q_LORA, MLA_H * (MLA_DN + MLA_DR)), MLA_Q_LORA ** -0.5)
    mla_w_uk = nrm(29, (DEPTH, MLA_KV_LORA, MLA_H * MLA_DN), MLA_KV_LORA ** -0.5)
    mla_w_uv = nrm(30, (DEPTH, MLA_KV_LORA, MLA_H * MLA_DV), MLA_KV_LORA ** -0.5)
    w_branch = nrm(31, (DEPTH, 3, D_MIX, D_MODEL), D_MIX ** -0.5)
    w_out = nrm(32, (DEPTH, D_MODEL, D_MODEL), D_MODEL ** -0.5)
    ffn_w_up = nrm(33, (DEPTH, D_MODEL, 2 * D_FF), D_MODEL ** -0.5)
    ffn_conv_w = nrm(34, (DEPTH, 3, 2 * D_FF), 3 ** -0.5)
    ffn_conv_b = nrm(35, (DEPTH, 2 * D_FF), 0.01)
    ffn_w_down = nrm(36, (DEPTH, D_FF, D_MODEL), D_FF ** -0.5)
    return {'x_prompt': x_prompt, 'x_sample': x_sample,
            'cache_mla_ckv': cache_mla_ckv, 'cache_mla_krope': cache_mla_krope,
            'state_ret_fwd': state_ret_fwd, 'state_ret_bwd': state_ret_bwd,
            'state_s5_fwd': state_s5_fwd, 'state_s5_bwd': state_s5_bwd,
            'c': c, 'c_ctx': c_ctx, 'ada_w': ada_w, 'ada_b': ada_b, 'norm_g': norm_g, 'w_in': w_in,
            's5_lam_re': s5_lam_re, 's5_lam_im': s5_lam_im, 's5_log_dt': s5_log_dt,
            's5_b_re': s5_b_re, 's5_b_im': s5_b_im, 's5_c_re': s5_c_re, 's5_c_im': s5_c_im,
            's5_d': s5_d, 's5_glu_w': s5_glu_w, 's5_glu_b': s5_glu_b,
            'ret_decay': ret_decay, 'ret_norm_g': ret_norm_g,
            'mla_q_norm': mla_q_norm, 'mla_kv_norm': mla_kv_norm,
            'mla_w_uq': mla_w_uq, 'mla_w_uk': mla_w_uk, 'mla_w_uv': mla_w_uv,
            'w_branch': w_branch, 'w_out': w_out,
            'ffn_w_up': ffn_w_up, 'ffn_conv_w': ffn_conv_w, 'ffn_conv_b': ffn_conv_b, 'ffn_w_down': ffn_w_down}


def reference(x_prompt, x_sample, cache_mla_ckv, cache_mla_krope, state_ret_fwd, state_ret_bwd,
              state_s5_fwd, state_s5_bwd, c, c_ctx, ada_w, ada_b, norm_g, w_in,
              s5_lam_re, s5_lam_im, s5_log_dt, s5_b_re, s5_b_im, s5_c_re, s5_c_im,
              s5_d, s5_glu_w, s5_glu_b, ret_decay, ret_norm_g,
              mla_q_norm, mla_kv_norm, mla_w_uq, mla_w_uk, mla_w_uv,
              w_branch, w_out, ffn_w_up, ffn_conv_w, ffn_conv_b, ffn_w_down):
    xp, xs = x_prompt, x_sample
    ckv_out, krope_out, retf_out, retb_out, s5f_out, s5b_out = [], [], [], [], [], []
    for l in range(DEPTH):
        lp = {'norm_g': norm_g[l], 'w_in': w_in[l],
              's5_lam_re': s5_lam_re[l], 's5_lam_im': s5_lam_im[l], 's5_log_dt': s5_log_dt[l],
              's5_b_re': s5_b_re[l], 's5_b_im': s5_b_im[l], 's5_c_re': s5_c_re[l], 's5_c_im': s5_c_im[l],
              's5_d': s5_d[l], 's5_glu_w': s5_glu_w[l], 's5_glu_b': s5_glu_b[l],
              'ret_decay': ret_decay[l], 'ret_norm_g': ret_norm_g[l],
              'mla_q_norm': mla_q_norm[l], 'mla_kv_norm': mla_kv_norm[l],
              'mla_w_uq': mla_w_uq[l], 'mla_w_uk': mla_w_uk[l], 'mla_w_uv': mla_w_uv[l],
              'w_branch': w_branch[l], 'w_out': w_out[l],
              'ffn_w_up': ffn_w_up[l], 'ffn_conv_w': ffn_conv_w[l], 'ffn_conv_b': ffn_conv_b[l],
              'ffn_w_down': ffn_w_down[l]}
        mods_ctx = adaln(c_ctx, ada_w[l], ada_b[l])
        xp, (s5_st, ret_st, mla_st) = trunk_layer(xp, mods_ctx, lp, None)
        s5f_out.append(s5_st[0])
        s5b_out.append(s5_st[1])
        retf_out.append(ret_st[0])
        retb_out.append(ret_st[1])
        ckv_out.append(mla_st[0])
        krope_out.append(mla_st[1])
        mods_lat = [m[:, None, :] for m in adaln(c, ada_w[l], ada_b[l])]
        ctx = {'s5': (state_s5_fwd[:, l], state_s5_bwd[:, l]),
               'ret': (state_ret_fwd[:, l], state_ret_bwd[:, l]),
               'mla': (cache_mla_ckv[:, l], cache_mla_krope[:, l])}
        xs, _ = trunk_layer(xs, mods_lat, lp, ctx)
    new_mla_ckv = jnp.stack(ckv_out, axis=1)
    new_mla_krope = jnp.stack(krope_out, axis=1)
    new_ret_fwd = jnp.stack(retf_out, axis=1)
    new_ret_bwd = jnp.stack(retb_out, axis=1)
    new_s5_fwd = jnp.stack(s5f_out, axis=1)
    new_s5_bwd = jnp.stack(s5b_out, axis=1)
    return (xp, xs, new_mla_ckv, new_mla_krope, new_ret_fwd, new_ret_bwd, new_s5_fwd, new_s5_bwd)
```

```cpp
#include <hip/hip_runtime.h>
#include <cstdio>
#include <cstdint>
namespace pg8 {
#define PG8_LAS __attribute__((address_space(3)))
typedef unsigned short bf16_t;
typedef short bf16x8 __attribute__((ext_vector_type(8)));
typedef float f32x4 __attribute__((ext_vector_type(4)));
typedef unsigned u32x4 __attribute__((ext_vector_type(4)));
typedef unsigned u32x2 __attribute__((ext_vector_type(2)));
constexpr int BM = 256, BK = 64, HALF = 128, HTB = HALF * BK * 2  , STAGE_BYTES = 8 * HTB, NXCD = 8, WGM = 8;

__host__ __device__ __forceinline__ int lds_byte(int r, int c) { const int st = (r >> 4) * 2 + (c >> 5), rr = r & 15, cc = c & 31, ob = rr * 64 + cc * 2; return st * 1024 + (ob ^ (((ob >> 9) & 1) << 5)); }
__host__ __device__ __forceinline__ void stage_rc(int b, int& R, int& C) { const int st = b / 1024, sb = b % 1024, swz = sb ^ (((sb >> 9) & 1) << 5); R = (st >> 1) * 16 + swz / 64; C = (st & 1) * 32 + (swz % 64) / 2; }
__host__ __device__ __forceinline__ int perm32(int rho) { const int n = rho >> 4, i = rho & 15; return 8 * (i >> 2) + 4 * n + (i & 3); }

struct Unit { int pm, pn; };
struct Gemm { const bf16_t* A; const bf16_t* Bt; int lda, ldb, K; };

struct StaticOrder {
    int nM, nN, nwg, G, c;
    __host__ __device__ void init(int M, int N, int G_, int c_) { nM = M / BM; nN = N / BM; nwg = nM * nN; G = G_; c = c_; }
    __host__ __device__ bool next(int i, Unit& u) const {
        const long L = (long)i * G + c; if (L >= nwg) return false;
        int wgid = (int)L; { const int q = nwg / NXCD, r = nwg % NXCD, xcd = wgid % NXCD, off = wgid / NXCD; wgid = (xcd < r ? xcd * (q + 1) : r * (q + 1) + (xcd - r) * q) + off; }
        const int nig = WGM * nN, gid = wgid / nig, fm = gid * WGM, gsz = (nM - fm) < WGM ? (nM - fm) : WGM;
        u.pm = fm + ((wgid % nig) % gsz); u.pn = (wgid % nig) / gsz; return true;
    }
    __device__ __forceinline__ void a_ready(const Unit&) const {}
    __device__ __forceinline__ void done(const Unit&) const {}
};
struct OrderSlice {
    StaticOrder base; int first, count;
    __device__ bool next(int i, Unit& u) const { if (i >= count) return false; return base.next(first + i, u); }
    __device__ __forceinline__ void a_ready(const Unit&) const {}
    __device__ __forceinline__ void done(const Unit&) const {}
};
struct OrderS5E {
    int G, c;
    __device__ bool next(int i, Unit& u) const { const int L = i * G + c; if (L >= 128) return false; u.pm = L; u.pn = L >> 1; return true; }
    __device__ __forceinline__ void a_ready(const Unit&) const {}
    __device__ __forceinline__ void done(const Unit&) const {}
};
struct OrderS5Y {
    int G, c;
    __device__ bool next(int i, Unit& u) const { const int L = i * G + c; if (L >= 256) return false; const int g = L >> 2; u.pm = 2 * g + ((L >> 1) & 1); u.pn = 2 * g + (L & 1); return true; }
    __device__ __forceinline__ void a_ready(const Unit&) const {}
    __device__ __forceinline__ void done(const Unit&) const {}
};
__device__ __forceinline__ unsigned cvt_pk_bf16(float lo, float hi) { unsigned r; asm volatile("v_cvt_pk_bf16_f32 %0, %1, %2" : "=v"(r) : "v"(lo), "v"(hi)); return r; }
__device__ __forceinline__ float bflo(unsigned w) { return __uint_as_float(w << 16); }
__device__ __forceinline__ float bfhi(unsigned w) { return __uint_as_float(w & 0xffff0000u); }
__device__ __forceinline__ float bf2f(bf16_t v) { return __uint_as_float(((unsigned)v) << 16); }
__device__ __forceinline__ bf16_t f2bf(float f) { unsigned u = __float_as_uint(f); u += 0x7fffu + ((u >> 16) & 1u); return (bf16_t)(u >> 16); }
__device__ __forceinline__ float sigm(float x) { return __builtin_amdgcn_rcpf(1.f + __expf(-x)); }
__device__ __forceinline__ float gelu_tanh(float x) { const float z = 1.5957691216f * (x + 0.044715f * x * x * x); return x * __builtin_amdgcn_rcpf(1.f + __expf(-z)); }

#define GAS1 __attribute__((address_space(1)))
__device__ __forceinline__ void gstore16(bf16_t* p, u32x4 w) { *(GAS1 u32x4*)(GAS1 void*)p = w; }
__device__ __forceinline__ u32x4 gload16(const bf16_t* p) { return *(const GAS1 u32x4*)(const GAS1 void*)p; }
__device__ __forceinline__ u32x4 xl(u32x4 w, int src4) { u32x4 r; r.x = (unsigned)__builtin_amdgcn_ds_bpermute(src4, (int)w.x); r.y = (unsigned)__builtin_amdgcn_ds_bpermute(src4, (int)w.y);
    r.z = (unsigned)__builtin_amdgcn_ds_bpermute(src4, (int)w.z); r.w = (unsigned)__builtin_amdgcn_ds_bpermute(src4, (int)w.w); return r; }
struct EpiBf16Plain {
    static constexpr bool PERM = true, AFTER_DRAIN = false, MID = false;
    bf16_t* O; int ldc;
    __device__ __forceinline__ void operator()(const f32x4 (&acc)[2][2][4][2], const Unit& u, int wr, int wc, int fr, int fq) const {
        const int lane = fq * 16 + fr, fr2 = lane >> 2, fq2 = lane & 3, src4 = (fq2 * 16 + fr2) * 4;
        const int row0 = u.pm * BM + wr * 64 + fr2, col0 = u.pn * BM + wc * 32 + 8 * fq2;
#pragma unroll
        for (int ai = 0; ai < 2; ++ai)
#pragma unroll
            for (int m = 0; m < 4; ++m) { bf16_t* rowp = O + (size_t)(row0 + ai * HALF + m * 16) * ldc + col0;
#pragma unroll
                for (int bj = 0; bj < 2; ++bj) { const f32x4 v0 = acc[ai][bj][m][0], v1 = acc[ai][bj][m][1];
                    u32x4 w; w.x = cvt_pk_bf16(v0[0], v0[1]); w.y = cvt_pk_bf16(v0[2], v0[3]); w.z = cvt_pk_bf16(v1[0], v1[1]); w.w = cvt_pk_bf16(v1[2], v1[3]);
                    gstore16(rowp + bj * HALF, xl(w, src4)); } }
    }
};
struct EpiF32Plain {
    static constexpr bool PERM = false, AFTER_DRAIN = false, MID = false;
    float* C; int ldc;
    __device__ __forceinline__ void operator()(const f32x4 (&acc)[2][2][4][2], const Unit& u, int wr, int wc, int fr, int fq) const {
        const int row0 = u.pm * BM + wr * 64 + fr, col0 = u.pn * BM + wc * 32 + 4 * fq;
#pragma unroll
        for (int ai = 0; ai < 2; ++ai)
#pragma unroll
            for (int m = 0; m < 4; ++m) { float* rowp = C + (size_t)(row0 + ai * HALF + m * 16) * ldc + col0;
#pragma unroll
                for (int bj = 0; bj < 2; ++bj)
#pragma unroll
                    for (int n = 0; n < 2; ++n) *(f32x4*)(rowp + bj * HALF + n * 16) = acc[ai][bj][m][n]; }
    }
};
struct EpiP2 {
    static constexpr bool PERM = true, AFTER_DRAIN = false, MID = false;
    bf16_t *UG, *Q, *K, *V, *Gt, *CQ, *CKV, *KR, *GATES;
    __device__ __forceinline__ void operator()(const f32x4 (&acc)[2][2][4][2], const Unit& u, int wr, int wc, int fr, int fq) const {
        const int pn = u.pn, row0 = u.pm * BM + wr * 64 + fr, cl = wc * 32 + 8 * fq;
        if (pn < 4) {
#pragma unroll
            for (int ai = 0; ai < 2; ++ai)
#pragma unroll
                for (int m = 0; m < 4; ++m) { const int r = row0 + ai * HALF + m * 16, chunk = r >> 5, tt = r & 31;
#pragma unroll
                    for (int bj = 0; bj < 2; ++bj) { const int c = pn * 256 + bj * HALF + cl, g = c >> 4, cp = c & 15;
                        const f32x4 v0 = acc[ai][bj][m][0], v1 = acc[ai][bj][m][1];
                        u32x4 w; w.x = cvt_pk_bf16(v0[0], v0[1]); w.y = cvt_pk_bf16(v0[2], v0[3]); w.z = cvt_pk_bf16(v1[0], v1[1]); w.w = cvt_pk_bf16(v1[2], v1[3]);
                        gstore16(UG + ((size_t)(g * 512 + chunk)) * 768 + tt * 16 + cp, w); } }
        } else {
            bf16_t* base; int ldc, colt;
            if (pn < 8) { base = Q; ldc = 1024; colt = (pn - 4) * 256; }
            else if (pn < 12) { base = K; ldc = 1024; colt = (pn - 8) * 256; }
            else if (pn < 16) { base = V; ldc = 1024; colt = (pn - 12) * 256; }
            else if (pn < 20) { base = Gt; ldc = 1024; colt = (pn - 16) * 256; }
            else if (pn < 23) { base = CQ; ldc = 768; colt = (pn - 20) * 256; }
            else if (pn < 25) { base = CKV; ldc = 512; colt = (pn - 23) * 256; }
            else if (pn == 25) { base = KR; ldc = 64; colt = 0; }
            else { base = GATES; ldc = 512; colt = (pn - 26) * 256; }
            const bool narrow = (pn == 25);
#pragma unroll
            for (int ai = 0; ai < 2; ++ai)
#pragma unroll
                for (int m = 0; m < 4; ++m) { bf16_t* rowp = base + (size_t)(row0 + ai * HALF + m * 16) * ldc + colt + cl;
#pragma unroll
                    for (int bj = 0; bj < 2; ++bj) { if (narrow && (bj * HALF + cl) >= 64) continue;
                        const f32x4 v0 = acc[ai][bj][m][0], v1 = acc[ai][bj][m][1];
                        u32x4 w; w.x = cvt_pk_bf16(v0[0], v0[1]); w.y = cvt_pk_bf16(v0[2], v0[3]); w.z = cvt_pk_bf16(v1[0], v1[1]); w.w = cvt_pk_bf16(v1[2], v1[3]);
                        gstore16(rowp + bj * HALF, w); } }
        }
    }
};
struct EpiS5E {
    static constexpr bool PERM = false, AFTER_DRAIN = false, MID = false;
    float* C;
    __device__ __forceinline__ void operator()(const f32x4 (&acc)[2][2][4][2], const Unit& u, int wr, int wc, int fr, int fq) const {
        const int row0 = u.pm * BM + wr * 64 + fr, col0 = wc * 32 + 4 * fq;
#pragma unroll
        for (int ai = 0; ai < 2; ++ai)
#pragma unroll
            for (int m = 0; m < 4; ++m) { float* rowp = C + (size_t)(row0 + ai * HALF + m * 16) * 256 + col0;
#pragma unroll
                for (int bj = 0; bj < 2; ++bj)
#pragma unroll
                    for (int n = 0; n < 2; ++n) *(f32x4*)(rowp + bj * HALF + n * 16) = acc[ai][bj][m][n]; }
    }
};
struct EpiS5Y {
    static constexpr bool PERM = true, AFTER_DRAIN = false, MID = false;
    const bf16_t* UG; const float* Dv; bf16_t* YA;
    __device__ __forceinline__ void operator()(const f32x4 (&acc)[2][2][4][2], const Unit& u, int wr, int wc, int fr, int fq) const {
        const int g = u.pm >> 1, a0 = (u.pm & 1) * 256 + wr * 64 + fr, ncl = (u.pn & 1) * 256 + wc * 32 + 8 * fq;
        f32x4 dv[2][2];
#pragma unroll
        for (int bj = 0; bj < 2; ++bj) { const int ch = g * 16 + ((ncl + bj * HALF) & 15); dv[bj][0] = *(const f32x4*)(Dv + ch); dv[bj][1] = *(const f32x4*)(Dv + ch + 4); }
#pragma unroll
        for (int ai = 0; ai < 2; ++ai) { u32x4 uw[4][2];
#pragma unroll
            for (int m = 0; m < 4; ++m)
#pragma unroll
                for (int bj = 0; bj < 2; ++bj) { const int a = a0 + ai * HALF + m * 16, nloc = ncl + bj * HALF; uw[m][bj] = *(const u32x4*)(UG + ((size_t)(g * 512 + a)) * 768 + (nloc >> 4) * 16 + (nloc & 15)); }
            __builtin_amdgcn_sched_barrier(0);
#pragma unroll
            for (int m = 0; m < 4; ++m)
#pragma unroll
                for (int bj = 0; bj < 2; ++bj) { const int a = a0 + ai * HALF + m * 16, nloc = ncl + bj * HALF, t = nloc >> 4, cp = nloc & 15, r = a * 32 + t, ch = g * 16 + cp;
                    const u32x4 x = uw[m][bj]; const f32x4 d0 = dv[bj][0], d1 = dv[bj][1], v0 = acc[ai][bj][m][0], v1 = acc[ai][bj][m][1];
                    const float y0 = gelu_tanh(v0[0] + d0[0] * bflo(x.x)), y1 = gelu_tanh(v0[1] + d0[1] * bfhi(x.x)), y2 = gelu_tanh(v0[2] + d0[2] * bflo(x.y)), y3 = gelu_tanh(v0[3] + d0[3] * bfhi(x.y));
                    const float y4 = gelu_tanh(v1[0] + d1[0] * bflo(x.z)), y5 = gelu_tanh(v1[1] + d1[1] * bfhi(x.z)), y6 = gelu_tanh(v1[2] + d1[2] * bflo(x.w)), y7 = gelu_tanh(v1[3] + d1[3] * bfhi(x.w));
                    u32x4 w; w.x = cvt_pk_bf16(y0, y1); w.y = cvt_pk_bf16(y2, y3); w.z = cvt_pk_bf16(y4, y5); w.w = cvt_pk_bf16(y6, y7);
                    *(u32x4*)(YA + (size_t)r * 1024 + ch) = w; }
            asm volatile("" ::: "memory"); }
    }
};
struct EpiGlu {
    static constexpr bool PERM = true, AFTER_DRAIN = false, MID = false;
    const bf16_t* YP; const float* bias; bf16_t* O; int ldo;
    __device__ __forceinline__ void operator()(const f32x4 (&acc)[2][2][4][2], const Unit& u, int wr, int wc, int fr, int fq) const {
        const int row0 = u.pm * BM + wr * 64 + fr, col0 = u.pn * BM + wc * 32 + 8 * fq;
        f32x4 bv[2][2];
#pragma unroll
        for (int bj = 0; bj < 2; ++bj) { bv[bj][0] = *(const f32x4*)(bias + col0 + bj * HALF); bv[bj][1] = *(const f32x4*)(bias + col0 + bj * HALF + 4); }
#pragma unroll
        for (int ai = 0; ai < 2; ++ai) { u32x4 yw[4][2];
#pragma unroll
            for (int m = 0; m < 4; ++m)
#pragma unroll
                for (int bj = 0; bj < 2; ++bj) yw[m][bj] = *(const u32x4*)(YP + (size_t)(row0 + ai * HALF + m * 16) * 1024 + col0 + bj * HALF);
            __builtin_amdgcn_sched_barrier(0);
#pragma unroll
            for (int m = 0; m < 4; ++m)
#pragma unroll
                for (int bj = 0; bj < 2; ++bj) { const u32x4 y = yw[m][bj]; const f32x4 v0 = acc[ai][bj][m][0] + bv[bj][0], v1 = acc[ai][bj][m][1] + bv[bj][1];
                    u32x4 w; w.x = cvt_pk_bf16(bflo(y.x) * sigm(v0[0]), bfhi(y.x) * sigm(v0[1])); w.y = cvt_pk_bf16(bflo(y.y) * sigm(v0[2]), bfhi(y.y) * sigm(v0[3]));
                    w.z = cvt_pk_bf16(bflo(y.z) * sigm(v1[0]), bfhi(y.z) * sigm(v1[1])); w.w = cvt_pk_bf16(bflo(y.w) * sigm(v1[2]), bfhi(y.w) * sigm(v1[3]));
                    *(u32x4*)(O + (size_t)(row0 + ai * HALF + m * 16) * ldo + col0 + bj * HALF) = w; }
            asm volatile("" ::: "memory"); }
    }
};
template <int ST> struct EpiBranch {
    static constexpr bool PERM = true, AFTER_DRAIN = false, MID = false;
    const bf16_t* GT; bf16_t* OUT; const bf16_t* G2;
    __device__ __forceinline__ void operator()(const f32x4 (&acc)[2][2][4][2], const Unit& u, int wr, int wc, int fr, int fq) const {
        const int row0 = u.pm * BM + wr * 64 + fr, col0 = u.pn * BM + wc * 32 + 8 * fq;
        const bool early = (ST == 0) && u.pn < 2; const bf16_t* gbase = early ? G2 : GT; const int gld = early ? 512 : 6144;
#pragma unroll
        for (int ai = 0; ai < 2; ++ai) {
            u32x4 gw[4][2], tw[4][2];
#pragma unroll
            for (int m = 0; m < 4; ++m)
#pragma unroll
                for (int bj = 0; bj < 2; ++bj) { const int r = row0 + ai * HALF + m * 16, c = col0 + bj * HALF;
                    gw[m][bj] = gload16(gbase + (size_t)r * gld + c);
                    if (ST != 0) tw[m][bj] = gload16(OUT + (size_t)r * 2048 + c); }
#pragma unroll
            for (int m = 0; m < 4; ++m)
#pragma unroll
                for (int bj = 0; bj < 2; ++bj) { const int r = row0 + ai * HALF + m * 16, c = col0 + bj * HALF;
                    const u32x4 g = gw[m][bj]; const f32x4 a0 = acc[ai][bj][m][0], a1 = acc[ai][bj][m][1];
                    float v0 = sigm(bflo(g.x)) * a0[0], v1 = sigm(bfhi(g.x)) * a0[1], v2 = sigm(bflo(g.y)) * a0[2], v3 = sigm(bfhi(g.y)) * a0[3];
                    float v4 = sigm(bflo(g.z)) * a1[0], v5 = sigm(bfhi(g.z)) * a1[1], v6 = sigm(bflo(g.w)) * a1[2], v7 = sigm(bfhi(g.w)) * a1[3];
                    if (ST != 0) { const u32x4 t = tw[m][bj]; v0 += bflo(t.x); v1 += bfhi(t.x); v2 += bflo(t.y); v3 += bfhi(t.y); v4 += bflo(t.z); v5 += bfhi(t.z); v6 += bflo(t.w); v7 += bfhi(t.w); }
                    u32x4 w; w.x = cvt_pk_bf16(v0, v1); w.y = cvt_pk_bf16(v2, v3); w.z = cvt_pk_bf16(v4, v5); w.w = cvt_pk_bf16(v6, v7);
                    gstore16(OUT + (size_t)r * 2048 + c, w); }
            asm volatile("" ::: "memory"); }
    }
};

struct EpiBranch3 {
    static constexpr bool PERM = true, AFTER_DRAIN = false, MID = true;
    const bf16_t* GT; const bf16_t* G2; bf16_t* OUT;
    __device__ __forceinline__ u32x4 gate16(int x, int r, int c) const { return (x == 0 && c < 512) ? gload16(G2 + (size_t)r * 512 + c) : gload16(GT + (size_t)r * 6144 + x * 2048 + c); }
    __device__ __forceinline__ void mid(f32x4 (&acc)[2][2][4][2], const Unit& u, int seg, int wr, int wc, int fr, int fq) const {
        int row0 = u.pm * BM + wr * 64 + fr, col0 = u.pn * BM + wc * 32 + 8 * fq; const int x = seg - 1;
        asm volatile("" : "+v"(row0), "+v"(col0));
#pragma unroll
        for (int ai = 0; ai < 2; ++ai) { u32x4 gn[4][2], gd[4][2];
#pragma unroll
            for (int m = 0; m < 4; ++m)
#pragma unroll
                for (int bj = 0; bj < 2; ++bj) { const int r = row0 + ai * HALF + m * 16, c = col0 + bj * HALF; gn[m][bj] = gate16(x, r, c); gd[m][bj] = gate16(x + 1, r, c); }
            __builtin_amdgcn_sched_barrier(0);
#pragma unroll
            for (int m = 0; m < 4; ++m)
#pragma unroll
                for (int bj = 0; bj < 2; ++bj) { const u32x4 a = gn[m][bj], b = gd[m][bj];
#define RAT(A, B) ((1.f + __expf(-fminf(fmaxf((B), -30.f), 30.f))) * __builtin_amdgcn_rcpf(1.f + __expf(-fminf(fmaxf((A), -30.f), 30.f))))
                    acc[ai][bj][m][0][0] *= RAT(bflo(a.x), bflo(b.x)); acc[ai][bj][m][0][1] *= RAT(bfhi(a.x), bfhi(b.x)); acc[ai][bj][m][0][2] *= RAT(bflo(a.y), bflo(b.y)); acc[ai][bj][m][0][3] *= RAT(bfhi(a.y), bfhi(b.y));
                    acc[ai][bj][m][1][0] *= RAT(bflo(a.z), bflo(b.z)); acc[ai][bj][m][1][1] *= RAT(bfhi(a.z), bfhi(b.z)); acc[ai][bj][m][1][2] *= RAT(bflo(a.w), bflo(b.w)); acc[ai][bj][m][1][3] *= RAT(bfhi(a.w), bfhi(b.w));
#undef RAT
                }
            asm volatile("" ::: "memory"); }
    }
    __device__ __forceinline__ void operator()(const f32x4 (&acc)[2][2][4][2], const Unit& u, int wr, int wc, int fr, int fq) const {
        int row0 = u.pm * BM + wr * 64 + fr, col0 = u.pn * BM + wc * 32 + 8 * fq; asm volatile("" : "+v"(row0), "+v"(col0));
#pragma unroll
        for (int ai = 0; ai < 2; ++ai) { u32x4 gw[4][2];
#pragma unroll
            for (int m = 0; m < 4; ++m)
#pragma unroll
                for (int bj = 0; bj < 2; ++bj) gw[m][bj] = gate16(2, row0 + ai * HALF + m * 16, col0 + bj * HALF);
            __builtin_amdgcn_sched_barrier(0);
#pragma unroll
            for (int m = 0; m < 4; ++m)
#pragma unroll
                for (int bj = 0; bj < 2; ++bj) { const u32x4 g = gw[m][bj]; const f32x4 a0 = acc[ai][bj][m][0], a1 = acc[ai][bj][m][1];
                    u32x4 w; w.x = cvt_pk_bf16(sigm(bflo(g.x)) * a0[0], sigm(bfhi(g.x)) * a0[1]); w.y = cvt_pk_bf16(sigm(bflo(g.y)) * a0[2], sigm(bfhi(g.y)) * a0[3]);
                    w.z = cvt_pk_bf16(sigm(bflo(g.z)) * a1[0], sigm(bfhi(g.z)) * a1[1]); w.w = cvt_pk_bf16(sigm(bflo(g.w)) * a1[2], sigm(bfhi(g.w)) * a1[3]);
                    gstore16(OUT + (size_t)(row0 + ai * HALF + m * 16) * 2048 + col0 + bj * HALF, w); }
            asm volatile("" ::: "memory"); }
    }
};
template <int CTRL> __device__ __forceinline__ float dppk(float oldv, float src) {
    return __builtin_bit_cast(float, __builtin_amdgcn_update_dpp(__builtin_bit_cast(int, oldv), __builtin_bit_cast(int, src), CTRL, 0xf, 0xf, false)); }
struct EpiUpConv {
    static constexpr bool PERM = true, AFTER_DRAIN = false, MID = false;
    const float* cw; const float* cb; bf16_t* AF; float* HALO; PG8_LAS float* xch;
    __device__ __forceinline__ void operator()(f32x4 (&acc)[2][2][4][2], const Unit& u, int wr, int wc, int fr, int fq) const {
        const int colL = wc * 32 + fq * 8;
#pragma unroll
        for (int ai = 0; ai < 2; ++ai) { const int blk = 2 * ai + wr;
            if (fr == 0) {
#pragma unroll
                for (int bj = 0; bj < 2; ++bj)
#pragma unroll
                    for (int n = 0; n < 2; ++n) *(PG8_LAS f32x4*)(xch + (blk * 2 + 0) * 256 + bj * 128 + colL + 4 * n) = acc[ai][bj][0][n]; }
            if (fr == 15) {
#pragma unroll
                for (int bj = 0; bj < 2; ++bj)
#pragma unroll
                    for (int n = 0; n < 2; ++n) *(PG8_LAS f32x4*)(xch + (blk * 2 + 1) * 256 + bj * 128 + colL + 4 * n) = acc[ai][bj][3][n]; } }
        if (u.pm >= 32) {
            if (wr == 0 && fr < 2) { float* hp = HALO + ((size_t)(u.pm * 4 + fr)) * 11264 + u.pn * 256 + colL;
#pragma unroll
                for (int bj = 0; bj < 2; ++bj)
#pragma unroll
                    for (int n = 0; n < 2; ++n) *(f32x4*)(hp + bj * 128 + 4 * n) = acc[0][bj][0][n]; }
            if (wr == 1 && fr >= 14) { float* hp = HALO + ((size_t)(u.pm * 4 + 2 + (fr - 14))) * 11264 + u.pn * 256 + colL;
#pragma unroll
                for (int bj = 0; bj < 2; ++bj)
#pragma unroll
                    for (int n = 0; n < 2; ++n) *(f32x4*)(hp + bj * 128 + 4 * n) = acc[1][bj][3][n]; }
        }
        asm volatile("s_waitcnt lgkmcnt(0)" ::: "memory"); __builtin_amdgcn_s_barrier(); asm volatile("" ::: "memory");
#pragma unroll
        for (int ai = 0; ai < 2; ++ai) { const int blk = 2 * ai + wr;
#pragma unroll
            for (int bj = 0; bj < 2; ++bj)
#pragma unroll
                for (int n = 0; n < 2; ++n) { const int ch = bj * 5632 + 128 * u.pn + colL + 4 * n;
                    const f32x4 w0 = *(const f32x4*)(cw + ch), w1 = *(const f32x4*)(cw + 11264 + ch), w2 = *(const f32x4*)(cw + 2 * 11264 + ch), bb = *(const f32x4*)(cb + ch);
                    f32x4 xu = (f32x4){0.f, 0.f, 0.f, 0.f}, xd = (f32x4){0.f, 0.f, 0.f, 0.f};
                    if (fr == 0 && blk > 0) xu = *(const PG8_LAS f32x4*)(xch + ((blk - 1) * 2 + 1) * 256 + bj * 128 + colL + 4 * n);
                    if (fr == 15 && blk < 3) xd = *(const PG8_LAS f32x4*)(xch + ((blk + 1) * 2 + 0) * 256 + bj * 128 + colL + 4 * n);
                    f32x4 y[4];
#pragma unroll
                    for (int m = 0; m < 4; ++m) { const f32x4 cur = acc[ai][bj][m][n];
#pragma unroll
                        for (int e = 0; e < 4; ++e) {
                            const float t1 = (m == 0) ? xu[e] : dppk<0x10F>(0.f, acc[ai][bj][m > 0 ? m - 1 : 0][n][e]);
                            const float up = dppk<0x111>(t1, cur[e]);
                            const float t2 = (m == 3) ? xd[e] : dppk<0x11F>(0.f, acc[ai][bj][m < 3 ? m + 1 : 3][n][e]);
                            const float dn = dppk<0x101>(t2, cur[e]);
                            y[m][e] = w0[e] * up + w1[e] * cur[e] + w2[e] * dn + bb[e]; } }
#pragma unroll
                    for (int m = 0; m < 4; ++m) acc[ai][bj][m][n] = y[m];
                    asm volatile("" : "+v"(acc[ai][bj][0][n]), "+v"(acc[ai][bj][1][n]), "+v"(acc[ai][bj][2][n]), "+v"(acc[ai][bj][3][n]) :: "memory"); } }
#pragma unroll
        for (int ai = 0; ai < 2; ++ai)
#pragma unroll
            for (int m = 0; m < 4; ++m) { const int r = u.pm * BM + ai * HALF + wr * 64 + m * 16 + fr;
                const f32x4 v0 = acc[ai][0][m][0], v1 = acc[ai][0][m][1], g0 = acc[ai][1][m][0], g1 = acc[ai][1][m][1];
                u32x4 w; w.x = cvt_pk_bf16(g0[0] * sigm(g0[0]) * v0[0], g0[1] * sigm(g0[1]) * v0[1]); w.y = cvt_pk_bf16(g0[2] * sigm(g0[2]) * v0[2], g0[3] * sigm(g0[3]) * v0[3]);
                w.z = cvt_pk_bf16(g1[0] * sigm(g1[0]) * v1[0], g1[1] * sigm(g1[1]) * v1[1]); w.w = cvt_pk_bf16(g1[2] * sigm(g1[2]) * v1[2], g1[3] * sigm(g1[3]) * v1[3]);
                gstore16(AF + (size_t)r * 5632 + 128 * u.pn + colL, w); }
    }
};

template <class Epi, class Sched, bool ALIGN_EPI = false, bool SP2 = false>
__device__ __forceinline__ void gemm_phase(PG8_LAS unsigned char* lds, const Gemm g, const Sched& S, const Epi& E) {
    int tid = threadIdx.x; asm volatile("" : "+v"(tid));
    const int wid = __builtin_amdgcn_readfirstlane(tid >> 6), lane = tid & 63, wr = wid >> 2, wc = wid & 3, fr = lane & 15, fq = lane >> 4;
    const int K = g.K, nt = K / BK;
    unsigned voffA[2], voffB[2];
#pragma unroll
    for (int i = 0; i < 2; ++i) { int R, C; stage_rc(tid * 16 + i * 8192, R, C); const int Rb = Epi::PERM ? ((R & ~31) + perm32(R & 31)) : R;
        voffA[i] = (unsigned)(R * g.lda + C) * 2u; voffB[i] = (unsigned)(Rb * g.ldb + C) * 2u; }
    const size_t kstep = (size_t)(BK * 2);
    const size_t hstepA = (size_t)HALF * g.lda * 2, hstepB = (size_t)HALF * g.ldb * 2;
    const size_t tstepA = 2 * hstepA, tstepB = 2 * hstepB;
    const unsigned ldsw = (unsigned)wid * 1024u;
    const int aoff = lds_byte(wr * 64 + fr, fq * 8), boff = lds_byte(wc * 32 + fr, fq * 8);
#define PG8_SA(b, h) (((b) * 2 + (h)) * HTB)
#define PG8_SB(b, h) ((4 + (b) * 2 + (h)) * HTB)
#define PG8_STAGE(bufoff, gbase, voff) do { _Pragma("unroll") for (int _i = 0; _i < 2; ++_i) \
        __builtin_amdgcn_global_load_lds((const unsigned*)((const char*)(gbase) + (voff)[_i]), (PG8_LAS unsigned*)(lds + (bufoff) + ldsw + _i * 8192), 16, 0, 0); } while (0)
#define PG8_LDA(dst, b, h) do { _Pragma("unroll") for (int m = 0; m < 4; ++m) _Pragma("unroll") for (int k = 0; k < 2; ++k) dst[m][k] = *(const PG8_LAS bf16x8*)(lds + PG8_SA(b, h) + aoff + m * 2048 + k * 1024); } while (0)
#define PG8_LDB(dst, b, h) do { _Pragma("unroll") for (int n = 0; n < 2; ++n) _Pragma("unroll") for (int k = 0; k < 2; ++k) dst[n][k] = *(const PG8_LAS bf16x8*)(lds + PG8_SB(b, h) + boff + n * 2048 + k * 1024); } while (0)
#define PG8_MMA(ai, bj, At, Bt) do { __builtin_amdgcn_s_setprio(1); _Pragma("unroll") for (int m = 0; m < 4; ++m) _Pragma("unroll") for (int n = 0; n < 2; ++n) _Pragma("unroll") for (int k = 0; k < 2; ++k) \
        acc[ai][bj][m][n] = __builtin_amdgcn_mfma_f32_16x16x32_bf16(Bt[n][k], At[m][k], acc[ai][bj][m][n], 0, 0, 0); __builtin_amdgcn_s_setprio(0); } while (0)
#define PG8_WAIT_V(n) asm volatile("s_waitcnt vmcnt(" #n ")" ::: "memory")
#define PG8_WAIT_L(n) asm volatile("s_waitcnt lgkmcnt(" #n ")" ::: "memory")
#define PG8_BAR __builtin_amdgcn_s_barrier()
#define PG8_SCHED __builtin_amdgcn_sched_barrier(0)
    Unit cur, nxt; int ui = 0;
    if (!S.next(0, cur)) return;
    f32x4 acc[2][2][4][2];
#pragma unroll
    for (int a = 0; a < 2; ++a)
#pragma unroll
        for (int b = 0; b < 2; ++b)
#pragma unroll
            for (int m = 0; m < 4; ++m)
#pragma unroll
                for (int n = 0; n < 2; ++n) acc[a][b][m][n] = (f32x4){0.f, 0.f, 0.f, 0.f};
    bf16x8 At[4][2], B0[2][2], B1[2][2];
    const char* cA = (const char*)g.A + (size_t)cur.pm * tstepA; const char* cB = (const char*)g.Bt + (size_t)cur.pn * tstepB;
    S.a_ready(cur);
    if constexpr (SP2) {
        PG8_STAGE(PG8_SB(0, 0), cB, voffB); PG8_STAGE(PG8_SB(0, 1), cB + hstepB, voffB); PG8_STAGE(PG8_SA(0, 0), cA, voffA); PG8_STAGE(PG8_SA(0, 1), cA + hstepA, voffA);
        PG8_STAGE(PG8_SB(1, 0), cB + kstep, voffB); PG8_STAGE(PG8_SA(1, 0), cA + kstep, voffA); PG8_STAGE(PG8_SB(1, 1), cB + hstepB + kstep, voffB);
        if (wr == 1) PG8_BAR;
        PG8_WAIT_V(8); PG8_BAR;
        PG8_WAIT_V(6); PG8_BAR;
    } else {
        PG8_STAGE(PG8_SB(0, 0), cB, voffB); PG8_STAGE(PG8_SA(0, 0), cA, voffA); PG8_STAGE(PG8_SB(0, 1), cB + hstepB, voffB); PG8_STAGE(PG8_SA(0, 1), cA + hstepA, voffA);
        if (wr == 1) PG8_BAR;
        PG8_WAIT_V(4); PG8_BAR;
        PG8_STAGE(PG8_SB(1, 0), cB + kstep, voffB); PG8_STAGE(PG8_SA(1, 0), cA + kstep, voffA); PG8_STAGE(PG8_SB(1, 1), cB + hstepB + kstep, voffB);
        PG8_WAIT_V(6); PG8_BAR;
    }
    for (;;) {
        const bool has_next = S.next(ui + 1, nxt);
        const char* nA = has_next ? (const char*)g.A + (size_t)nxt.pm * tstepA : cA; const char* nB = has_next ? (const char*)g.Bt + (size_t)nxt.pn * tstepB : cB;
        for (int t = 0; t < nt; t += 2) {
            const bool last = (t == nt - 2);
            const char* a1 = cA + (size_t)(t + 1) * kstep;
            const char* a2 = last ? nA : cA + (size_t)(t + 2) * kstep; const char* b2 = last ? nB : cB + (size_t)(t + 2) * kstep;
            const char* a3 = a2 + kstep; const char* b3 = b2 + kstep;
            if constexpr (Epi::MID) { if (t == 16 || t == 32) E.mid(acc, cur, t >> 4, wr, wc, fr, fq); }
            if (last && has_next) S.a_ready(nxt);
            if constexpr (SP2) {
            PG8_LDB(B0, 0, 0); PG8_LDB(B1, 0, 1); PG8_SCHED; PG8_LDA(At, 0, 0); PG8_STAGE(PG8_SA(1, 1), a1 + hstepA, voffA);
            PG8_WAIT_V(8); PG8_WAIT_L(0); PG8_BAR; PG8_MMA(0, 0, At, B0); PG8_MMA(0, 1, At, B1); PG8_BAR; PG8_SCHED;
            PG8_LDA(At, 0, 1); PG8_STAGE(PG8_SB(0, 0), b2, voffB); PG8_STAGE(PG8_SB(0, 1), b2 + hstepB, voffB); PG8_STAGE(PG8_SA(0, 0), a2, voffA);
            PG8_WAIT_V(8); PG8_WAIT_L(0); PG8_BAR; PG8_MMA(1, 0, At, B0); PG8_MMA(1, 1, At, B1); PG8_BAR; PG8_SCHED;
            PG8_LDB(B0, 1, 0); PG8_LDB(B1, 1, 1); PG8_SCHED; PG8_LDA(At, 1, 0); PG8_STAGE(PG8_SA(0, 1), a2 + hstepA, voffA);
            PG8_WAIT_V(8); PG8_WAIT_L(0); PG8_BAR; PG8_MMA(0, 0, At, B0); PG8_MMA(0, 1, At, B1); PG8_BAR; PG8_SCHED;
            PG8_LDA(At, 1, 1); PG8_STAGE(PG8_SB(1, 0), b3, voffB); PG8_STAGE(PG8_SB(1, 1), b3 + hstepB, voffB); PG8_STAGE(PG8_SA(1, 0), a3, voffA);
            PG8_WAIT_V(8); PG8_WAIT_L(0); PG8_BAR; PG8_MMA(1, 0, At, B0); PG8_MMA(1, 1, At, B1); PG8_BAR; PG8_SCHED;
            } else {
            PG8_LDB(B0, 0, 0); PG8_SCHED; PG8_LDA(At, 0, 0); PG8_STAGE(PG8_SA(1, 1), a1 + hstepA, voffA);
            PG8_WAIT_L(8); PG8_BAR; PG8_WAIT_L(0); PG8_MMA(0, 0, At, B0); PG8_BAR; PG8_SCHED;
            PG8_LDB(B1, 0, 1); PG8_STAGE(PG8_SB(0, 0), b2, voffB);
            PG8_BAR; PG8_WAIT_L(0); PG8_MMA(0, 1, At, B1); PG8_BAR;
            PG8_LDA(At, 0, 1); PG8_STAGE(PG8_SA(0, 0), a2, voffA);
            PG8_BAR; PG8_WAIT_L(0); PG8_MMA(1, 0, At, B0); PG8_BAR; PG8_SCHED;
            PG8_STAGE(PG8_SB(0, 1), b2 + hstepB, voffB);
            PG8_WAIT_V(6); PG8_BAR; PG8_MMA(1, 1, At, B1); PG8_BAR;
            PG8_LDB(B0, 1, 0); PG8_SCHED; PG8_LDA(At, 1, 0); PG8_STAGE(PG8_SA(0, 1), a2 + hstepA, voffA);
            PG8_WAIT_L(8); PG8_BAR; PG8_WAIT_L(0); PG8_MMA(0, 0, At, B0); PG8_BAR; PG8_SCHED;
            PG8_LDB(B1, 1, 1); PG8_STAGE(PG8_SB(1, 0), b3, voffB);
            PG8_BAR; PG8_WAIT_L(0); PG8_MMA(0, 1, At, B1); PG8_BAR;
            PG8_LDA(At, 1, 1); PG8_STAGE(PG8_SA(1, 0), a3, voffA);
            PG8_BAR; PG8_WAIT_L(0); PG8_MMA(1, 0, At, B0); PG8_BAR; PG8_SCHED;
            PG8_STAGE(PG8_SB(1, 1), b3 + hstepB, voffB);
            PG8_WAIT_V(6); PG8_BAR; PG8_MMA(1, 1, At, B1); PG8_BAR;
            }
        }
        if constexpr (ALIGN_EPI) { if (wr == 0) PG8_BAR; }
        if constexpr (!Epi::AFTER_DRAIN) { E(acc, cur, wr, wc, fr, fq); S.done(cur); }
        if (!has_next) break;
#pragma unroll
        for (int a = 0; a < 2; ++a)
#pragma unroll
            for (int b = 0; b < 2; ++b)
#pragma unroll
                for (int m = 0; m < 4; ++m)
#pragma unroll
                    for (int n = 0; n < 2; ++n) acc[a][b][m][n] = (f32x4){0.f, 0.f, 0.f, 0.f};
        cur = nxt; cA = nA; cB = nB; ++ui;
        if constexpr (ALIGN_EPI) { if (wr == 1) PG8_BAR; }
    }
    PG8_WAIT_V(0);
    if constexpr (!ALIGN_EPI) { if (wr == 0) PG8_BAR; }
    PG8_BAR;
    if constexpr (Epi::AFTER_DRAIN) { E.fused(acc, cur, wr, wc, fr, fq, lds, wid, lane); S.done(cur); }
#undef PG8_SA
#undef PG8_SB
#undef PG8_STAGE
#undef PG8_LDA
#undef PG8_LDB
#undef PG8_MMA
#undef PG8_WAIT_V
#undef PG8_WAIT_L
#undef PG8_BAR
#undef PG8_SCHED
}
}
using namespace pg8;
#define LAS __attribute__((address_space(3)))
constexpr int DM = 2048, M = 16384, MPR = 8192, MK = M + 512;
constexpr int NMOD = 12288, NIN = 12608, NP2 = 6656, NP2REAL = 6464, NGATE = 6144, NINT = 12800;
constexpr int DFF = 5632, DFF2 = 11264;
constexpr float EPS = 1e-6f;
constexpr size_t O_CKV = 33554432, O_KR = 41943040, O_RF = 42991616, O_RB = 51380224, O_SF = 59768832, O_SB = 60293120, O_END = 60817408;
constexpr size_t MiB = 1u << 20;
constexpr size_t WS_CTL = 0, CTL_ZERO_BYTES = 1 * MiB;
constexpr size_t WS_MODS = 1 * MiB, WS_ROPE = 2 * MiB, WS_ABT = 3 * MiB, WS_R1 = 3 * MiB + 524288;
constexpr size_t WS_WIN = 4 * MiB, WS_WGLU = 54 * MiB, WS_WUQ = 56 * MiB, WS_WKV = 59 * MiB, WS_WBR = 61 * MiB, WS_WOUT = 73 * MiB, WS_WUP = 81 * MiB, WS_WDN = 125 * MiB, WS_BTY = 147 * MiB, WS_BTE = 195 * MiB;
constexpr size_t PO = 212 * MiB;
constexpr size_t WS_H = PO, WS_UG = PO + 64 * MiB, WS_Q = PO + 112 * MiB, WS_K = PO + 144 * MiB, WS_V = PO + 176 * MiB, WS_G = PO + 208 * MiB, WS_CQ = PO + 240 * MiB, WS_CKV = PO + 264 * MiB, WS_KR = PO + 281 * MiB;
constexpr size_t WS_ELOC = PO + 284 * MiB, WS_LRET = PO + 316 * MiB, WS_SRET = PO + 444 * MiB, WS_QMLA = PO + 508 * MiB, WS_KVMLA = PO + 556 * MiB;
constexpr size_t WS_YAP = PO + 240 * MiB, WS_Y3 = PO + 284 * MiB, WS_GATES = PO + 380 * MiB;
constexpr int LDY3 = 3072;
constexpr size_t WS_MTMP = PO + 64 * MiB, WS_MERGED = PO + 192 * MiB, WS_MO = PO + 284 * MiB, WS_UF = PO + 64 * MiB, WS_AF = PO + 416 * MiB, WS_DN = PO + 64 * MiB;
constexpr size_t WS_HALO = PO + 200 * MiB;
constexpr size_t WS_G2 = PO + 622 * MiB;
constexpr size_t WS_END = PO + 638 * MiB;
constexpr int CW_BAR = 4096;
constexpr int RING_BYTES = 131072, MISC_OFF = RING_BYTES + 320, XCH_OFF = RING_BYTES + 1024, LDS_BYTES = 147456;

#define XB_TMO      128
#define XB_XCNT(j)  (256  + 64 * (j))
#define XB_XSUB(j)  (1280 + 64 * (j))
#define XB_XGEN(j)  (2304 + 64 * (j))
#define XB_TOP      3328
#define XB_TOPGEN   3392
#define XCD_BAR_WORDS 3456
#define XB_SPIN_CAP (1u << 18)

__device__ __forceinline__ unsigned xb_ld(unsigned* p)              { return __hip_atomic_load(p, __ATOMIC_RELAXED, __HIP_MEMORY_SCOPE_AGENT); }
__device__ __forceinline__ unsigned xb_add(unsigned* p, unsigned v) { return __hip_atomic_fetch_add(p, v, __ATOMIC_RELAXED, __HIP_MEMORY_SCOPE_AGENT); }
__device__ __forceinline__ unsigned xb_xcc_id() { return (unsigned)__builtin_amdgcn_s_getreg((3 << 11) | 20) & 0xFu; }
#define XB_SPIN(cond, bar) do { unsigned _sp = 0; while (cond) { __builtin_amdgcn_s_sleep(1); \
    if ((++_sp & 255u) == 0u) { if (xb_ld(&(bar)[XB_TMO])) break; if (_sp > XB_SPIN_CAP) { atomicAdd(&(bar)[XB_TMO], 1u); break; } } } } while (0)

struct XcdBarrier {
    unsigned* bar; unsigned x;
    volatile LAS unsigned* st;
};

__device__ __forceinline__ XcdBarrier xcd_barrier_post(unsigned* bar, volatile LAS unsigned* st) {
    XcdBarrier b; b.bar = bar; b.x = xb_xcc_id(); b.st = st;
    if (threadIdx.x == 0) (void)xb_add(&bar[XB_XCNT(b.x)], 1u);
    return b;
}
__device__ __forceinline__ void xcd_barrier_complete(unsigned* bar, unsigned x, unsigned& nloc, unsigned& nx) {
    const unsigned G = gridDim.x * gridDim.y * gridDim.z;
    unsigned sum, cnt, mine, sp = 0u;
    for (;;) {
        sum = 0u; cnt = 0u; mine = 0u;
#pragma unroll
        for (unsigned j = 0; j < 16; ++j) { const unsigned c = xb_ld(&bar[XB_XCNT(j)]); sum += c; cnt += (c > 0u) ? 1u : 0u; mine = (j == x) ? c : mine; }
        if (sum == G) break;
        __builtin_amdgcn_s_sleep(1);
        if ((++sp & 255u) == 0u) { if (xb_ld(&bar[XB_TMO])) break; if (sp > XB_SPIN_CAP) { atomicAdd(&bar[XB_TMO], 1u); break; } }
    }
    nloc = mine > 0u ? mine : 1u; nx = cnt > 0u ? cnt : 1u;
}

__device__ __forceinline__ void xcd_barrier(const XcdBarrier& b) {
    asm volatile("s_waitcnt vmcnt(0)" ::: "memory");
    __syncthreads();
    if (threadIdx.x == 0) {
        unsigned* bar = b.bar;
        __builtin_amdgcn_s_waitcnt(0);
        unsigned nloc = b.st[0], nx = b.st[1];
        if (nloc == 0u) { xcd_barrier_complete(bar, b.x, nloc, nx); b.st[0] = nloc; b.st[1] = nx; }
        const unsigned old = xb_add(&bar[XB_XSUB(b.x)], 1u);
        const unsigned gen = old / nloc;
        if (old + 1u == (gen + 1u) * nloc) {
            __builtin_amdgcn_fence(__ATOMIC_RELEASE, "agent");
            asm volatile("s_waitcnt vmcnt(0)" ::: "memory");
            const unsigned og = xb_add(&bar[XB_TOP], 1u);
            const unsigned tg = og / nx;
            if (og + 1u == (tg + 1u) * nx) xb_add(&bar[XB_TOPGEN], 1u);
            else XB_SPIN(xb_ld(&bar[XB_TOPGEN]) == tg, bar);
            __builtin_amdgcn_fence(__ATOMIC_ACQUIRE, "agent");
            xb_add(&bar[XB_XGEN(b.x)], 1u);
            asm volatile("s_waitcnt vmcnt(0)" ::: "memory");
        } else {
            XB_SPIN(xb_ld(&bar[XB_XGEN(b.x)]) == gen, bar);
            __builtin_amdgcn_fence(__ATOMIC_ACQUIRE, "agent");
            asm volatile("s_waitcnt vmcnt(0)" ::: "memory");
        }
    }
    __syncthreads();
}

__device__ __forceinline__ float wave_sum(float v) {
#pragma unroll
    for (int o = 1; o < 64; o <<= 1) v += __shfl_xor(v, o);
    return v;
}
__device__ __forceinline__ void* opaque_uniform(void* p) {
    unsigned lo32 = (unsigned)(uintptr_t)p, hi32 = (unsigned)((uintptr_t)p >> 32); asm volatile("" : "+v"(lo32), "+v"(hi32));
    lo32 = __builtin_amdgcn_readfirstlane(lo32); hi32 = __builtin_amdgcn_readfirstlane(hi32);
    return (void*)(((uintptr_t)hi32 << 32) | (uintptr_t)lo32);
}
struct Ctx {
    unsigned char* lds; unsigned char* ws; float* out; const float* const* in;
    int G, bid;
};
typedef float f32x2 __attribute__((ext_vector_type(2)));

struct TrItem { const float* W; bf16_t* WT; int ldw, K; };
__device__ __forceinline__ void tr_load(const TrItem& t, int lane, f32x4 (&v)[8]) {
    const float* p = t.W + (size_t)(lane >> 3) * t.ldw + (lane & 7) * 4;
#pragma unroll
    for (int i = 0; i < 8; ++i) v[i] = *(const f32x4*)(p + (size_t)(8 * i) * t.ldw);
}
__device__ __forceinline__ void tr_store(const TrItem& t, int lane, const f32x4 (&v)[8], float* scr) {
    const int kl = lane >> 3, n4 = (lane & 7) * 4;
#pragma unroll
    for (int i = 0; i < 8; ++i) { float* d = scr + (8 * i + kl) * 33 + n4; d[0] = v[i][0]; d[1] = v[i][1]; d[2] = v[i][2]; d[3] = v[i][3]; }
    asm volatile("s_waitcnt lgkmcnt(0)" ::: "memory");
    const int c = lane & 7;
#pragma unroll
    for (int j = 0; j < 4; ++j) { const int n = (lane >> 3) + 8 * j; const float* s = scr + (8 * c) * 33 + n;
        u32x4 o; o.x = cvt_pk_bf16(s[0 * 33], s[1 * 33]); o.y = cvt_pk_bf16(s[2 * 33], s[3 * 33]); o.z = cvt_pk_bf16(s[4 * 33], s[5 * 33]); o.w = cvt_pk_bf16(s[6 * 33], s[7 * 33]);
        *(u32x4*)(t.WT + (size_t)n * t.K + 8 * c) = o; }
    asm volatile("s_waitcnt lgkmcnt(0)" ::: "memory");
}
constexpr int TI0 = 32 * 202, TI1 = 32 * 192, TI2 = 16 * 32, TI3 = 12 * 48, TI4 = 8 * 32, TI5 = 8 * 32, TI6 = 3 * 16 * 64, TI7 = 32 * 64, TI8 = 32 * 352, TI9 = 88 * 64;
constexpr int TNIT = TI0 + TI1 + TI2 + TI3 + TI4 + TI5 + TI6 + TI7 + TI8 + TI9;
__device__ __forceinline__ TrItem tr_decode(const Ctx& X, int l, int r) {
    const float* W; bf16_t* WT; int ldw, K, kb, sc, dr;
    if (r < TI0) { W = X.in[13] + (size_t)l * 2048 * NIN; WT = (bf16_t*)(X.ws + WS_WIN); ldw = NIN; K = 2048; kb = r / 202; sc = dr = (r % 202) * 32; }
    else if ((r -= TI0) < TI1) { W = X.in[13] + (size_t)l * 2048 * NIN + NP2REAL; WT = (bf16_t*)(X.ws + WS_WIN) + (size_t)NP2 * 2048; ldw = NIN; K = 2048; kb = r / 192; sc = dr = (r % 192) * 32; }
    else if ((r -= TI1) < TI2) { W = X.in[22] + (size_t)l * 1024 * 1024; WT = (bf16_t*)(X.ws + WS_WGLU); ldw = 1024; K = 1024; kb = r / 32; sc = dr = (r % 32) * 32; }
    else if ((r -= TI2) < TI3) { W = X.in[28] + (size_t)l * 768 * 1536; WT = (bf16_t*)(X.ws + WS_WUQ); ldw = 1536; K = 768; kb = r / 48; sc = dr = (r % 48) * 32; }
    else if ((r -= TI3) < TI4) { W = X.in[29] + (size_t)l * 512 * 1024; WT = (bf16_t*)(X.ws + WS_WKV); ldw = 1024; K = 512; kb = r / 32; sc = dr = (r % 32) * 32; }
    else if ((r -= TI4) < TI5) { W = X.in[30] + (size_t)l * 512 * 1024; WT = (bf16_t*)(X.ws + WS_WKV) + (size_t)1024 * 512; ldw = 1024; K = 512; kb = r / 32; sc = dr = (r % 32) * 32; }
    else if ((r -= TI5) < TI6) { const int x = r / 1024, rr = r % 1024; W = X.in[31] + ((size_t)l * 3 + x) * 1024 * 2048; WT = (bf16_t*)(X.ws + WS_WBR) + (size_t)x * 1024; ldw = 2048; K = 3072; kb = rr / 64; sc = dr = (rr % 64) * 32; }
    else if ((r -= TI6) < TI7) { W = X.in[32] + (size_t)l * 2048 * 2048; WT = (bf16_t*)(X.ws + WS_WOUT); ldw = 2048; K = 2048; kb = r / 64; sc = dr = (r % 64) * 32; }
    else if ((r -= TI7) < TI8) { W = X.in[33] + (size_t)l * 2048 * DFF2; WT = (bf16_t*)(X.ws + WS_WUP); ldw = DFF2; K = 2048; kb = r / 352; sc = (r % 352) * 32;
        const int half = sc >= DFF ? 1 : 0, wi = sc - half * DFF; dr = (wi >> 7) * 256 + half * 128 + (wi & 127); }
    else { r -= TI8; W = X.in[36] + (size_t)l * DFF * 2048; WT = (bf16_t*)(X.ws + WS_WDN); ldw = 2048; K = DFF; kb = r / 64; sc = dr = (r % 64) * 32; }
    TrItem t; t.W = W + (size_t)(64 * kb) * ldw + sc; t.WT = WT + (size_t)dr * K + 64 * kb; t.ldw = ldw; t.K = K; return t;
}

__device__ __forceinline__ void phase_pre(const Ctx& X, int l) {
    int tid = threadIdx.x; asm volatile("" : "+v"(tid)); const int lane = tid & 63, wave = __builtin_amdgcn_readfirstlane(tid >> 6);
    float* L = (float*)X.lds;
    const int nmods = (l == 0) ? 384 : 0;
    for (int it = X.bid; it < 128 + nmods; it += X.G) {
      if (it < 128) {
        const int g = it >> 1, hf = it & 1;
        float* Cc = L; float* Bp = L + 2048; float* PW = L + 6144; float* KL = L + 14592;
        const float* lam_re = X.in[14]; const float* lam_im = X.in[15]; const float* log_dt = X.in[16];
        const float* b_re = X.in[17]; const float* b_im = X.in[18]; const float* c_re = X.in[19]; const float* c_im = X.in[20];
        if (tid < 128) {
            const int d = tid >> 6, p = tid & 63;
            const double dt = exp((double)log_dt[(l * 2 + d) * 64 + g]);
            const double lr = (double)lam_re[((l * 2 + d) * 64 + g) * 64 + p], li = (double)lam_im[((l * 2 + d) * 64 + g) * 64 + p];
            const double ar = lr * dt, ai = li * dt, mag = exp(ar);
            const double abr = mag * cos(ai), abi = mag * sin(ai);
            const double nr = abr - 1.0, ni = abi, den = lr * lr + li * li;
            const double cr = (nr * lr + ni * li) / den, ci = (ni * lr - nr * li) / den;
            double zr = 1.0, zi = 0.0;
            for (int n = 0; n <= 32; ++n) { PW[((d * 64 + p) * 33 + n) * 2] = (float)zr; PW[((d * 64 + p) * 33 + n) * 2 + 1] = (float)zi;
                const double t = zr * abr - zi * abi; zi = zr * abi + zi * abr; zr = t; }
            for (int c = 0; c < 16; ++c) { const double br = (double)b_re[((l * 64 + g) * 64 + p) * 16 + c], bi = (double)b_im[((l * 64 + g) * 64 + p) * 16 + c];
                Bp[((d * 64 + p) * 16 + c) * 2] = (float)(cr * br - ci * bi); Bp[((d * 64 + p) * 16 + c) * 2 + 1] = (float)(cr * bi + ci * br); }
        }
        for (int i = tid; i < 1024; i += 512) { Cc[2 * i] = c_re[(size_t)(l * 64 + g) * 1024 + i]; Cc[2 * i + 1] = c_im[(size_t)(l * 64 + g) * 1024 + i]; }
        __syncthreads();
        if (hf == 0 && tid < 128) { const int d = tid >> 6, p = tid & 63; float* abt = (float*)(X.ws + WS_ABT);
            abt[((d * 64 + g) * 64 + p) * 2] = PW[((d * 64 + p) * 33 + 32) * 2]; abt[((d * 64 + g) * 64 + p) * 2 + 1] = PW[((d * 64 + p) * 33 + 32) * 2 + 1]; }
        for (int o = tid; o < 1024; o += 512) { const int d = o >> 9, n = (o >> 4) & 31, c = o & 15; float a[16];
#pragma unroll
            for (int q = 0; q < 16; ++q) a[q] = 0.f;
            for (int p = 0; p < 64; ++p) { const f32x2 C2 = *(const f32x2*)(Cc + (c * 64 + p) * 2), P2 = *(const f32x2*)(PW + ((d * 64 + p) * 33 + n) * 2);
                const float Wr = C2[0] * P2[0] - C2[1] * P2[1], Wi = C2[0] * P2[1] + C2[1] * P2[0];
                const f32x4* bp = (const f32x4*)(Bp + ((d * 64 + p) * 16) * 2);
#pragma unroll
                for (int q = 0; q < 8; ++q) { const f32x4 b = bp[q]; a[2 * q] += Wr * b[0] - Wi * b[1]; a[2 * q + 1] += Wr * b[2] - Wi * b[3]; } }
#pragma unroll
            for (int q = 0; q < 4; ++q) *(f32x4*)(KL + (d * 32 + n) * 256 + c * 16 + 4 * q) = (f32x4){a[4 * q], a[4 * q + 1], a[4 * q + 2], a[4 * q + 3]}; }
        __syncthreads();
        bf16_t* BTY = (bf16_t*)(X.ws + WS_BTY); bf16_t* BTE = (bf16_t*)(X.ws + WS_BTE);
        for (int seg = tid; seg < 256 * 64; seg += 512) { const int nidx = 256 * hf + (seg >> 6), ks = seg & 63, t = nidx >> 4, c = nidx & 15, ta = ks >> 1, cp0 = (ks & 1) * 8; float v[8];
#pragma unroll
            for (int e = 0; e < 8; ++e) { float val = 0.f;
                if (t >= ta) val += KL[((t - ta)) * 256 + c * 16 + cp0 + e];
                if (t <= ta) val += KL[(32 + (ta - t)) * 256 + c * 16 + cp0 + e];
                v[e] = val; }
            u32x4 w; w.x = cvt_pk_bf16(v[0], v[1]); w.y = cvt_pk_bf16(v[2], v[3]); w.z = cvt_pk_bf16(v[4], v[5]); w.w = cvt_pk_bf16(v[6], v[7]);
            *(u32x4*)(BTY + ((size_t)(g * 512 + nidx)) * 768 + ks * 8) = w; }
        for (int seg = tid; seg < 256 * 32; seg += 512) { const int nidx = 256 * hf + (seg >> 5), ks = seg & 31, t = nidx >> 4, c = nidx & 15, d = ks >> 4, p0 = (ks & 15) * 4, ex = d == 0 ? t + 1 : 32 - t; float v[8];
#pragma unroll
            for (int e = 0; e < 4; ++e) { const int p = p0 + e; const float Cr = Cc[(c * 64 + p) * 2], Ci = Cc[(c * 64 + p) * 2 + 1], Pr = PW[((d * 64 + p) * 33 + ex) * 2], Pi = PW[((d * 64 + p) * 33 + ex) * 2 + 1];
                v[2 * e] = Cr * Pr - Ci * Pi; v[2 * e + 1] = -(Cr * Pi + Ci * Pr); }
            u32x4 w; w.x = cvt_pk_bf16(v[0], v[1]); w.y = cvt_pk_bf16(v[2], v[3]); w.z = cvt_pk_bf16(v[4], v[5]); w.w = cvt_pk_bf16(v[6], v[7]);
            *(u32x4*)(BTY + ((size_t)(g * 512 + nidx)) * 768 + 512 + ks * 8) = w; }
        for (int seg = tid; seg < 128 * 64; seg += 512) { const int er = 128 * hf + (seg >> 6), ks = seg & 63, d = er >> 7, p = (er & 127) >> 1, ri = er & 1; float v[8];
#pragma unroll
            for (int e = 0; e < 8; ++e) { const int kidx = ks * 8 + e, ta = kidx >> 4, cp = kidx & 15, ex = d == 0 ? 31 - ta : ta;
                const float Pr = PW[((d * 64 + p) * 33 + ex) * 2], Pi = PW[((d * 64 + p) * 33 + ex) * 2 + 1], Br = Bp[((d * 64 + p) * 16 + cp) * 2], Bi = Bp[((d * 64 + p) * 16 + cp) * 2 + 1];
                v[e] = ri ? (Pr * Bi + Pi * Br) : (Pr * Br - Pi * Bi); }
            u32x4 w; w.x = cvt_pk_bf16(v[0], v[1]); w.y = cvt_pk_bf16(v[2], v[3]); w.z = cvt_pk_bf16(v[4], v[5]); w.w = cvt_pk_bf16(v[6], v[7]);
            *(u32x4*)(BTE + ((size_t)(g * 256 + er)) * 512 + ks * 8) = w; }
        __syncthreads();
      } else {
        const int mi = it - 128, ml = mi / 192, cb = mi - ml * 192;
        float* sv = L; float* part = L + 6144;
        const float* cc = X.in[8]; const float* cctx = X.in[9]; const float* ada_w = X.in[10]; const float* ada_b = X.in[11];
        for (int i = tid; i < 6144; i += 512) { const int cv = i >> 11, k = i & 2047; const float x = cv == 0 ? cctx[k] : cc[(cv - 1) * 2048 + k]; sv[i] = x / (1.f + expf(-x)); }
        __syncthreads();
        const int ks = tid >> 4, c4 = (tid & 15) * 4; f32x4 a0 = (f32x4){0.f, 0.f, 0.f, 0.f}, a1 = a0, a2 = a0;
        const float* wp = ada_w + ((size_t)ml * 2048 + ks * 64) * NMOD + cb * 64 + c4;
#pragma unroll 8
        for (int k = 0; k < 64; ++k) { const f32x4 w = *(const f32x4*)(wp + (size_t)k * NMOD); a0 += w * sv[ks * 64 + k]; a1 += w * sv[2048 + ks * 64 + k]; a2 += w * sv[4096 + ks * 64 + k]; }
        *(f32x4*)(part + (ks * 3 + 0) * 64 + c4) = a0; *(f32x4*)(part + (ks * 3 + 1) * 64 + c4) = a1; *(f32x4*)(part + (ks * 3 + 2) * 64 + c4) = a2;
        __syncthreads();
        if (tid < 192) { const int cv = tid >> 6, c2 = tid & 63; float s2 = ada_b[ml * NMOD + cb * 64 + c2];
            for (int k2 = 0; k2 < 32; ++k2) s2 += part[(k2 * 3 + cv) * 64 + c2];
            ((float*)(X.ws + WS_MODS))[(size_t)(ml * 3 + cv) * NMOD + cb * 64 + c2] = s2; }
        __syncthreads();
      }
    }
    {
        float* scr = (float*)(X.lds + wave * 16384);
        unsigned* ctr = (unsigned*)(X.ws + WS_CTL) + 16 + 64 * l;
        for (;;) {
            unsigned base = 0u; if (lane == 0) base = __hip_atomic_fetch_add(ctr, 8u, __ATOMIC_RELAXED, __HIP_MEMORY_SCOPE_AGENT);
            base = __builtin_amdgcn_readfirstlane(base);
            if (base >= (unsigned)TNIT) break;
            const int i0 = (int)base, i1 = (i0 + 8 < TNIT) ? i0 + 8 : TNIT;
            f32x4 va[8], vb[8]; TrItem ta = tr_decode(X, l, i0), tb = ta; tr_load(ta, lane, va);
            for (int it = i0; it < i1; it += 2) {
                if (it + 1 < i1) { tb = tr_decode(X, l, it + 1); tr_load(tb, lane, vb); }
                tr_store(ta, lane, va, scr);
                if (it + 1 < i1) { if (it + 2 < i1) { ta = tr_decode(X, l, it + 2); tr_load(ta, lane, va); } tr_store(tb, lane, vb, scr); }
            }
        }
        __syncthreads();
    }
    {
        const size_t gt = (size_t)X.bid * 512 + tid, NT = (size_t)X.G * 512;
        bf16_t* WIN = (bf16_t*)(X.ws + WS_WIN);
        for (size_t i = gt; i < (size_t)192 * 2048 / 8; i += NT) *(u32x4*)(WIN + (size_t)NP2REAL * 2048 + i * 8) = (u32x4){0u, 0u, 0u, 0u};
        bf16_t* CKV = (bf16_t*)(X.ws + WS_CKV); bf16_t* KR = (bf16_t*)(X.ws + WS_KR);
        const float* cck = X.in[2]; const float* ckr = X.in[3];
        for (size_t i = gt; i < (size_t)512 * 512; i += NT) { const int rr = (int)(i >> 9), c = (int)(i & 511), b = rr >> 8, t = rr & 255;
            CKV[(size_t)(M + rr) * 512 + c] = f2bf(cck[((size_t)(b * 2 + l) * 256 + t) * 512 + c]); }
        for (size_t i = gt; i < (size_t)512 * 64; i += NT) { const int rr = (int)(i >> 6), c = (int)(i & 63), b = rr >> 8, t = rr & 255;
            KR[(size_t)(M + rr) * 64 + c] = f2bf(ckr[((size_t)(b * 2 + l) * 256 + t) * 64 + c]); }
        if (l == 0) {
            float* rope = (float*)(X.ws + WS_ROPE);
            for (size_t i = gt; i < (size_t)4096 * 32; i += NT) { const int pos = (int)(i >> 5), j = (int)(i & 31);
                const double inv = exp2(-(double)(j & 15) / 16.0 * 13.287712379549449), ang = (double)(j < 16 ? (pos >> 6) : (pos & 63)) * inv;
                rope[i * 2] = (float)cos(ang); rope[i * 2 + 1] = (float)sin(ang); }
        }
    }
}

template <int MODE> __device__ __forceinline__ void phase_norm(const Ctx& X, int l, const bf16_t* src) {
    int tid = threadIdx.x; asm volatile("" : "+v"(tid)); const int lane = tid & 63, wave = __builtin_amdgcn_readfirstlane(tid >> 6); (void)lane; (void)wave;
    const int gw = X.bid * 8 + wave, NGW = X.G * 8;
    const float* ng = X.in[12] + (size_t)l * 4 * DM; bf16_t* H = (bf16_t*)(X.ws + WS_H);
#pragma unroll 2
    for (int r = gw; r < M; r += NGW) {
        const int cv = r < MPR ? 0 : 1 + ((r - MPR) >> 12);
        const float* mb = (const float*)(X.ws + WS_MODS) + (size_t)(l * 3 + cv) * NMOD;
        float* xr = X.out + (size_t)r * DM;
        const float* xs = (l == 0) ? (r < MPR ? X.in[0] + (size_t)r * DM : X.in[1] + (size_t)(r - MPR) * DM) : xr;
        f32x4 v[8];
        if (MODE == 0) {
            float ss = 0.f;
#pragma unroll
            for (int j = 0; j < 8; ++j) { v[j] = *(const f32x4*)(xs + j * 256 + lane * 4); ss += v[j][0] * v[j][0] + v[j][1] * v[j][1] + v[j][2] * v[j][2] + v[j][3] * v[j][3]; }
            const float rs = rsqrtf(wave_sum(ss) * (1.f / DM) + EPS);
#pragma unroll
            for (int j = 0; j < 8; ++j) { const int c = j * 256 + lane * 4; const f32x4 g = *(const f32x4*)(ng + c), sc = *(const f32x4*)(mb + 2048 + c), sh = *(const f32x4*)(mb + c);
                f32x4 h; for (int e = 0; e < 4; ++e) h[e] = v[j][e] * rs * g[e] * (1.f + sc[e]) + sh[e];
                u32x2 w; w.x = cvt_pk_bf16(h[0], h[1]); w.y = cvt_pk_bf16(h[2], h[3]); *(u32x2*)(H + (size_t)r * DM + c) = w; }
        } else {
            const bf16_t* sr = src + (size_t)r * DM; float ss = 0.f;
#pragma unroll
            for (int j = 0; j < 8; ++j) { const u32x2 w = *(const u32x2*)(sr + j * 256 + lane * 4); v[j] = (f32x4){bflo(w.x), bfhi(w.x), bflo(w.y), bfhi(w.y)}; }
            f32x4 xv[8];
#pragma unroll
            for (int j = 0; j < 8; ++j) xv[j] = __builtin_nontemporal_load((const f32x4*)(xs + j * 256 + lane * 4));
#pragma unroll
            for (int j = 0; j < 8; ++j) ss += v[j][0] * v[j][0] + v[j][1] * v[j][1] + v[j][2] * v[j][2] + v[j][3] * v[j][3];
            const float rs = rsqrtf(wave_sum(ss) * (1.f / DM) + EPS);
            const float* ngp = ng + (MODE == 1 ? 1 : 3) * DM; const float* gp = mb + (MODE == 1 ? 2 : 5) * 2048;
            float* R1 = (float*)(X.ws + WS_R1);
            if (MODE == 1) { if (lane == 0) R1[r] = rs; }
            if (MODE == 2) {
                const bf16_t* mr = (const bf16_t*)(X.ws + WS_MO) + (size_t)r * DM; const float r1 = R1[r];
#pragma unroll
                for (int j = 0; j < 8; ++j) { const int c = j * 256 + lane * 4; const u32x2 w = *(const u32x2*)(mr + c); const f32x4 g = *(const f32x4*)(ng + DM + c), gt = *(const f32x4*)(mb + 2 * 2048 + c);
                    xv[j][0] += gt[0] * (bflo(w.x) * r1 * g[0]); xv[j][1] += gt[1] * (bfhi(w.x) * r1 * g[1]); xv[j][2] += gt[2] * (bflo(w.y) * r1 * g[2]); xv[j][3] += gt[3] * (bfhi(w.y) * r1 * g[3]); } }
            float s2 = 0.f;
#pragma unroll
            for (int j = 0; j < 8; ++j) { const int c = j * 256 + lane * 4; const f32x4 g = *(const f32x4*)(ngp + c), gt = *(const f32x4*)(gp + c), x0 = xv[j];
                for (int e = 0; e < 4; ++e) v[j][e] = x0[e] + gt[e] * (v[j][e] * rs * g[e]);
                if (MODE == 2) __builtin_nontemporal_store(v[j], (f32x4*)(xr + c));
                s2 += v[j][0] * v[j][0] + v[j][1] * v[j][1] + v[j][2] * v[j][2] + v[j][3] * v[j][3]; }
            if (MODE == 2 && l == 0) {
                const float r2 = rsqrtf(wave_sum(s2) * (1.f / DM) + EPS); const float* mb1 = mb + 3 * NMOD; const float* ng1 = ng + 4 * DM;
#pragma unroll
                for (int j = 0; j < 8; ++j) { const int c = j * 256 + lane * 4; const f32x4 g = *(const f32x4*)(ng1 + c), sc = *(const f32x4*)(mb1 + 2048 + c), sh = *(const f32x4*)(mb1 + c);
                    f32x4 h; for (int e = 0; e < 4; ++e) h[e] = v[j][e] * r2 * g[e] * (1.f + sc[e]) + sh[e];
                    u32x2 w; w.x = cvt_pk_bf16(h[0], h[1]); w.y = cvt_pk_bf16(h[2], h[3]); *(u32x2*)(H + (size_t)r * DM + c) = w; }
            }
            if (MODE == 1) {
                const float r2 = rsqrtf(wave_sum(s2) * (1.f / DM) + EPS);
#pragma unroll
                for (int j = 0; j < 8; ++j) { const int c = j * 256 + lane * 4; const f32x4 g = *(const f32x4*)(ng + 2 * DM + c), sc = *(const f32x4*)(mb + 4 * 2048 + c), sh = *(const f32x4*)(mb + 3 * 2048 + c);
                    f32x4 h; for (int e = 0; e < 4; ++e) h[e] = v[j][e] * r2 * g[e] * (1.f + sc[e]) + sh[e];
                    u32x2 w; w.x = cvt_pk_bf16(h[0], h[1]); w.y = cvt_pk_bf16(h[2], h[3]); *(u32x2*)(H + (size_t)r * DM + c) = w; }
            }
        }
    }
}

__device__ __forceinline__ void phase_mla_norm(const Ctx& X, int l) {
    int tid = threadIdx.x; asm volatile("" : "+v"(tid)); const int lane = tid & 63, wave = __builtin_amdgcn_readfirstlane(tid >> 6); (void)lane; (void)wave;
    const int gw = X.bid * 8 + wave, NGW = X.G * 8;
    bf16_t* CQ = (bf16_t*)(X.ws + WS_CQ); bf16_t* CKV = (bf16_t*)(X.ws + WS_CKV); bf16_t* KR = (bf16_t*)(X.ws + WS_KR);
    const float* gq = X.in[26] + l * 768; const float* gkv = X.in[27] + l * 512; const float* rope = (const float*)(X.ws + WS_ROPE);
    const bool evenG = (X.G & 1) == 0, lowh = X.bid < X.G / 2; const int RA = evenG ? 5632 : 0;
    const int r_lo = evenG ? (lowh ? 0 : RA) : 0, r_hi = evenG ? (lowh ? RA : M) : M, wi = evenG ? (lowh ? X.bid : X.bid - X.G / 2) * 8 + wave : gw, NW = evenG ? (X.G / 2) * 8 : NGW;
#pragma unroll 2
    for (int r = r_lo + wi; r < r_hi; r += NW) {
        {
            u32x2 w[3]; float ss = 0.f;
#pragma unroll
            for (int j = 0; j < 3; ++j) { w[j] = *(const u32x2*)(CQ + (size_t)r * 768 + (j * 64 + lane) * 4); const float a = bflo(w[j].x), b = bfhi(w[j].x), c = bflo(w[j].y), d = bfhi(w[j].y); ss += a * a + b * b + c * c + d * d; }
            const float rs = rsqrtf(wave_sum(ss) * (1.f / 768.f) + EPS);
#pragma unroll
            for (int j = 0; j < 3; ++j) { const int c0 = (j * 64 + lane) * 4; const f32x4 g = *(const f32x4*)(gq + c0);
                u32x2 o; o.x = cvt_pk_bf16(bflo(w[j].x) * rs * g[0], bfhi(w[j].x) * rs * g[1]); o.y = cvt_pk_bf16(bflo(w[j].y) * rs * g[2], bfhi(w[j].y) * rs * g[3]);
                *(u32x2*)(CQ + (size_t)r * 768 + c0) = o; }
        }
        {
            const u32x4 w = *(const u32x4*)(CKV + (size_t)r * 512 + lane * 8);
            float x[8] = {bflo(w.x), bfhi(w.x), bflo(w.y), bfhi(w.y), bflo(w.z), bfhi(w.z), bflo(w.w), bfhi(w.w)}; float ss = 0.f;
#pragma unroll
            for (int e = 0; e < 8; ++e) ss += x[e] * x[e];
            const float rs = rsqrtf(wave_sum(ss) * (1.f / 512.f) + EPS);
            const f32x4 g0 = *(const f32x4*)(gkv + lane * 8), g1 = *(const f32x4*)(gkv + lane * 8 + 4);
#pragma unroll
            for (int e = 0; e < 4; ++e) { x[e] = x[e] * rs * g0[e]; x[4 + e] = x[4 + e] * rs * g1[e]; }
            u32x4 o; o.x = cvt_pk_bf16(x[0], x[1]); o.y = cvt_pk_bf16(x[2], x[3]); o.z = cvt_pk_bf16(x[4], x[5]); o.w = cvt_pk_bf16(x[6], x[7]);
            *(u32x4*)(CKV + (size_t)r * 512 + lane * 8) = o;
            if (r < MPR) { const int b = r >> 8, t = r & 255; float* op = X.out + O_CKV + ((size_t)(b * 2 + l) * 256 + t) * 512 + lane * 8;
                *(f32x4*)op = (f32x4){x[0], x[1], x[2], x[3]}; *(f32x4*)(op + 4) = (f32x4){x[4], x[5], x[6], x[7]}; }
        }
        {
            const float v = bf2f(KR[(size_t)r * 64 + lane]);
            if (r < MPR) { const int b = r >> 8, t = r & 255; X.out[O_KR + ((size_t)(b * 2 + l) * 256 + t) * 64 + lane] = v; }
            else { const int pos = (r - MPR) & 4095, i = lane >> 1; const float cs = rope[((size_t)pos * 32 + i) * 2], sn = rope[((size_t)pos * 32 + i) * 2 + 1];
                const float pv = __shfl_xor(v, 1); const float o = (lane & 1) ? (pv * sn + v * cs) : (v * cs - pv * sn);
                KR[(size_t)r * 64 + lane] = f2bf(o); }
        }
    }
}

constexpr int RLD = 136;
constexpr float RET_SC = 0.08838834764831845f;
typedef float f32x4v __attribute__((ext_vector_type(4)));
__device__ __forceinline__ void ret_stage_T(const bf16_t* src, int ld, bf16_t* dstT, int mode, float lg, int tid) {
#pragma unroll
    for (int it = 0; it < 4; ++it) { const int seg = tid + it * 512, t = seg >> 4, s = seg & 15;
        const u32x4 w = *(const u32x4*)(src + (size_t)t * ld + s * 8);
        const float sc = mode == 0 ? 1.f : RET_SC * exp2f(lg * (float)(mode == 1 ? 127 - t : t));
        bf16_t* d = dstT + (s * 8) * RLD + t;
        d[0 * RLD] = f2bf(bflo(w.x) * sc); d[1 * RLD] = f2bf(bfhi(w.x) * sc); d[2 * RLD] = f2bf(bflo(w.y) * sc); d[3 * RLD] = f2bf(bfhi(w.y) * sc);
        d[4 * RLD] = f2bf(bflo(w.z) * sc); d[5 * RLD] = f2bf(bfhi(w.z) * sc); d[6 * RLD] = f2bf(bflo(w.w) * sc); d[7 * RLD] = f2bf(bfhi(w.w) * sc); }
}
__device__ __forceinline__ float ret_lg(const Ctx& X, int l, int d, int h) { return -expf(X.in[24][(l * 2 + d) * 8 + h]) * 1.4426950408889634f; }

__device__ __forceinline__ void phase_ret_prefix(const Ctx& X, int l) {
    int tid = threadIdx.x; asm volatile("" : "+v"(tid));
    const bf16_t* LR = (const bf16_t*)(X.ws + WS_LRET); bf16_t* SR = (bf16_t*)(X.ws + WS_SRET);
    constexpr int WS_ = 2 * 8 * 2 * 128 * 32, WP_ = 32 * 8 * 2 * 128 * 32;
    for (int id = X.bid * 512 + tid; id < WS_; id += X.G * 512) {
        const int dk4 = id & 31, dv = (id >> 5) & 127, d = (id >> 12) & 1, h = (id >> 13) & 7, s = id >> 16, c0 = 64 + 32 * s;
        const float g128 = exp2f(ret_lg(X, l, d, h) * 128.f);
        f32x4 S; { const float* s0 = X.in[d ? 5 : 4] + ((size_t)(s * 2 + l) * 8 + h) * 16384;
#pragma unroll
            for (int e = 0; e < 4; ++e) S[e] = s0[(size_t)(dk4 * 4 + e) * 128 + dv]; }
#define PFX_LD(LV, J0) do { _Pragma("unroll") for (int q = 0; q < 8; ++q) { const int ci = c0 + (d ? 31 - ((J0) + q) : (J0) + q); LV[q] = *(const u32x2*)(LR + ((size_t)((ci * 8 + h) * 2 + d) * 128 + dv) * 128 + dk4 * 4); } \
            __builtin_amdgcn_sched_barrier(0); } while (0)
#define PFX_RUN(LV, J0) do { _Pragma("unroll") for (int q = 0; q < 8; ++q) { const int ci = c0 + (d ? 31 - ((J0) + q) : (J0) + q); const size_t o = ((size_t)((ci * 8 + h) * 2 + d) * 128 + dv) * 128 + dk4 * 4; \
                u32x2 w; w.x = cvt_pk_bf16(S[0], S[1]); w.y = cvt_pk_bf16(S[2], S[3]); *(u32x2*)(SR + o) = w; S = S * g128 + (f32x4){bflo(LV[q].x), bfhi(LV[q].x), bflo(LV[q].y), bfhi(LV[q].y)}; } } while (0)
        { u32x2 La[8], Lb[8];
          PFX_LD(La, 0); PFX_LD(Lb, 8); PFX_RUN(La, 0); PFX_LD(La, 16); PFX_RUN(Lb, 8); PFX_LD(Lb, 24); PFX_RUN(La, 16); PFX_RUN(Lb, 24); }
#undef PFX_LD
#undef PFX_RUN
    }
    const bool evenG2 = (X.G & 1) == 0, lowh2 = X.bid < X.G / 2; constexpr int PA = WP_ / 32 * 9;
    const int p_lo = evenG2 ? (lowh2 ? 0 : PA) : 0, p_hi = evenG2 ? (lowh2 ? PA : WP_) : WP_, pt = evenG2 ? (lowh2 ? X.bid : X.bid - X.G / 2) * 512 + tid : X.bid * 512 + tid, PS = evenG2 ? (X.G / 2) * 512 : X.G * 512;
    for (int id = p_lo + pt; id < p_hi; id += PS) {
        const int dk4 = id & 31, dv = (id >> 5) & 127, d = (id >> 12) & 1, h = (id >> 13) & 7, s = id >> 16;
        const float g128 = exp2f(ret_lg(X, l, d, h) * 128.f);
        const int cA = 2 * s + (d ? 1 : 0), cB = 2 * s + (d ? 0 : 1);
        const size_t oA = ((size_t)((cA * 8 + h) * 2 + d) * 128 + dv) * 128 + dk4 * 4, oB = ((size_t)((cB * 8 + h) * 2 + d) * 128 + dv) * 128 + dk4 * 4;
        const u32x2 wA = *(const u32x2*)(LR + oA), wB = *(const u32x2*)(LR + oB);
        const f32x4 LA = (f32x4){bflo(wA.x), bfhi(wA.x), bflo(wA.y), bfhi(wA.y)}, LB = (f32x4){bflo(wB.x), bfhi(wB.x), bflo(wB.y), bfhi(wB.y)};
        *(u32x2*)(SR + oA) = (u32x2){0u, 0u};
        *(u32x2*)(SR + oB) = wA;
        const f32x4 S = LA * g128 + LB;
        float* op = X.out + (d ? O_RB : O_RF) + ((size_t)(s * 2 + l) * 8 + h) * 16384;
#pragma unroll
        for (int e = 0; e < 4; ++e) op[(size_t)(dk4 * 4 + e) * 128 + dv] = S[e];
    }
}
__device__ __forceinline__ bf16x8 scale_frag(bf16x8 q, float s) {
    const u32x4 w = __builtin_bit_cast(u32x4, q); u32x4 o;
    o.x = cvt_pk_bf16(bflo(w.x) * s, bfhi(w.x) * s); o.y = cvt_pk_bf16(bflo(w.y) * s, bfhi(w.y) * s); o.z = cvt_pk_bf16(bflo(w.z) * s, bfhi(w.z) * s); o.w = cvt_pk_bf16(bflo(w.w) * s, bfhi(w.w) * s);
    return __builtin_bit_cast(bf16x8, o);
}
__device__ __forceinline__ void phase_s5_carry(const Ctx& X, int l) {
    int tid = threadIdx.x; asm volatile("" : "+v"(tid)); const int lane = tid & 63, wave = __builtin_amdgcn_readfirstlane(tid >> 6);
    const int gw = wave * X.G + X.bid, NGW = X.G * 8, p = lane;
    const float* EL = (const float*)(X.ws + WS_ELOC); bf16_t* UG = (bf16_t*)(X.ws + WS_UG); const float* abt = (const float*)(X.ws + WS_ABT);
    for (int it = gw; it < 34 * 128; it += NGW) {
        const int d = it & 1, g = (it >> 1) & 63, sq = it >> 7;
        const bool smp = sq < 2; const int s = smp ? sq : sq - 2, nc = smp ? 128 : 8, c0 = smp ? 256 + 128 * s : 8 * s;
        const float ar = abt[((d * 64 + g) * 64 + p) * 2], ai = abt[((d * 64 + g) * 64 + p) * 2 + 1];
        float sr = 0.f, si = 0.f;
        if (smp) { const float* s0 = X.in[d ? 7 : 6] + (((size_t)(s * 2 + l) * 64 + g) * 64 + p) * 2; sr = s0[0]; si = s0[1]; }
#define CARRY_LD(EV, J0, NB) do { _Pragma("unroll") for (int q = 0; q < (NB); ++q) { const int ch = c0 + (d ? nc - 1 - ((J0) + q) : (J0) + q); EV[q] = *(const f32x2*)(EL + (size_t)(g * 512 + ch) * 256 + d * 128 + 2 * p); } \
            __builtin_amdgcn_sched_barrier(0); } while (0)
#define CARRY_RUN(EV, J0, NB) do { _Pragma("unroll") for (int q = 0; q < (NB); ++q) { const int ch = c0 + (d ? nc - 1 - ((J0) + q) : (J0) + q); \
                *(unsigned*)(UG + (size_t)(g * 512 + ch) * 768 + 512 + d * 128 + 2 * p) = cvt_pk_bf16(sr, si); \
                const float tr = ar * sr - ai * si + EV[q][0]; si = ar * si + ai * sr + EV[q][1]; sr = tr; } } while (0)
        if (smp) {
            f32x2 ea[16], eb[16];
            CARRY_LD(ea, 0, 16);
            for (int jb = 0; jb < 128; jb += 32) {
                CARRY_LD(eb, jb + 16, 16); CARRY_RUN(ea, jb, 16);
                if (jb + 32 < 128) CARRY_LD(ea, jb + 32, 16);
                CARRY_RUN(eb, jb + 16, 16); }
        } else { f32x2 ev[8]; CARRY_LD(ev, 0, 8); CARRY_RUN(ev, 0, 8); }
#undef CARRY_LD
#undef CARRY_RUN
        if (!smp) { float* op = X.out + (d ? O_SB : O_SF) + (((size_t)(s * 2 + l) * 64 + g) * 64 + p) * 2; op[0] = sr; op[1] = si; }
    }
}

__device__ __forceinline__ void phase_convfix(const Ctx& X, int l) {
    int tid = threadIdx.x; asm volatile("" : "+v"(tid));
    const float* HALO = (const float*)(X.ws + WS_HALO); bf16_t* AF = (bf16_t*)(X.ws + WS_AF);
    const float* cw = X.in[34] + (size_t)l * 3 * DFF2; const float* cb = X.in[35] + (size_t)l * DFF2;
    for (int idx = X.bid * 512 + tid; idx < 32 * 2 * 1408; idx += X.G * 512) {
        const int cq = idx % 1408, wrw = (idx / 1408) & 1, pm = 32 + idx / 2816, ts = pm & 15, ch = cq * 4;
        if ((wrw == 0 && ts == 0) || (wrw == 1 && ts == 15)) continue;
        const int hc = (ch >> 7) * 256 + (ch & 127);
        const float* pu = HALO + (size_t)(wrw == 0 ? (pm - 1) * 4 + 3 : pm * 4 + 2) * DFF2 + hc;
        const float* pc = HALO + (size_t)(wrw == 0 ? pm * 4 + 0 : pm * 4 + 3) * DFF2 + hc;
        const float* pd = HALO + (size_t)(wrw == 0 ? pm * 4 + 1 : (pm + 1) * 4 + 0) * DFF2 + hc;
        f32x4 res[2];
#pragma unroll
        for (int part = 0; part < 2; ++part) { const int cc = ch + part * DFF;
            const f32x4 a = *(const f32x4*)(pu + part * 128), b = *(const f32x4*)(pc + part * 128), c = *(const f32x4*)(pd + part * 128);
            const f32x4 w0 = *(const f32x4*)(cw + cc), w1 = *(const f32x4*)(cw + DFF2 + cc), w2 = *(const f32x4*)(cw + 2 * DFF2 + cc), bb = *(const f32x4*)(cb + cc);
            res[part] = w0 * a + w1 * b + w2 * c + bb; }
        const int r = pm * 256 + (wrw ? 255 : 0);
        u32x2 w; w.x = cvt_pk_bf16(res[1][0] * sigm(res[1][0]) * res[0][0], res[1][1] * sigm(res[1][1]) * res[0][1]); w.y = cvt_pk_bf16(res[1][2] * sigm(res[1][2]) * res[0][2], res[1][3] * sigm(res[1][3]) * res[0][3]);
        *(u32x2*)(AF + (size_t)r * DFF + ch) = w;
    }
}

namespace att {
using s16x4  = __attribute__((ext_vector_type(4))) short;
using f32x16 = __attribute__((ext_vector_type(16))) float;
constexpr float SCALE = 0.07216878364870322f, THR = 8.f;
constexpr int K_BYTES = 64 * 400, V_BYTES = 64 * 256;
#define KSW(row, colB) ((row) * 400 + (colB))
#define SBAR() __builtin_amdgcn_sched_barrier(0)
__device__ __forceinline__ int crow(int r, int hi) { return (r & 3) + 8 * (r >> 2) + 4 * hi; }
__device__ __forceinline__ void partialSM(f32x16& p0, f32x16& p1, float& m_reg, float& mn, float& alpha) {
  constexpr float C = SCALE * 1.4426950408889634f;
  float pmax = p0[0];
#pragma unroll
  for (int r = 1; r < 16; ++r) pmax = fmaxf(pmax, p0[r]);
#pragma unroll
  for (int r = 0; r < 16; ++r) pmax = fmaxf(pmax, p1[r]);
  { auto rr = __builtin_amdgcn_permlane32_swap(__float_as_uint(pmax), __float_as_uint(pmax), false, false);
    pmax = fmaxf(__uint_as_float(rr[0]), __uint_as_float(rr[1])); }
  if (__builtin_expect(__all(pmax - m_reg <= THR / SCALE), 1)) { mn = m_reg; alpha = 1.f; }
  else { mn = fmaxf(m_reg, pmax); alpha = __builtin_amdgcn_exp2f((m_reg - mn) * C); m_reg = mn; }
  const float mnC = -mn * C;
#pragma unroll
  for (int r = 0; r < 16; ++r) p0[r] = __builtin_amdgcn_exp2f(fmaf(p0[r], C, mnC));
#pragma unroll
  for (int r = 0; r < 16; ++r) p1[r] = __builtin_amdgcn_exp2f(fmaf(p1[r], C, mnC));
}
__device__ __forceinline__ void sm_max(const f32x16& p0, const f32x16& p1, float& m_reg, float& mnC, float& alpha) {
  constexpr float C = SCALE * 1.4426950408889634f;
  float pmax = p0[0];
#pragma unroll
  for (int r = 1; r < 16; ++r) pmax = fmaxf(pmax, p0[r]);
#pragma unroll
  for (int r = 0; r < 16; ++r) pmax = fmaxf(pmax, p1[r]);
  { auto rr = __builtin_amdgcn_permlane32_swap(__float_as_uint(pmax), __float_as_uint(pmax), false, false);
    pmax = fmaxf(__uint_as_float(rr[0]), __uint_as_float(rr[1])); }
  float mn;
  if (__builtin_expect(__all(pmax - m_reg <= THR / SCALE), 1)) { mn = m_reg; alpha = 1.f; }
  else { mn = fmaxf(m_reg, pmax); alpha = __builtin_amdgcn_exp2f((m_reg - mn) * C); m_reg = mn; }
  mnC = -mn * C;
}
template <int BASE> __device__ __forceinline__ void sm_exp8(f32x16& p, float mnC) {
  constexpr float C = SCALE * 1.4426950408889634f;
#pragma unroll
  for (int r = BASE; r < BASE + 8; ++r) p[r] = __builtin_amdgcn_exp2f(fmaf(p[r], C, mnC));
#pragma unroll
  for (int r = BASE; r < BASE + 8; ++r) { float t = p[r]; asm volatile("" : "+v"(t)); p[r] = t; }
}
__device__ __forceinline__ void finishSM(f32x16& p0, f32x16& p1, float alpha, float& l_reg, bf16x8& pa0, bf16x8& pa1, bf16x8& pa2, bf16x8& pa3) {
  float ps = 0;
#pragma unroll
  for (int r = 0; r < 16; ++r) ps += p0[r];
#pragma unroll
  for (int r = 0; r < 16; ++r) ps += p1[r];
  { auto rr = __builtin_amdgcn_permlane32_swap(__float_as_uint(ps), __float_as_uint(ps), false, false);
    ps = __uint_as_float(rr[0]) + __uint_as_float(rr[1]); }
  l_reg = l_reg * alpha + ps;
#define PK4(P, BASE, OUT) do { unsigned a0 = cvt_pk_bf16(P[BASE + 0], P[BASE + 1]), a1 = cvt_pk_bf16(P[BASE + 2], P[BASE + 3]);   \
    unsigned b0 = cvt_pk_bf16(P[BASE + 4], P[BASE + 5]), b1 = cvt_pk_bf16(P[BASE + 6], P[BASE + 7]);                              \
    auto r0 = __builtin_amdgcn_permlane32_swap(a0, b0, false, false); auto r1 = __builtin_amdgcn_permlane32_swap(a1, b1, false, false); \
    u32x4 w = {r0[0], r1[0], r0[1], r1[1]}; OUT = __builtin_bit_cast(bf16x8, w); } while (0)
  PK4(p0, 0, pa0); PK4(p0, 8, pa1); PK4(p1, 0, pa2); PK4(p1, 8, pa3);
#undef PK4
}
__device__ __forceinline__ int v_st(int k, int c) { const int kk = (k & ~0xC) | ((k & 4) << 1) | ((k & 8) >> 1); return ((kk >> 3) * 4 + (c >> 5)) * 512 + ((kk & 7) * 32 + (c & 31)) * 2; }
__device__ __forceinline__ int v_rd_base(int lane) { return ((lane & 3) << 3) | (((lane >> 2) & 3) << 6) | (((lane >> 4) & 1) << 5) | (((lane >> 5) & 1) << 8); }
constexpr int v_rd_off(int d0, int ks, int half) { return d0 * 512 + ks * 4096 + half * 2048; }
template <int OFF> __device__ __forceinline__ s16x4 tr_read(int vb) {
  s16x4 r; asm volatile("ds_read_b64_tr_b16 %0, %1 offset:%2" : "=&v"(r) : "v"(vb), "i"(OFF) : "memory"); return r;
}
template <int D0> __device__ __forceinline__ void pv_one(f32x16& od, int vb, bf16x8 pa0, bf16x8 pa1, bf16x8 pa2, bf16x8 pa3) {
  const s16x4 l0 = tr_read<v_rd_off(D0, 0, 0)>(vb), h0 = tr_read<v_rd_off(D0, 0, 1)>(vb), l1 = tr_read<v_rd_off(D0, 1, 0)>(vb), h1 = tr_read<v_rd_off(D0, 1, 1)>(vb);
  const s16x4 l2 = tr_read<v_rd_off(D0, 2, 0)>(vb), h2 = tr_read<v_rd_off(D0, 2, 1)>(vb), l3 = tr_read<v_rd_off(D0, 3, 0)>(vb), h3 = tr_read<v_rd_off(D0, 3, 1)>(vb);
  asm volatile("s_waitcnt lgkmcnt(0)" ::: "memory"); SBAR();
#define PK(L, H) (bf16x8){L[0], L[1], L[2], L[3], H[0], H[1], H[2], H[3]}
  od = __builtin_amdgcn_mfma_f32_32x32x16_bf16(pa0, PK(l0, h0), od, 0, 0, 0);
  od = __builtin_amdgcn_mfma_f32_32x32x16_bf16(pa1, PK(l1, h1), od, 0, 0, 0);
  od = __builtin_amdgcn_mfma_f32_32x32x16_bf16(pa2, PK(l2, h2), od, 0, 0, 0);
  od = __builtin_amdgcn_mfma_f32_32x32x16_bf16(pa3, PK(l3, h3), od, 0, 0, 0);
#undef PK
}
__device__ __forceinline__ void attn_unit(const Ctx& X, bool smp, int b, int h, int qb) {
  const bf16_t* QM = (const bf16_t*)(X.ws + WS_QMLA); const bf16_t* KV = (const bf16_t*)(X.ws + WS_KVMLA); const bf16_t* KR = (const bf16_t*)(X.ws + WS_KR);
  bf16_t* YC = (bf16_t*)(X.ws + WS_Y3) + 2048; const float* rope = (const float*)(X.ws + WS_ROPE);
  int tid = threadIdx.x; asm volatile("" : "+v"(tid)); const int lane = tid & 63, wave = __builtin_amdgcn_readfirstlane(tid >> 6); (void)lane; (void)wave;
  const int wid = wave, r32 = lane & 31, hi = lane >> 5;
  constexpr int BUF = K_BYTES + V_BYTES;
  char* K_lds = (char*)X.lds; char* V_lds = (char*)X.lds + K_BYTES;
  float* wsl = (float*)(X.lds + 3 * BUF) + wid * 64; float* li_l = wsl; float* al_l = wsl + 32;
  const int row0 = smp ? MPR + b * 4096 + qb * 256 : b * 256, NT = smp ? 68 : 4;
  float m_reg = -1e30f, l_reg = 0.f; f32x16 o[4] = {}; bf16x8 qr[12];
  const int vb0 = (int)(uintptr_t)V_lds + v_rd_base(lane);
  int rel[6]; bool isr[4];
#pragma unroll
  for (int i = 0; i < 4; ++i) { const int off = (wid + 8 * i) * 1024 + lane * 16, row = off / 400, colB = off - row * 400;
    isr[i] = colB >= 256; rel[i] = isr[i] ? row * 64 + ((colB - 256) >> 1) : row * 2048 + h * 128 + (colB >> 1); }
#pragma unroll
  for (int i = 4; i < 6; ++i) { const int off = (wid + 8 * (i - 4)) * 1024 + lane * 16, st = off >> 9, rem = off & 511, kk = (st >> 2) * 8 + (rem >> 6), cc = (st & 3) * 32 + ((rem & 63) >> 1);
    const int k = (kk & ~0xC) | ((kk & 4) << 1) | ((kk & 8) >> 1); rel[i] = k * 2048 + 1024 + h * 128 + cc; }
#define ATT_DMA(KT, B) do { const int kt_ = (KT); const int kv0 = smp ? (kt_ < 64 ? MPR + b * 4096 + 64 * kt_ : M + b * 256 + 64 * (kt_ - 64)) : b * 256 + 64 * kt_; \
    const bf16_t* kvb = KV + (size_t)kv0 * 2048; const bf16_t* krb = KR + (size_t)kv0 * 64; \
    _Pragma("unroll") for (int i = 0; i < 3; ++i) __builtin_amdgcn_global_load_lds((const unsigned*)(isr[i] ? krb + rel[i] : kvb + rel[i]), (LAS unsigned*)(K_lds + (B) * BUF + (wid + 8 * i) * 1024), 16, 0, 0); \
    if (wid == 0) __builtin_amdgcn_global_load_lds((const unsigned*)(isr[3] ? krb + rel[3] : kvb + rel[3]), (LAS unsigned*)(K_lds + (B) * BUF + 24 * 1024), 16, 0, 0); \
    _Pragma("unroll") for (int i = 4; i < 6; ++i) __builtin_amdgcn_global_load_lds((const unsigned*)(kvb + rel[i]), (LAS unsigned*)(V_lds + (B) * BUF + (wid + 8 * (i - 4)) * 1024), 16, 0, 0); } while (0)
#define ATT_SYNC() do { asm volatile("s_waitcnt vmcnt(0)" ::: "memory"); __syncthreads(); } while (0)
  f32x16 pA0, pA1, pB0, pB1; float alA = 1.f, alB = 1.f, mnx;
#define ATT_QK(BI, P0, P1) do { const char* Kc = K_lds + (BI) * BUF; P0 = f32x16{}; P1 = f32x16{}; \
    _Pragma("unroll") for (int d0 = 0; d0 < 12; ++d0) { const int cb = (d0 * 16 + hi * 8) * 2; \
      const bf16x8 b0 = *(const bf16x8*)(Kc + KSW(r32, cb)), b1 = *(const bf16x8*)(Kc + KSW(32 + r32, cb)); \
      P0 = __builtin_amdgcn_mfma_f32_32x32x16_bf16(b0, qr[d0], P0, 0, 0, 0); P1 = __builtin_amdgcn_mfma_f32_32x32x16_bf16(b1, qr[d0], P1, 0, 0, 0); } } while (0)
#define ATT_PV(BI) do { const int vbc = vb0 + (BI) * BUF; \
    pv_one<0>(o[0], vbc, pa0, pa1, pa2, pa3); pv_one<1>(o[1], vbc, pa0, pa1, pa2, pa3); pv_one<2>(o[2], vbc, pa0, pa1, pa2, pa3); pv_one<3>(o[3], vbc, pa0, pa1, pa2, pa3); } while (0)
#define ATT_PVX(BI, P0, P1, AL) do { const int vbc = vb0 + (BI) * BUF; float mnC_; sm_max(P0, P1, m_reg, mnC_, AL); \
    pv_one<0>(o[0], vbc, pa0, pa1, pa2, pa3); sm_exp8<0>(P0, mnC_); pv_one<1>(o[1], vbc, pa0, pa1, pa2, pa3); sm_exp8<8>(P0, mnC_); \
    pv_one<2>(o[2], vbc, pa0, pa1, pa2, pa3); sm_exp8<0>(P1, mnC_); pv_one<3>(o[3], vbc, pa0, pa1, pa2, pa3); sm_exp8<8>(P1, mnC_); } while (0)
#define ATT_RESC(AL) do { if (__any((AL) < 1.f)) { if (hi == 0) al_l[r32] = (AL); asm volatile("s_waitcnt lgkmcnt(0)" ::: "memory"); \
      _Pragma("unroll") for (int d = 0; d < 4; ++d) _Pragma("unroll") for (int r = 0; r < 16; ++r) o[d][r] *= al_l[crow(r, hi)]; } } while (0)
#define ATT_STAGE(KT) do { if ((KT) + 1 < NT) ATT_DMA((KT) + 1, bnext); } while (0)
#define ATT_ROT() do { const int t_ = bprev; bprev = bcur; bcur = bnext; bnext = t_; } while (0)
  bf16x8 pa0, pa1, pa2, pa3;
  ATT_DMA(0, 0);
  {
    const int qrow = row0 + wid * 32 + r32; const bf16_t* Qw = QM + (size_t)qrow * 1536 + h * 192 + hi * 8;
#pragma unroll
    for (int d0 = 0; d0 < 12; ++d0) qr[d0] = *(const bf16x8*)(Qw + d0 * 16);
    if (smp) { const int pos = qb * 256 + wid * 32 + r32;
#pragma unroll
      for (int d0 = 8; d0 < 12; ++d0) { const int i0 = 8 * (d0 - 8) + 4 * hi; const float* rp = rope + ((size_t)pos * 32 + i0) * 2;
        const f32x4 c01 = *(const f32x4*)rp, c23 = *(const f32x4*)(rp + 4);
        const u32x4 w = __builtin_bit_cast(u32x4, qr[d0]); u32x4 ow;
        { const float x1 = bflo(w.x), x2 = bfhi(w.x); ow.x = cvt_pk_bf16(x1 * c01[0] - x2 * c01[1], x1 * c01[1] + x2 * c01[0]); }
        { const float x1 = bflo(w.y), x2 = bfhi(w.y); ow.y = cvt_pk_bf16(x1 * c01[2] - x2 * c01[3], x1 * c01[3] + x2 * c01[2]); }
        { const float x1 = bflo(w.z), x2 = bfhi(w.z); ow.z = cvt_pk_bf16(x1 * c23[0] - x2 * c23[1], x1 * c23[1] + x2 * c23[0]); }
        { const float x1 = bflo(w.w), x2 = bfhi(w.w); ow.w = cvt_pk_bf16(x1 * c23[2] - x2 * c23[3], x1 * c23[3] + x2 * c23[2]); }
        qr[d0] = __builtin_bit_cast(bf16x8, ow); } }
  }
  ATT_SYNC();
  int bprev = 2, bcur = 0, bnext = 1;
  ATT_STAGE(0); SBAR(); ATT_QK(bcur, pA0, pA1); partialSM(pA0, pA1, m_reg, mnx, alA); ATT_RESC(alA); ATT_SYNC(); ATT_ROT();
#pragma unroll 1
  for (int kt = 1; kt + 1 < NT; kt += 2) {
    ATT_STAGE(kt); SBAR(); ATT_QK(bcur, pB0, pB1); finishSM(pA0, pA1, alA, l_reg, pa0, pa1, pa2, pa3); SBAR();
    ATT_PVX(bprev, pB0, pB1, alB); ATT_RESC(alB); ATT_SYNC(); ATT_ROT();
    ATT_STAGE(kt + 1); SBAR(); ATT_QK(bcur, pA0, pA1); finishSM(pB0, pB1, alB, l_reg, pa0, pa1, pa2, pa3); SBAR();
    ATT_PVX(bprev, pA0, pA1, alA); ATT_RESC(alA); ATT_SYNC(); ATT_ROT();
  }
  ATT_STAGE(NT - 1); SBAR(); ATT_QK(bcur, pB0, pB1); finishSM(pA0, pA1, alA, l_reg, pa0, pa1, pa2, pa3); SBAR();
  ATT_PVX(bprev, pB0, pB1, alB); ATT_RESC(alB); ATT_SYNC(); ATT_ROT();
  finishSM(pB0, pB1, alB, l_reg, pa0, pa1, pa2, pa3); ATT_PV(bprev);
#undef ATT_QK
#undef ATT_PV
#undef ATT_PVX
#undef ATT_RESC
#undef ATT_STAGE
#undef ATT_ROT
#undef ATT_DMA
#undef ATT_SYNC
  if (hi == 0) li_l[r32] = l_reg; asm volatile("s_waitcnt lgkmcnt(0)" ::: "memory");
  bf16_t* Ow = YC + (size_t)(row0 + wid * 32) * LDY3 + h * 128;
#pragma unroll
  for (int r = 0; r < 16; ++r) { const int orow = crow(r, hi); const float rl = __builtin_amdgcn_rcpf(li_l[orow]);
#pragma unroll
    for (int d0 = 0; d0 < 4; ++d0) Ow[(size_t)orow * LDY3 + d0 * 32 + r32] = f2bf(o[d0][r] * rl); }
  __syncthreads();
}
__device__ __forceinline__ void phase_attn(const Ctx& X) {
  for (int u = X.bid; u < 512; u += X.G) {
    if (u < 256) { const int pr = (X.G == 256) ? (u & 7) * 2 + (u >> 7) : u >> 4, qb = (X.G == 256) ? (u >> 3) & 15 : u & 15;
      attn_unit(X, true, pr >> 3, pr & 7, qb); }
    else { const int v = u - 256; attn_unit(X, false, v >> 3, v & 7, 0); }
  }
}
}

namespace ret {
using att::s16x4; using att::f32x16; using att::tr_read; using att::v_st; using att::v_rd_base; using att::v_rd_off; using att::crow;
#define KS256(row, colB) ((row) * 256 + ((colB) ^ (((row) & 7) << 4)))
#define RPK(L, H) (bf16x8){L[0], L[1], L[2], L[3], H[0], H[1], H[2], H[3]}
__device__ __forceinline__ void phase_ret_pass1(const Ctx& X, int l) {
    int tid = threadIdx.x; asm volatile("" : "+v"(tid)); const int lane = tid & 63, w = __builtin_amdgcn_readfirstlane(tid >> 6), r32 = lane & 31, hi = lane >> 5;
    char* VL = (char*)X.lds; char* KF = VL + 32768; char* KB = VL + 65536;
    const bf16_t* Kb = (const bf16_t*)(X.ws + WS_K); const bf16_t* Vb = (const bf16_t*)(X.ws + WS_V); bf16_t* LR = (bf16_t*)(X.ws + WS_LRET);
    const int dvb = w & 3, dk0 = 2 * (w >> 2);
    const int va = (int)(uintptr_t)VL + v_rd_base(lane) + dvb * 512, kfa = (int)(uintptr_t)KF + v_rd_base(lane) + dk0 * 512, kba = (int)(uintptr_t)KB + v_rd_base(lane) + dk0 * 512;
    for (int u = X.bid; u < 1024; u += X.G) {
        const int ci = u >> 3, h = u & 7, r0 = ci * 128;
        const float lgf = ret_lg(X, l, 0, h), lgb = ret_lg(X, l, 1, h);
#pragma unroll
        for (int it = 0; it < 4; ++it) { const int seg = tid + it * 512, t = seg >> 4, sg = seg & 15, off = (t >> 6) * 16384 + v_st(t & 63, sg * 8);
            const u32x4 vv = *(const u32x4*)(Vb + (size_t)(r0 + t) * 1024 + h * 128 + sg * 8), kk = *(const u32x4*)(Kb + (size_t)(r0 + t) * 1024 + h * 128 + sg * 8);
            *(u32x4*)(VL + off) = vv;
            const float sf = RET_SC * __builtin_amdgcn_exp2f(lgf * (float)(127 - t)), sb = RET_SC * __builtin_amdgcn_exp2f(lgb * (float)t);
            u32x4 a, b; a.x = cvt_pk_bf16(bflo(kk.x) * sf, bfhi(kk.x) * sf); a.y = cvt_pk_bf16(bflo(kk.y) * sf, bfhi(kk.y) * sf); a.z = cvt_pk_bf16(bflo(kk.z) * sf, bfhi(kk.z) * sf); a.w = cvt_pk_bf16(bflo(kk.w) * sf, bfhi(kk.w) * sf);
            b.x = cvt_pk_bf16(bflo(kk.x) * sb, bfhi(kk.x) * sb); b.y = cvt_pk_bf16(bflo(kk.y) * sb, bfhi(kk.y) * sb); b.z = cvt_pk_bf16(bflo(kk.z) * sb, bfhi(kk.z) * sb); b.w = cvt_pk_bf16(bflo(kk.w) * sb, bfhi(kk.w) * sb);
            *(u32x4*)(KF + off) = a; *(u32x4*)(KB + off) = b; }
        __syncthreads();
        f32x16 acc[2][2] = {};
#define RP1_STEP(T, KS) do { \
            const s16x4 al = tr_read<(T) * 16384 + v_rd_off(0, KS, 0)>(va), ah = tr_read<(T) * 16384 + v_rd_off(0, KS, 1)>(va); \
            const s16x4 f0l = tr_read<(T) * 16384 + v_rd_off(0, KS, 0)>(kfa), f0h = tr_read<(T) * 16384 + v_rd_off(0, KS, 1)>(kfa), f1l = tr_read<(T) * 16384 + v_rd_off(1, KS, 0)>(kfa), f1h = tr_read<(T) * 16384 + v_rd_off(1, KS, 1)>(kfa); \
            const s16x4 b0l = tr_read<(T) * 16384 + v_rd_off(0, KS, 0)>(kba), b0h = tr_read<(T) * 16384 + v_rd_off(0, KS, 1)>(kba), b1l = tr_read<(T) * 16384 + v_rd_off(1, KS, 0)>(kba), b1h = tr_read<(T) * 16384 + v_rd_off(1, KS, 1)>(kba); \
            asm volatile("s_waitcnt lgkmcnt(0)" ::: "memory"); __builtin_amdgcn_sched_barrier(0); \
            const bf16x8 A = RPK(al, ah); \
            acc[0][0] = __builtin_amdgcn_mfma_f32_32x32x16_bf16(A, RPK(f0l, f0h), acc[0][0], 0, 0, 0); acc[0][1] = __builtin_amdgcn_mfma_f32_32x32x16_bf16(A, RPK(f1l, f1h), acc[0][1], 0, 0, 0); \
            acc[1][0] = __builtin_amdgcn_mfma_f32_32x32x16_bf16(A, RPK(b0l, b0h), acc[1][0], 0, 0, 0); acc[1][1] = __builtin_amdgcn_mfma_f32_32x32x16_bf16(A, RPK(b1l, b1h), acc[1][1], 0, 0, 0); } while (0)
        RP1_STEP(0, 0); RP1_STEP(0, 1); RP1_STEP(0, 2); RP1_STEP(0, 3); RP1_STEP(1, 0); RP1_STEP(1, 1); RP1_STEP(1, 2); RP1_STEP(1, 3);
#undef RP1_STEP
#pragma unroll
        for (int dir = 0; dir < 2; ++dir)
#pragma unroll
            for (int q = 0; q < 2; ++q) { bf16_t* o = LR + ((size_t)(u * 2 + dir) * 128 + 32 * dvb) * 128 + 32 * (dk0 + q) + r32;
#pragma unroll
                for (int r = 0; r < 16; ++r) o[(size_t)crow(r, hi) * 128] = f2bf(acc[dir][q][r]); }
        __syncthreads();
    }
}
template <int D0> __device__ __forceinline__ void pv128(f32x16& od, int vb, const bf16x8 (&pa)[8]) {
    att::pv_one<D0>(od, vb, pa[0], pa[1], pa[2], pa[3]); att::pv_one<D0>(od, vb + 16384, pa[4], pa[5], pa[6], pa[7]);
}
__device__ __forceinline__ void phase_ret_pass2(const Ctx& X, int l) {
    int tid = threadIdx.x; asm volatile("" : "+v"(tid)); const int lane = tid & 63, w = __builtin_amdgcn_readfirstlane(tid >> 6), r32 = lane & 31, hi = lane >> 5;
    char* KL = (char*)X.lds; char* VL = KL + 32768; char* SF = KL + 65536; char* SB = KL + 98304; float* ST = (float*)(X.lds + XCH_OFF);
    const bf16_t* Qb = (const bf16_t*)(X.ws + WS_Q); const bf16_t* Kb = (const bf16_t*)(X.ws + WS_K); const bf16_t* Vb = (const bf16_t*)(X.ws + WS_V); const bf16_t* Gb = (const bf16_t*)(X.ws + WS_G);
    const bf16_t* SR = (const bf16_t*)(X.ws + WS_SRET); bf16_t* YB = (bf16_t*)(X.ws + WS_Y3) + 1024; const float* gain = X.in[25] + l * 1024;
    const int rq = w & 3, ch = w >> 2, vb = (int)(uintptr_t)VL + v_rd_base(lane);
#define RP2_DMA_A(U) do { const int u_ = (U), r0_ = (u_ >> 3) * 128, h_ = u_ & 7; const bf16_t* kb_ = Kb + (size_t)r0_ * 1024 + h_ * 128; const bf16_t* vb_ = Vb + (size_t)r0_ * 1024 + h_ * 128; \
        _Pragma("unroll") for (int i = 0; i < 4; ++i) { const int off = (w + 8 * i) * 1024 + ln * 16, row = off >> 8, cB = (off & 255) ^ ((row & 7) << 4); \
            __builtin_amdgcn_global_load_lds((const unsigned*)(kb_ + row * 1024 + (cB >> 1)), (LAS unsigned*)(KL + (w + 8 * i) * 1024), 16, 0, 0); } \
        _Pragma("unroll") for (int i = 0; i < 4; ++i) { const int off = (w + 8 * i) * 1024 + ln * 16, t_ = off >> 14, o2 = off & 16383, st = o2 >> 9, rem = o2 & 511, kk = (st >> 2) * 8 + (rem >> 6), cc = (st & 3) * 32 + ((rem & 63) >> 1); \
            const int k_ = ((kk & ~0xC) | ((kk & 4) << 1) | ((kk & 8) >> 1)) + 64 * t_; \
            __builtin_amdgcn_global_load_lds((const unsigned*)(vb_ + k_ * 1024 + cc), (LAS unsigned*)(VL + (w + 8 * i) * 1024), 16, 0, 0); } } while (0)
#define RP2_DMA_B(U) do { const bf16_t* sf_ = SR + (size_t)((U) * 2) * 16384; \
        _Pragma("unroll") for (int i = 0; i < 4; ++i) { const int off = (w + 8 * i) * 1024 + ln * 16, row = off >> 8, cB = (off & 255) ^ ((row & 7) << 4); \
            __builtin_amdgcn_global_load_lds((const unsigned*)(sf_ + row * 128 + (cB >> 1)), (LAS unsigned*)(SF + (w + 8 * i) * 1024), 16, 0, 0); \
            __builtin_amdgcn_global_load_lds((const unsigned*)(sf_ + 16384 + row * 128 + (cB >> 1)), (LAS unsigned*)(SB + (w + 8 * i) * 1024), 16, 0, 0); } } while (0)
    { int ln = lane; asm volatile("" : "+v"(ln)); if (X.bid < 1024) RP2_DMA_A(X.bid); }
    bf16x8 qr[8];
#define RP2_LDQ(U) do { const int u_ = (U); const bf16_t* Qw = Qb + (size_t)((u_ >> 3) * 128 + 32 * rq + r32) * 1024 + (u_ & 7) * 128 + hi * 8; \
        _Pragma("unroll") for (int d0 = 0; d0 < 8; ++d0) qr[d0] = *(const bf16x8*)(Qw + d0 * 16); } while (0)
    if (X.bid < 1024) RP2_LDQ(X.bid);
    asm volatile("s_waitcnt vmcnt(0)" ::: "memory"); __syncthreads();
    for (int u = X.bid; u < 1024; u += X.G) {
        const int ci = u >> 3, h = u & 7, r0 = ci * 128;
        const float lgf = ret_lg(X, l, 0, h), lgb = ret_lg(X, l, 1, h);
        int ln = lane; asm volatile("" : "+v"(ln));
        RP2_DMA_B(u);
        unsigned gq[16][2];
#pragma unroll
        for (int r = 0; r < 16; ++r)
#pragma unroll
            for (int dd = 0; dd < 2; ++dd) gq[r][dd] = Gb[(size_t)(r0 + 32 * rq + crow(r, hi)) * 1024 + h * 128 + 32 * (2 * ch + dd) + r32];
        __builtin_amdgcn_sched_barrier(0);
        bf16x8 pa[8];
        { int i = 32 * rq + r32, hq = hi; asm volatile("" : "+v"(i), "+v"(hq));
#pragma unroll
          for (int kb = 0; kb < 4; ++kb) { f32x16 p = {};
#pragma unroll
            for (int d0 = 0; d0 < 8; ++d0) { const bf16x8 kf = *(const bf16x8*)(KL + KS256(32 * kb + r32, (d0 * 16 + hi * 8) * 2)); p = __builtin_amdgcn_mfma_f32_32x32x16_bf16(kf, qr[d0], p, 0, 0, 0); }
#pragma unroll
            for (int r = 0; r < 16; ++r) { const int dl = i - (32 * kb + crow(r, hq)); const float ex = __builtin_amdgcn_exp2f(dl >= 0 ? lgf * (float)dl : -lgb * (float)dl); p[r] *= (dl == 0 ? 2.f * RET_SC : RET_SC) * ex; }
#define RPK4(P, BASE, OUT) do { unsigned a0 = cvt_pk_bf16(P[BASE + 0], P[BASE + 1]), a1 = cvt_pk_bf16(P[BASE + 2], P[BASE + 3]), b0 = cvt_pk_bf16(P[BASE + 4], P[BASE + 5]), b1 = cvt_pk_bf16(P[BASE + 6], P[BASE + 7]); \
            auto x0 = __builtin_amdgcn_permlane32_swap(a0, b0, false, false); auto x1 = __builtin_amdgcn_permlane32_swap(a1, b1, false, false); u32x4 wv = {x0[0], x1[0], x0[1], x1[1]}; OUT = __builtin_bit_cast(bf16x8, wv); } while (0)
            RPK4(p, 0, pa[2 * kb]); RPK4(p, 8, pa[2 * kb + 1]);
            asm volatile("" ::: "memory"); __builtin_amdgcn_sched_barrier(0);
#undef RPK4
          } }
        f32x16 o[2] = {};
        if (ch == 0) { pv128<0>(o[0], vb, pa); pv128<1>(o[1], vb, pa); } else { pv128<2>(o[0], vb, pa); pv128<3>(o[1], vb, pa); }
        asm volatile("s_waitcnt vmcnt(0)" ::: "memory"); __syncthreads();
        if (u + X.G < 1024) RP2_DMA_A(u + X.G);
        { const int i = 32 * rq + r32; const float scf = exp2f(lgf * (float)(i + 1)), scb = exp2f(lgb * (float)(128 - i));
#pragma unroll
          for (int ks = 0; ks < 8; ++ks) { const bf16x8 qf = scale_frag(qr[ks], scf), qb = scale_frag(qr[ks], scb);
#pragma unroll
            for (int dd = 0; dd < 2; ++dd) { const int row = 32 * (2 * ch + dd) + r32, cb = (ks * 16 + hi * 8) * 2;
                const bf16x8 sfv = *(const bf16x8*)(SF + KS256(row, cb)), sbv = *(const bf16x8*)(SB + KS256(row, cb));
                o[dd] = __builtin_amdgcn_mfma_f32_32x32x16_bf16(qf, sfv, o[dd], 0, 0, 0); o[dd] = __builtin_amdgcn_mfma_f32_32x32x16_bf16(qb, sbv, o[dd], 0, 0, 0); }
            asm volatile("" ::: "memory"); __builtin_amdgcn_sched_barrier(0); } }
        if (u + X.G < 1024) RP2_LDQ(u + X.G);
        __builtin_amdgcn_sched_barrier(0);
        float s1[16], s2[16];
#pragma unroll
        for (int r = 0; r < 16; ++r) { float a = o[0][r] + o[1][r], b = o[0][r] * o[0][r] + o[1][r] * o[1][r];
#pragma unroll
            for (int m = 1; m < 32; m <<= 1) { a += __shfl_xor(a, m); b += __shfl_xor(b, m); }
            s1[r] = a; s2[r] = b; }
        if (r32 == 0) {
#pragma unroll
            for (int r = 0; r < 16; ++r) { ST[(w * 32 + crow(r, hi)) * 2] = s1[r]; ST[(w * 32 + crow(r, hi)) * 2 + 1] = s2[r]; } }
        __syncthreads();
#pragma unroll
        for (int r = 0; r < 16; ++r) { const int row = crow(r, hi); const float a = s1[r] + ST[((w ^ 4) * 32 + row) * 2], b = s2[r] + ST[((w ^ 4) * 32 + row) * 2 + 1];
            const float mu = a * (1.f / 128.f), var = b * (1.f / 128.f) - mu * mu, rstd = rsqrtf(fmaxf(var, 0.f) + EPS);
            const size_t ro = (size_t)(r0 + 32 * rq + row) * 1024 + h * 128;
#pragma unroll
            for (int dd = 0; dd < 2; ++dd) { const int c = 32 * (2 * ch + dd) + r32; const float gv = __uint_as_float(gq[r][dd] << 16);
                YB[(size_t)(r0 + 32 * rq + row) * LDY3 + h * 128 + c] = f2bf(gv * sigm(gv) * ((o[dd][r] - mu) * rstd) * gain[h * 128 + c]); } }
        asm volatile("s_waitcnt vmcnt(0)" ::: "memory"); __syncthreads();
    }
#undef RP2_DMA_A
#undef RP2_DMA_B
#undef RP2_LDQ
}
}

#ifndef GA
#define GA true
#endif
#ifndef GS
#define GS true
#endif
#ifndef MK_PER_PHASE
#define MK_PER_PHASE 0
#endif
constexpr int NPH = 14, NPHASES = 2 * NPH;
struct Args { const float* in[37]; float* out; unsigned char* ws; int ph_lo, ph_hi, li, pad; };
template <int l> __device__ __forceinline__ void run_layer(const Args& args, unsigned char* lds, const XcdBarrier& bar, const int lo, const int hi, PG8_LAS unsigned char* ring) {
#define PHASE_CTX Ctx X; { unsigned char* w_ = args.ws; float* o_ = args.out; const float* const* i_ = args.in; w_ = (unsigned char*)opaque_uniform(w_); o_ = (float*)opaque_uniform(o_); \
        X.ws = w_; X.out = o_; X.in = i_; X.lds = lds; X.G = gridDim.x; X.bid = blockIdx.x; } unsigned char* ws = X.ws; const int G = X.G, bid = X.bid; (void)ws; (void)G; (void)bid;
        const int pb = l * NPH;
#ifndef SUBMASK
#define SUBMASK 0xFF
#endif
#define SUB(j) (((SUBMASK) >> (j)) & 1)
#ifndef PHMASK
#define PHMASK 0xFFFF
#endif
#define IN(k) ((((PHMASK) >> (k)) & 1) && lo <= pb + (k) && pb + (k) < hi)
#ifndef PROBE_MASK
#define PROBE_MASK 0
#endif
#define REP(id) for (int rep_ = 0; rep_ < ((((PROBE_MASK) >> (id)) & 1) ? 2 : 1); ++rep_)
#define SEAM(k) do { if (pb + (k) + 1 < hi) xcd_barrier(bar); } while (0)
        if (l == 0 && IN(0)) { PHASE_CTX  phase_pre(X, 0); SEAM(0); }
        if (l == 0 && IN(1)) { PHASE_CTX  phase_norm<0>(X, 0, nullptr); SEAM(1); }
        if (IN(2)) { PHASE_CTX
            Gemm g{(const bf16_t*)(ws + WS_H), (const bf16_t*)(ws + WS_WIN), 2048, 2048, 2048}; StaticOrder S; S.init(M, NP2 + 512, G, bid);
            EpiP2 E{(bf16_t*)(ws + WS_UG), (bf16_t*)(ws + WS_Q), (bf16_t*)(ws + WS_K), (bf16_t*)(ws + WS_V), (bf16_t*)(ws + WS_G), (bf16_t*)(ws + WS_CQ), (bf16_t*)(ws + WS_CKV), (bf16_t*)(ws + WS_KR), (bf16_t*)(ws + WS_G2)};
            REP(2) gemm_phase<EpiP2, StaticOrder, GA, GS>(ring, g, S, E); SEAM(2); }
        if (IN(3)) { PHASE_CTX
            { Gemm g{(const bf16_t*)(ws + WS_UG), (const bf16_t*)(ws + WS_BTE), 768, 512, 512}; OrderS5E S{G, bid}; EpiS5E E{(float*)(ws + WS_ELOC)};
              REP(3) gemm_phase<EpiS5E, OrderS5E, GA, GS>(ring, g, S, E); }
            __syncthreads();
            REP(4) ret::phase_ret_pass1(X, l);
            phase_mla_norm(X, l); SEAM(3); }
        if (IN(4)) { PHASE_CTX
            { Gemm g{(const bf16_t*)(ws + WS_CQ), (const bf16_t*)(ws + WS_WUQ), 768, 768, 768}; StaticOrder S; S.init(M, 1536, G, bid); EpiBf16Plain E{(bf16_t*)(ws + WS_QMLA), 1536};
              REP(5) gemm_phase<EpiBf16Plain, StaticOrder, GA, GS>(ring, g, S, E); }
            { Gemm g{(const bf16_t*)(ws + WS_CKV), (const bf16_t*)(ws + WS_WKV), 512, 512, 512}; StaticOrder S; S.init(MK, 2048, G, (bid + G / 2) % G); EpiBf16Plain E{(bf16_t*)(ws + WS_KVMLA), 2048};
              REP(5) gemm_phase<EpiBf16Plain, StaticOrder, GA, GS>(ring, g, S, E); }
            REP(6) phase_s5_carry(X, l);
            REP(7) phase_ret_prefix(X, l); SEAM(4); }
        if (IN(5)) { PHASE_CTX
            { Gemm g{(const bf16_t*)(ws + WS_UG), (const bf16_t*)(ws + WS_BTY), 768, 768, 768}; OrderS5Y S{G, bid}; EpiS5Y E{(const bf16_t*)(ws + WS_UG), X.in[21] + l * 1024, (bf16_t*)(ws + WS_YAP)};
              REP(8) gemm_phase<EpiS5Y, OrderS5Y, GA, GS>(ring, g, S, E); }
            __syncthreads();
            REP(9) att::phase_attn(X);
            REP(10) ret::phase_ret_pass2(X, l); SEAM(5); }
        if (IN(6)) { PHASE_CTX
            const bool up = bid >= G / 2;
            Gemm gg{(const bf16_t*)(ws + WS_YAP), (const bf16_t*)(ws + WS_WGLU), 1024, 1024, 1024}; StaticOrder SG; SG.init(M, 1024, G - G / 2, up ? bid - G / 2 : 0);
            EpiGlu EG{(const bf16_t*)(ws + WS_YAP), X.in[23] + l * 1024, (bf16_t*)(ws + WS_Y3), LDY3};
            if (up) { OrderSlice S0{SG, 0, 1}; gemm_phase<EpiGlu, OrderSlice, GA, GS>(ring, gg, S0, EG); }
            { Gemm g{(const bf16_t*)(ws + WS_H), (const bf16_t*)(ws + WS_WIN) + (size_t)(NP2 + 512) * 2048, 2048, 2048, 2048}; StaticOrder S; S.init(M, NGATE - 512, G, bid); EpiBf16Plain E{(bf16_t*)(ws + WS_GATES) + 512, NGATE};
              gemm_phase<EpiBf16Plain, StaticOrder, GA, GS>(ring, g, S, E); }
            if (up) { OrderSlice S1{SG, 1, 1}; gemm_phase<EpiGlu, OrderSlice, GA, GS>(ring, gg, S1, EG); }
            SEAM(6); }
        if (IN(7)) { PHASE_CTX
            Gemm g{(const bf16_t*)(ws + WS_Y3), (const bf16_t*)(ws + WS_WBR), LDY3, 3072, 3072}; StaticOrder S; S.init(M, 2048, G, bid);
            EpiBranch3 E{(const bf16_t*)(ws + WS_GATES), (const bf16_t*)(ws + WS_G2), (bf16_t*)(ws + WS_MERGED)};
            REP(13) gemm_phase<EpiBranch3, StaticOrder, GA, GS>(ring, g, S, E); SEAM(7); }
        if (IN(8)) { PHASE_CTX
            Gemm g{(const bf16_t*)(ws + WS_MERGED), (const bf16_t*)(ws + WS_WOUT), 2048, 2048, 2048}; StaticOrder S; S.init(M, 2048, G, bid); EpiBf16Plain E{(bf16_t*)(ws + WS_MO), 2048};
            REP(14) gemm_phase<EpiBf16Plain, StaticOrder, GA, GS>(ring, g, S, E); SEAM(8); }
        if (IN(9)) { PHASE_CTX  phase_norm<1>(X, l, (const bf16_t*)(ws + WS_MO)); SEAM(9); }
        if (IN(10)) { PHASE_CTX
            Gemm g{(const bf16_t*)(ws + WS_H), (const bf16_t*)(ws + WS_WUP), 2048, 2048, 2048}; StaticOrder S; S.init(M, DFF2, G, bid); EpiUpConv E{X.in[34] + (size_t)l * 3 * DFF2, X.in[35] + (size_t)l * DFF2, (bf16_t*)(ws + WS_AF), (float*)(ws + WS_HALO), (PG8_LAS float*)(ring + XCH_OFF)};
            REP(15) gemm_phase<EpiUpConv, StaticOrder, true, true>(ring, g, S, E); SEAM(10); }
        if (IN(11)) { PHASE_CTX  phase_convfix(X, l); SEAM(11); }
        if (IN(12)) { PHASE_CTX
            Gemm g{(const bf16_t*)(ws + WS_AF), (const bf16_t*)(ws + WS_WDN), DFF, DFF, DFF}; StaticOrder S; S.init(M, 2048, G, bid); EpiBf16Plain E{(bf16_t*)(ws + WS_DN), 2048};
            REP(17) gemm_phase<EpiBf16Plain, StaticOrder, GA, GS>(ring, g, S, E); SEAM(12); }
        if (IN(13)) { PHASE_CTX  phase_norm<2>(X, l, (const bf16_t*)(ws + WS_DN)); if (l == 0) phase_pre(X, 1); if (l == 0 && pb + 16 < hi) xcd_barrier(bar); }
#undef IN
#undef SEAM
#undef PHASE_CTX
}
__global__ void __launch_bounds__(512, 2) mk_fwd(Args args) {
    extern __shared__ __attribute__((aligned(16))) unsigned char lds[];
    volatile LAS unsigned* MISC = (volatile LAS unsigned*)((LAS unsigned char*)lds + MISC_OFF);
    if (threadIdx.x < 32) MISC[threadIdx.x] = 0u;
    __syncthreads();
    XcdBarrier bar = xcd_barrier_post((unsigned*)(args.ws + WS_CTL) + CW_BAR + args.li * XCD_BAR_WORDS, MISC + 8);
    const int lo = args.ph_lo, hi = args.ph_hi;
    PG8_LAS unsigned char* ring = (PG8_LAS unsigned char*)lds;
    run_layer<0>(args, lds, bar, lo, hi, ring);
    run_layer<1>(args, lds, bar, lo, hi, ring);
}

extern "C" void kernel_launch(void* const* d_in, const int* in_sizes, int n_in, void* d_out, int out_size, void* d_ws, size_t ws_size, hipStream_t stream) {
    static int grid = 0;
    if (grid == 0) {
        if (n_in != 37 || (size_t)out_size != O_END || ws_size < WS_END) { fprintf(stderr, "kernel_launch: unexpected shapes: n_in %d out %d ws %zu (need %zu)\n", n_in, out_size, ws_size, (size_t)WS_END); grid = -1; return; }
        int dev = 0, cus = 0;
        if (hipGetDevice(&dev) != hipSuccess || hipDeviceGetAttribute(&cus, hipDeviceAttributeMultiprocessorCount, dev) != hipSuccess) { grid = -1; return; }
        if (hipFuncSetAttribute((const void*)mk_fwd, hipFuncAttributeMaxDynamicSharedMemorySize, LDS_BYTES) != hipSuccess) { fprintf(stderr, "kernel_launch: hipFuncSetAttribute failed\n"); grid = -1; return; }
        int per_cu = 0;
        if (hipOccupancyMaxActiveBlocksPerMultiprocessor(&per_cu, (const void*)mk_fwd, 512, LDS_BYTES) != hipSuccess || per_cu < 1) fprintf(stderr, "kernel_launch: occupancy query reports %d\n", per_cu);
        (void)hipGetLastError();
        grid = cus;
    }
    if (grid < 0) return;
    (void)hipMemsetAsync((char*)d_ws + WS_CTL, 0, CTL_ZERO_BYTES, stream);
    Args a{};
    for (int i = 0; i < 37; ++i) a.in[i] = (const float*)d_in[i];
    a.out = (float*)d_out; a.ws = (unsigned char*)d_ws; a.pad = 0;
#if MK_PER_PHASE
    for (int p = 0; p < NPHASES; ++p) { a.ph_lo = p; a.ph_hi = p + 1; a.li = p; hipLaunchKernelGGL(mk_fwd, dim3(grid), dim3(512), LDS_BYTES, stream, a); }
#else
    a.ph_lo = 0; a.ph_hi = NPHASES; a.li = 0; hipLaunchKernelGGL(mk_fwd, dim3(grid), dim3(512), LDS_BYTES, stream, a);
#endif
    const hipError_t le = hipPeekAtLastError();
    if (le != hipSuccess) fprintf(stderr, "kernel_launch: launch failed: %s\n", hipGetErrorName(le));
}
```

```cpp
#include <hip/hip_runtime.h>
#include <cstdio>
#include <cstdint>
namespace pg8 {
#define PG8_LAS __attribute__((address_space(3)))
typedef unsigned short bf16_t;
typedef short bf16x8 __attribute__((ext_vector_type(8)));
typedef float f32x4 __attribute__((ext_vector_type(4)));
typedef unsigned u32x4 __attribute__((ext_vector_type(4)));
typedef unsigned u32x2 __attribute__((ext_vector_type(2)));
constexpr int BM = 256, BK = 64, HALF = 128, HTB = HALF * BK * 2  , STAGE_BYTES = 8 * HTB, NXCD = 8, WGM = 8;

__host__ __device__ __forceinline__ int lds_byte(int r, int c) { const int st = (r >> 4) * 2 + (c >> 5), rr = r & 15, cc = c & 31, ob = rr * 64 + cc * 2; return st * 1024 + (ob ^ (((ob >> 9) & 1) << 5)); }
__host__ __device__ __forceinline__ void stage_rc(int b, int& R, int& C) { const int st = b / 1024, sb = b % 1024, swz = sb ^ (((sb >> 9) & 1) << 5); R = (st >> 1) * 16 + swz / 64; C = (st & 1) * 32 + (swz % 64) / 2; }
__host__ __device__ __forceinline__ int perm32(int rho) { const int n = rho >> 4, i = rho & 15; return 8 * (i >> 2) + 4 * n + (i & 3); }

struct Unit { int pm, pn; };
struct Gemm { const bf16_t* A; const bf16_t* Bt; int lda, ldb, K; };

struct StaticOrder {
    int nM, nN, nwg, G, c;
    __host__ __device__ void init(int M, int N, int G_, int c_) { nM = M / BM; nN = N / BM; nwg = nM * nN; G = G_; c = c_; }
    __host__ __device__ bool next(int i, Unit& u) const {
        const long L = (long)i * G + c; if (L >= nwg) return false;
        int wgid = (int)L; { const int q = nwg / NXCD, r = nwg % NXCD, xcd = wgid % NXCD, off = wgid / NXCD; wgid = (xcd < r ? xcd * (q + 1) : r * (q + 1) + (xcd - r) * q) + off; }
        const int nig = WGM * nN, gid = wgid / nig, fm = gid * WGM, gsz = (nM - fm) < WGM ? (nM - fm) : WGM;
        u.pm = fm + ((wgid % nig) % gsz); u.pn = (wgid % nig) / gsz; return true;
    }
    __device__ __forceinline__ void a_ready(const Unit&) const {}
    __device__ __forceinline__ void done(const Unit&) const {}
};
struct OrderSlice {
    StaticOrder base; int first, count;
    __device__ bool next(int i, Unit& u) const { if (i >= count) return false; return base.next(first + i, u); }
    __device__ __forceinline__ void a_ready(const Unit&) const {}
    __device__ __forceinline__ void done(const Unit&) const {}
};
struct OrderS5E {
    int G, c;
    __device__ bool next(int i, Unit& u) const { const int L = i * G + c; if (L >= 128) return false; u.pm = L; u.pn = L >> 1; return true; }
    __device__ __forceinline__ void a_ready(const Unit&) const {}
    __device__ __forceinline__ void done(const Unit&) const {}
};
struct OrderS5Y {
    int G, c;
    __device__ bool next(int i, Unit& u) const { const int L = i * G + c; if (L >= 256) return false; const int g = L >> 2; u.pm = 2 * g + ((L >> 1) & 1); u.pn = 2 * g + (L & 1); return true; }
    __device__ __forceinline__ void a_ready(const Unit&) const {}
    __device__ __forceinline__ void done(const Unit&) const {}
};
__device__ __forceinline__ unsigned cvt_pk_bf16(float lo, float hi) { unsigned r; asm volatile("v_cvt_pk_bf16_f32 %0, %1, %2" : "=v"(r) : "v"(lo), "v"(hi)); return r; }
__device__ __forceinline__ float bflo(unsigned w) { return __uint_as_float(w << 16); }
__device__ __forceinline__ float bfhi(unsigned w) { return __uint_as_float(w & 0xffff0000u); }
__device__ __forceinline__ float bf2f(bf16_t v) { return __uint_as_float(((unsigned)v) << 16); }
__device__ __forceinline__ bf16_t f2bf(float f) { unsigned u = __float_as_uint(f); u += 0x7fffu + ((u >> 16) & 1u); return (bf16_t)(u >> 16); }
__device__ __forceinline__ float sigm(float x) { return __builtin_amdgcn_rcpf(1.f + __expf(-x)); }
__device__ __forceinline__ float gelu_tanh(float x) { const float z = 1.5957691216f * (x + 0.044715f * x * x * x); return x * __builtin_amdgcn_rcpf(1.f + __expf(-z)); }

#define GAS1 __attribute__((address_space(1)))
__device__ __forceinline__ void gstore16(bf16_t* p, u32x4 w) { *(GAS1 u32x4*)(GAS1 void*)p = w; }
__device__ __forceinline__ u32x4 gload16(const bf16_t* p) { return __builtin_nontemporal_load((const GAS1 u32x4*)(const GAS1 void*)p); }
__device__ __forceinline__ u32x4 xl(u32x4 w, int src4) { u32x4 r; r.x = (unsigned)__builtin_amdgcn_ds_bpermute(src4, (int)w.x); r.y = (unsigned)__builtin_amdgcn_ds_bpermute(src4, (int)w.y);
    r.z = (unsigned)__builtin_amdgcn_ds_bpermute(src4, (int)w.z); r.w = (unsigned)__builtin_amdgcn_ds_bpermute(src4, (int)w.w); return r; }
struct EpiBf16Plain {
    static constexpr bool PERM = true, AFTER_DRAIN = false, MID = false;
    bf16_t* O; int ldc;
    __device__ __forceinline__ void operator()(const f32x4 (&acc)[2][2][4][2], const Unit& u, int wr, int wc, int fr, int fq) const {
        const int lane = fq * 16 + fr, fr2 = lane >> 2, fq2 = lane & 3, src4 = (fq2 * 16 + fr2) * 4;
        const int row0 = u.pm * BM + wr * 64 + fr2, col0 = u.pn * BM + wc * 32 + 8 * fq2;
#pragma unroll
        for (int ai = 0; ai < 2; ++ai)
#pragma unroll
            for (int m = 0; m < 4; ++m) { bf16_t* rowp = O + (size_t)(row0 + ai * HALF + m * 16) * ldc + col0;
#pragma unroll
                for (int bj = 0; bj < 2; ++bj) { const f32x4 v0 = acc[ai][bj][m][0], v1 = acc[ai][bj][m][1];
                    u32x4 w; w.x = cvt_pk_bf16(v0[0], v0[1]); w.y = cvt_pk_bf16(v0[2], v0[3]); w.z = cvt_pk_bf16(v1[0], v1[1]); w.w = cvt_pk_bf16(v1[2], v1[3]);
                    gstore16(rowp + bj * HALF, xl(w, src4)); } }
    }
};
struct EpiF32Plain {
    static constexpr bool PERM = false, AFTER_DRAIN = false, MID = false;
    float* C; int ldc;
    __device__ __forceinline__ void operator()(const f32x4 (&acc)[2][2][4][2], const Unit& u, int wr, int wc, int fr, int fq) const {
        const int row0 = u.pm * BM + wr * 64 + fr, col0 = u.pn * BM + wc * 32 + 4 * fq;
#pragma unroll
        for (int ai = 0; ai < 2; ++ai)
#pragma unroll
            for (int m = 0; m < 4; ++m) { float* rowp = C + (size_t)(row0 + ai * HALF + m * 16) * ldc + col0;
#pragma unroll
                for (int bj = 0; bj < 2; ++bj)
#pragma unroll
                    for (int n = 0; n < 2; ++n) *(f32x4*)(rowp + bj * HALF + n * 16) = acc[ai][bj][m][n]; }
    }
};
struct EpiP2 {
    static constexpr bool PERM = true, AFTER_DRAIN = false, MID = false;
    bf16_t *UG, *Q, *K, *V, *Gt, *CQ, *CKV, *KR, *GATES;
    __device__ __forceinline__ void operator()(const f32x4 (&acc)[2][2][4][2], const Unit& u, int wr, int wc, int fr, int fq) const {
        const int pn = u.pn, row0 = u.pm * BM + wr * 64 + fr, cl = wc * 32 + 8 * fq;
        if (pn < 4) {
#pragma unroll
            for (int ai = 0; ai < 2; ++ai)
#pragma unroll
                for (int m = 0; m < 4; ++m) { const int r = row0 + ai * HALF + m * 16, chunk = r >> 5, tt = r & 31;
#pragma unroll
                    for (int bj = 0; bj < 2; ++bj) { const int c = pn * 256 + bj * HALF + cl, g = c >> 4, cp = c & 15;
                        const f32x4 v0 = acc[ai][bj][m][0], v1 = acc[ai][bj][m][1];
                        u32x4 w; w.x = cvt_pk_bf16(v0[0], v0[1]); w.y = cvt_pk_bf16(v0[2], v0[3]); w.z = cvt_pk_bf16(v1[0], v1[1]); w.w = cvt_pk_bf16(v1[2], v1[3]);
                        gstore16(UG + ((size_t)(g * 512 + chunk)) * 768 + tt * 16 + cp, w); } }
        } else {
            bf16_t* base; int ldc, colt;
            if (pn < 8) { base = Q; ldc = 1024; colt = (pn - 4) * 256; }
            else if (pn < 12) { base = K; ldc = 1024; colt = (pn - 8) * 256; }
            else if (pn < 16) { base = V; ldc = 1024; colt = (pn - 12) * 256; }
            else if (pn < 20) { base = Gt; ldc = 1024; colt = (pn - 16) * 256; }
            else if (pn < 23) { base = CQ; ldc = 768; colt = (pn - 20) * 256; }
            else if (pn < 25) { base = CKV; ldc = 512; colt = (pn - 23) * 256; }
            else if (pn == 25) { base = KR; ldc = 64; colt = 0; }
            else { base = GATES; ldc = 512; colt = (pn - 26) * 256; }
            const bool narrow = (pn == 25);
#pragma unroll
            for (int ai = 0; ai < 2; ++ai)
#pragma unroll
                for (int m = 0; m < 4; ++m) { bf16_t* rowp = base + (size_t)(row0 + ai * HALF + m * 16) * ldc + colt + cl;
#pragma unroll
                    for (int bj = 0; bj < 2; ++bj) { if (narrow && (bj * HALF + cl) >= 64) continue;
                        const f32x4 v0 = acc[ai][bj][m][0], v1 = acc[ai][bj][m][1];
                        u32x4 w; w.x = cvt_pk_bf16(v0[0], v0[1]); w.y = cvt_pk_bf16(v0[2], v0[3]); w.z = cvt_pk_bf16(v1[0], v1[1]); w.w = cvt_pk_bf16(v1[2], v1[3]);
                        gstore16(rowp + bj * HALF, w); } }
        }
    }
};
struct EpiS5E {
    static constexpr bool PERM = false, AFTER_DRAIN = false, MID = false;
    float* C;
    __device__ __forceinline__ void operator()(const f32x4 (&acc)[2][2][4][2], const Unit& u, int wr, int wc, int fr, int fq) const {
        const int row0 = u.pm * BM + wr * 64 + fr, col0 = wc * 32 + 4 * fq;
#pragma unroll
        for (int ai = 0; ai < 2; ++ai)
#pragma unroll
            for (int m = 0; m < 4; ++m) { float* rowp = C + (size_t)(row0 + ai * HALF + m * 16) * 256 + col0;
#pragma unroll
                for (int bj = 0; bj < 2; ++bj)
#pragma unroll
                    for (int n = 0; n < 2; ++n) *(f32x4*)(rowp + bj * HALF + n * 16) = acc[ai][bj][m][n]; }
    }
};
struct EpiS5Y {
    static constexpr bool PERM = true, AFTER_DRAIN = false, MID = false;
    const bf16_t* UG; const float* Dv; bf16_t* YA;
    __device__ __forceinline__ void operator()(const f32x4 (&acc)[2][2][4][2], const Unit& u, int wr, int wc, int fr, int fq) const {
        const int g = u.pm >> 1, a0 = (u.pm & 1) * 256 + wr * 64 + fr, ncl = (u.pn & 1) * 256 + wc * 32 + 8 * fq;
        f32x4 dv[2][2];
#pragma unroll
        for (int bj = 0; bj < 2; ++bj) { const int ch = g * 16 + ((ncl + bj * HALF) & 15); dv[bj][0] = *(const f32x4*)(Dv + ch); dv[bj][1] = *(const f32x4*)(Dv + ch + 4); }
#pragma unroll
        for (int ai = 0; ai < 2; ++ai) { u32x4 uw[4][2];
#pragma unroll
            for (int m = 0; m < 4; ++m)
#pragma unroll
                for (int bj = 0; bj < 2; ++bj) { const int a = a0 + ai * HALF + m * 16, nloc = ncl + bj * HALF; uw[m][bj] = *(const u32x4*)(UG + ((size_t)(g * 512 + a)) * 768 + (nloc >> 4) * 16 + (nloc & 15)); }
            __builtin_amdgcn_sched_barrier(0);
#pragma unroll
            for (int m = 0; m < 4; ++m)
#pragma unroll
                for (int bj = 0; bj < 2; ++bj) { const int a = a0 + ai * HALF + m * 16, nloc = ncl + bj * HALF, t = nloc >> 4, cp = nloc & 15, r = a * 32 + t, ch = g * 16 + cp;
                    const u32x4 x = uw[m][bj]; const f32x4 d0 = dv[bj][0], d1 = dv[bj][1], v0 = acc[ai][bj][m][0], v1 = acc[ai][bj][m][1];
                    const float y0 = gelu_tanh(v0[0] + d0[0] * bflo(x.x)), y1 = gelu_tanh(v0[1] + d0[1] * bfhi(x.x)), y2 = gelu_tanh(v0[2] + d0[2] * bflo(x.y)), y3 = gelu_tanh(v0[3] + d0[3] * bfhi(x.y));
                    const float y4 = gelu_tanh(v1[0] + d1[0] * bflo(x.z)), y5 = gelu_tanh(v1[1] + d1[1] * bfhi(x.z)), y6 = gelu_tanh(v1[2] + d1[2] * bflo(x.w)), y7 = gelu_tanh(v1[3] + d1[3] * bfhi(x.w));
                    u32x4 w; w.x = cvt_pk_bf16(y0, y1); w.y = cvt_pk_bf16(y2, y3); w.z = cvt_pk_bf16(y4, y5); w.w = cvt_pk_bf16(y6, y7);
                    *(u32x4*)(YA + (size_t)r * 1024 + ch) = w; }
            asm volatile("" ::: "memory"); }
    }
};
struct EpiGlu {
    static constexpr bool PERM = true, AFTER_DRAIN = false, MID = false;
    const bf16_t* YP; const float* bias; bf16_t* O; int ldo;
    __device__ __forceinline__ void operator()(const f32x4 (&acc)[2][2][4][2], const Unit& u, int wr, int wc, int fr, int fq) const {
        const int row0 = u.pm * BM + wr * 64 + fr, col0 = u.pn * BM + wc * 32 + 8 * fq;
        f32x4 bv[2][2];
#pragma unroll
        for (int bj = 0; bj < 2; ++bj) { bv[bj][0] = *(const f32x4*)(bias + col0 + bj * HALF); bv[bj][1] = *(const f32x4*)(bias + col0 + bj * HALF + 4); }
#pragma unroll
        for (int ai = 0; ai < 2; ++ai) { u32x4 yw[4][2];
#pragma unroll
            for (int m = 0; m < 4; ++m)
#pragma unroll
                for (int bj = 0; bj < 2; ++bj) yw[m][bj] = *(const u32x4*)(YP + (size_t)(row0 + ai * HALF + m * 16) * 1024 + col0 + bj * HALF);
            __builtin_amdgcn_sched_barrier(0);
#pragma unroll
            for (int m = 0; m < 4; ++m)
#pragma unroll
                for (int bj = 0; bj < 2; ++bj) { const u32x4 y = yw[m][bj]; const f32x4 v0 = acc[ai][bj][m][0] + bv[bj][0], v1 = acc[ai][bj][m][1] + bv[bj][1];
                    u32x4 w; w.x = cvt_pk_bf16(bflo(y.x) * sigm(v0[0]), bfhi(y.x) * sigm(v0[1])); w.y = cvt_pk_bf16(bflo(y.y) * sigm(v0[2]), bfhi(y.y) * sigm(v0[3]));
                    w.z = cvt_pk_bf16(bflo(y.z) * sigm(v1[0]), bfhi(y.z) * sigm(v1[1])); w.w = cvt_pk_bf16(bflo(y.w) * sigm(v1[2]), bfhi(y.w) * sigm(v1[3]));
                    *(u32x4*)(O + (size_t)(row0 + ai * HALF + m * 16) * ldo + col0 + bj * HALF) = w; }
            asm volatile("" ::: "memory"); }
    }
};
template <int ST> struct EpiBranch {
    static constexpr bool PERM = true, AFTER_DRAIN = false, MID = false;
    const bf16_t* GT; bf16_t* OUT; const bf16_t* G2;
    __device__ __forceinline__ void operator()(const f32x4 (&acc)[2][2][4][2], const Unit& u, int wr, int wc, int fr, int fq) const {
        const int row0 = u.pm * BM + wr * 64 + fr, col0 = u.pn * BM + wc * 32 + 8 * fq;
        const bool early = (ST == 0) && u.pn < 2; const bf16_t* gbase = early ? G2 : GT; const int gld = early ? 512 : 6144;
#pragma unroll
        for (int ai = 0; ai < 2; ++ai) {
            u32x4 gw[4][2], tw[4][2];
#pragma unroll
            for (int m = 0; m < 4; ++m)
#pragma unroll
                for (int bj = 0; bj < 2; ++bj) { const int r = row0 + ai * HALF + m * 16, c = col0 + bj * HALF;
                    gw[m][bj] = gload16(gbase + (size_t)r * gld + c);
                    if (ST != 0) tw[m][bj] = gload16(OUT + (size_t)r * 2048 + c); }
#pragma unroll
            for (int m = 0; m < 4; ++m)
#pragma unroll
                for (int bj = 0; bj < 2; ++bj) { const int r = row0 + ai * HALF + m * 16, c = col0 + bj * HALF;
                    const u32x4 g = gw[m][bj]; const f32x4 a0 = acc[ai][bj][m][0], a1 = acc[ai][bj][m][1];
                    float v0 = sigm(bflo(g.x)) * a0[0], v1 = sigm(bfhi(g.x)) * a0[1], v2 = sigm(bflo(g.y)) * a0[2], v3 = sigm(bfhi(g.y)) * a0[3];
                    float v4 = sigm(bflo(g.z)) * a1[0], v5 = sigm(bfhi(g.z)) * a1[1], v6 = sigm(bflo(g.w)) * a1[2], v7 = sigm(bfhi(g.w)) * a1[3];
                    if (ST != 0) { const u32x4 t = tw[m][bj]; v0 += bflo(t.x); v1 += bfhi(t.x); v2 += bflo(t.y); v3 += bfhi(t.y); v4 += bflo(t.z); v5 += bfhi(t.z); v6 += bflo(t.w); v7 += bfhi(t.w); }
                    u32x4 w; w.x = cvt_pk_bf16(v0, v1); w.y = cvt_pk_bf16(v2, v3); w.z = cvt_pk_bf16(v4, v5); w.w = cvt_pk_bf16(v6, v7);
                    gstore16(OUT + (size_t)r * 2048 + c, w); }
            asm volatile("" ::: "memory"); }
    }
};

struct EpiBranch3 {
    static constexpr bool PERM = true, AFTER_DRAIN = false, MID = true;
    const bf16_t* GT; const bf16_t* G2; bf16_t* OUT;
    __device__ __forceinline__ u32x4 gate16(int x, int r, int c) const { return (x == 0 && c < 512) ? gload16(G2 + (size_t)r * 512 + c) : gload16(GT + (size_t)r * 6144 + x * 2048 + c); }
    __device__ __forceinline__ void mid(f32x4 (&acc)[2][2][4][2], const Unit& u, int seg, int wr, int wc, int fr, int fq) const {
        int row0 = u.pm * BM + wr * 64 + fr, col0 = u.pn * BM + wc * 32 + 8 * fq; const int x = seg - 1;
        asm volatile("" : "+v"(row0), "+v"(col0));
#pragma unroll
        for (int ai = 0; ai < 2; ++ai) { u32x4 gn[4][2], gd[4][2];
#pragma unroll
            for (int m = 0; m < 4; ++m)
#pragma unroll
                for (int bj = 0; bj < 2; ++bj) { const int r = row0 + ai * HALF + m * 16, c = col0 + bj * HALF; gn[m][bj] = gate16(x, r, c); gd[m][bj] = gate16(x + 1, r, c); }
            __builtin_amdgcn_sched_barrier(0);
#pragma unroll
            for (int m = 0; m < 4; ++m)
#pragma unroll
                for (int bj = 0; bj < 2; ++bj) { const u32x4 a = gn[m][bj], b = gd[m][bj];
#define CL4(X) (f32x4){__builtin_amdgcn_fmed3f(X[0], -30.f, 30.f), __builtin_amdgcn_fmed3f(X[1], -30.f, 30.f), __builtin_amdgcn_fmed3f(X[2], -30.f, 30.f), __builtin_amdgcn_fmed3f(X[3], -30.f, 30.f)}
#define EX4(X) (f32x4){__builtin_amdgcn_exp2f(X[0]), __builtin_amdgcn_exp2f(X[1]), __builtin_amdgcn_exp2f(X[2]), __builtin_amdgcn_exp2f(X[3])}
#define RC4(X) (f32x4){__builtin_amdgcn_rcpf(X[0]), __builtin_amdgcn_rcpf(X[1]), __builtin_amdgcn_rcpf(X[2]), __builtin_amdgcn_rcpf(X[3])}
                    const f32x4 a0 = (f32x4){bflo(a.x), bfhi(a.x), bflo(a.y), bfhi(a.y)}, a1 = (f32x4){bflo(a.z), bfhi(a.z), bflo(a.w), bfhi(a.w)};
                    const f32x4 b0 = (f32x4){bflo(b.x), bfhi(b.x), bflo(b.y), bfhi(b.y)}, b1 = (f32x4){bflo(b.z), bfhi(b.z), bflo(b.w), bfhi(b.w)};
                    const f32x4 za0 = CL4(a0) * -1.4426950408889634f, za1 = CL4(a1) * -1.4426950408889634f, zb0 = CL4(b0) * -1.4426950408889634f, zb1 = CL4(b1) * -1.4426950408889634f;
                    const f32x4 da0 = EX4(za0) + 1.f, da1 = EX4(za1) + 1.f, nb0 = EX4(zb0) + 1.f, nb1 = EX4(zb1) + 1.f;
                    acc[ai][bj][m][0] *= nb0 * RC4(da0); acc[ai][bj][m][1] *= nb1 * RC4(da1);
#undef CL4
#undef EX4
#undef RC4
                }
            asm volatile("" ::: "memory"); }
    }
    __device__ __forceinline__ void operator()(const f32x4 (&acc)[2][2][4][2], const Unit& u, int wr, int wc, int fr, int fq) const {
        int row0 = u.pm * BM + wr * 64 + fr, col0 = u.pn * BM + wc * 32 + 8 * fq; asm volatile("" : "+v"(row0), "+v"(col0));
#pragma unroll
        for (int ai = 0; ai < 2; ++ai) { u32x4 gw[4][2];
#pragma unroll
            for (int m = 0; m < 4; ++m)
#pragma unroll
                for (int bj = 0; bj < 2; ++bj) gw[m][bj] = gate16(2, row0 + ai * HALF + m * 16, col0 + bj * HALF);
            __builtin_amdgcn_sched_barrier(0);
#pragma unroll
            for (int m = 0; m < 4; ++m)
#pragma unroll
                for (int bj = 0; bj < 2; ++bj) { const u32x4 g = gw[m][bj]; const f32x4 a0 = acc[ai][bj][m][0], a1 = acc[ai][bj][m][1];
                    u32x4 w; w.x = cvt_pk_bf16(sigm(bflo(g.x)) * a0[0], sigm(bfhi(g.x)) * a0[1]); w.y = cvt_pk_bf16(sigm(bflo(g.y)) * a0[2], sigm(bfhi(g.y)) * a0[3]);
                    w.z = cvt_pk_bf16(sigm(bflo(g.z)) * a1[0], sigm(bfhi(g.z)) * a1[1]); w.w = cvt_pk_bf16(sigm(bflo(g.w)) * a1[2], sigm(bfhi(g.w)) * a1[3]);
                    gstore16(OUT + (size_t)(row0 + ai * HALF + m * 16) * 2048 + col0 + bj * HALF, w); }
            asm volatile("" ::: "memory"); }
    }
};
#define DPPF(T, S, W, CTL) "v_fmac_f32_dpp %[" #T "], %[" #S "], %[" #W "] " CTL " row_mask:0xf bank_mask:0xf\n\t"
__device__ __forceinline__ void conv_taps(f32x4& t, const f32x4 c, const f32x4 p, const f32x4 x, const f32x4 a, const f32x4 b, bool hasp, bool hasn) {
    float t0 = t[0], t1 = t[1], t2 = t[2], t3 = t[3];
    asm("s_nop 1\n\t"
        DPPF(t0, c0, a0, "row_shr:1") DPPF(t1, c1, a1, "row_shr:1") DPPF(t2, c2, a2, "row_shr:1") DPPF(t3, c3, a3, "row_shr:1")
        DPPF(t0, c0, b0, "row_shl:1") DPPF(t1, c1, b1, "row_shl:1") DPPF(t2, c2, b2, "row_shl:1") DPPF(t3, c3, b3, "row_shl:1")
        : [t0] "+v"(t0), [t1] "+v"(t1), [t2] "+v"(t2), [t3] "+v"(t3)
        : [c0] "v"(c[0]), [c1] "v"(c[1]), [c2] "v"(c[2]), [c3] "v"(c[3]), [a0] "v"(a[0]), [a1] "v"(a[1]), [a2] "v"(a[2]), [a3] "v"(a[3]), [b0] "v"(b[0]), [b1] "v"(b[1]), [b2] "v"(b[2]), [b3] "v"(b[3]));
    if (hasp) asm("s_nop 1\n\t" DPPF(t0, c0, a0, "row_shl:15") DPPF(t1, c1, a1, "row_shl:15") DPPF(t2, c2, a2, "row_shl:15") DPPF(t3, c3, a3, "row_shl:15")
        : [t0] "+v"(t0), [t1] "+v"(t1), [t2] "+v"(t2), [t3] "+v"(t3) : [c0] "v"(p[0]), [c1] "v"(p[1]), [c2] "v"(p[2]), [c3] "v"(p[3]), [a0] "v"(a[0]), [a1] "v"(a[1]), [a2] "v"(a[2]), [a3] "v"(a[3]));
    if (hasn) asm("s_nop 1\n\t" DPPF(t0, c0, a0, "row_shr:15") DPPF(t1, c1, a1, "row_shr:15") DPPF(t2, c2, a2, "row_shr:15") DPPF(t3, c3, a3, "row_shr:15")
        : [t0] "+v"(t0), [t1] "+v"(t1), [t2] "+v"(t2), [t3] "+v"(t3) : [c0] "v"(x[0]), [c1] "v"(x[1]), [c2] "v"(x[2]), [c3] "v"(x[3]), [a0] "v"(b[0]), [a1] "v"(b[1]), [a2] "v"(b[2]), [a3] "v"(b[3]));
    t[0] = t0; t[1] = t1; t[2] = t2; t[3] = t3;
}
#undef DPPF
template <int CTRL> __device__ __forceinline__ float dppk(float oldv, float src) {
    return __builtin_bit_cast(float, __builtin_amdgcn_update_dpp(__builtin_bit_cast(int, oldv), __builtin_bit_cast(int, src), CTRL, 0xf, 0xf, false)); }
struct EpiUpConv {
    static constexpr bool PERM = true, AFTER_DRAIN = false, MID = false;
    const float* cw; const float* cb; bf16_t* AF; float* HALO; PG8_LAS float* xch;
    __device__ __forceinline__ void operator()(f32x4 (&acc)[2][2][4][2], const Unit& u, int wr, int wc, int fr, int fq) const {
        const int colL = wc * 32 + fq * 8;
#pragma unroll
        for (int ai = 0; ai < 2; ++ai) { const int blk = 2 * ai + wr;
            if (fr == 0) {
#pragma unroll
                for (int bj = 0; bj < 2; ++bj)
#pragma unroll
                    for (int n = 0; n < 2; ++n) *(PG8_LAS f32x4*)(xch + (blk * 2 + 0) * 256 + bj * 128 + colL + 4 * n) = acc[ai][bj][0][n]; }
            if (fr == 15) {
#pragma unroll
                for (int bj = 0; bj < 2; ++bj)
#pragma unroll
                    for (int n = 0; n < 2; ++n) *(PG8_LAS f32x4*)(xch + (blk * 2 + 1) * 256 + bj * 128 + colL + 4 * n) = acc[ai][bj][3][n]; } }
        if (u.pm >= 32) {
            if (wr == 0 && fr < 2) { float* hp = HALO + ((size_t)(u.pm * 4 + fr)) * 11264 + u.pn * 256 + colL;
#pragma unroll
                for (int bj = 0; bj < 2; ++bj)
#pragma unroll
                    for (int n = 0; n < 2; ++n) *(f32x4*)(hp + bj * 128 + 4 * n) = acc[0][bj][0][n]; }
            if (wr == 1 && fr >= 14) { float* hp = HALO + ((size_t)(u.pm * 4 + 2 + (fr - 14))) * 11264 + u.pn * 256 + colL;
#pragma unroll
                for (int bj = 0; bj < 2; ++bj)
#pragma unroll
                    for (int n = 0; n < 2; ++n) *(f32x4*)(hp + bj * 128 + 4 * n) = acc[1][bj][3][n]; }
        }
        asm volatile("s_waitcnt lgkmcnt(0)" ::: "memory"); __builtin_amdgcn_s_barrier(); asm volatile("" ::: "memory");
#pragma unroll
        for (int ai = 0; ai < 2; ++ai) { const int blk = 2 * ai + wr;
#pragma unroll
            for (int bj = 0; bj < 2; ++bj)
#pragma unroll
                for (int n = 0; n < 2; ++n) { const int ch = bj * 5632 + 128 * u.pn + colL + 4 * n;
                    const f32x4 w0 = *(const f32x4*)(cw + ch), w1 = *(const f32x4*)(cw + 11264 + ch), w2 = *(const f32x4*)(cw + 2 * 11264 + ch), bb = *(const f32x4*)(cb + ch);
                    f32x4 xu = (f32x4){0.f, 0.f, 0.f, 0.f}, xd = (f32x4){0.f, 0.f, 0.f, 0.f};
                    if (fr == 0 && blk > 0) xu = *(const PG8_LAS f32x4*)(xch + ((blk - 1) * 2 + 1) * 256 + bj * 128 + colL + 4 * n);
                    if (fr == 15 && blk < 3) xd = *(const PG8_LAS f32x4*)(xch + ((blk + 1) * 2 + 0) * 256 + bj * 128 + colL + 4 * n);
                    f32x4 y[4];
#pragma unroll
                    for (int m = 0; m < 4; ++m) { const f32x4 cur = acc[ai][bj][m][n]; f32x4 t;
                        t = w1 * cur + bb;
                        if (m == 0) t = w0 * xu + t;
                        if (m == 3) t = w2 * xd + t;
                        conv_taps(t, cur, acc[ai][bj][m > 0 ? m - 1 : 0][n], acc[ai][bj][m < 3 ? m + 1 : 3][n], w0, w2, m > 0, m < 3);
                        y[m] = t; }
#pragma unroll
                    for (int m = 0; m < 4; ++m) acc[ai][bj][m][n] = y[m];
                    asm volatile("" : "+v"(acc[ai][bj][0][n]), "+v"(acc[ai][bj][1][n]), "+v"(acc[ai][bj][2][n]), "+v"(acc[ai][bj][3][n]) :: "memory"); } }
#pragma unroll
        for (int ai = 0; ai < 2; ++ai)
#pragma unroll
            for (int m = 0; m < 4; ++m) { const int r = u.pm * BM + ai * HALF + wr * 64 + m * 16 + fr;
                const f32x4 v0 = acc[ai][0][m][0], v1 = acc[ai][0][m][1], g0 = acc[ai][1][m][0], g1 = acc[ai][1][m][1];
                const f32x4 p0 = g0 * v0, p1 = g1 * v1, z0 = g0 * -1.4426950408889634f, z1 = g1 * -1.4426950408889634f;
                f32x4 e0, e1;
#pragma unroll
                for (int e = 0; e < 4; ++e) { e0[e] = __builtin_amdgcn_exp2f(z0[e]); e1[e] = __builtin_amdgcn_exp2f(z1[e]); }
                e0 = e0 + 1.f; e1 = e1 + 1.f;
#pragma unroll
                for (int e = 0; e < 4; ++e) { e0[e] = __builtin_amdgcn_rcpf(e0[e]); e1[e] = __builtin_amdgcn_rcpf(e1[e]); }
                const f32x4 s0 = p0 * e0, s1 = p1 * e1;
                u32x4 w; w.x = cvt_pk_bf16(s0[0], s0[1]); w.y = cvt_pk_bf16(s0[2], s0[3]); w.z = cvt_pk_bf16(s1[0], s1[1]); w.w = cvt_pk_bf16(s1[2], s1[3]);
                gstore16(AF + (size_t)r * 5632 + 128 * u.pn + colL, w); }
    }
};

template <class Epi, class Sched, bool ALIGN_EPI = false, bool SP2 = false>
__device__ __forceinline__ void gemm_phase(PG8_LAS unsigned char* lds, const Gemm g, const Sched& S, const Epi& E) {
    int tid = threadIdx.x; asm volatile("" : "+v"(tid));
    const int wid = __builtin_amdgcn_readfirstlane(tid >> 6), lane = tid & 63, wr = wid >> 2, wc = wid & 3, fr = lane & 15, fq = lane >> 4;
    const int K = g.K, nt = K / BK;
    unsigned voffA[2], voffB[2];
#pragma unroll
    for (int i = 0; i < 2; ++i) { int R, C; stage_rc(tid * 16 + i * 8192, R, C); const int Rb = Epi::PERM ? ((R & ~31) + perm32(R & 31)) : R;
        voffA[i] = (unsigned)(R * g.lda + C) * 2u; voffB[i] = (unsigned)(Rb * g.ldb + C) * 2u; }
    const size_t kstep = (size_t)(BK * 2);
    const size_t hstepA = (size_t)HALF * g.lda * 2, hstepB = (size_t)HALF * g.ldb * 2;
    const size_t tstepA = 2 * hstepA, tstepB = 2 * hstepB;
    const unsigned ldsw = (unsigned)wid * 1024u;
    const int aoff = lds_byte(wr * 64 + fr, fq * 8), boff = lds_byte(wc * 32 + fr, fq * 8);
#define PG8_SA(b, h) (((b) * 2 + (h)) * HTB)
#define PG8_SB(b, h) ((4 + (b) * 2 + (h)) * HTB)
#define PG8_STAGE(bufoff, gbase, voff) do { _Pragma("unroll") for (int _i = 0; _i < 2; ++_i) \
        __builtin_amdgcn_global_load_lds((const unsigned*)((const char*)(gbase) + (voff)[_i]), (PG8_LAS unsigned*)(lds + (bufoff) + ldsw + _i * 8192), 16, 0, 0); } while (0)
#define PG8_LDA(dst, b, h) do { _Pragma("unroll") for (int m = 0; m < 4; ++m) _Pragma("unroll") for (int k = 0; k < 2; ++k) dst[m][k] = *(const PG8_LAS bf16x8*)(lds + PG8_SA(b, h) + aoff + m * 2048 + k * 1024); } while (0)
#define PG8_LDB(dst, b, h) do { _Pragma("unroll") for (int n = 0; n < 2; ++n) _Pragma("unroll") for (int k = 0; k < 2; ++k) dst[n][k] = *(const PG8_LAS bf16x8*)(lds + PG8_SB(b, h) + boff + n * 2048 + k * 1024); } while (0)
#define PG8_MMA(ai, bj, At, Bt) do { __builtin_amdgcn_s_setprio(1); _Pragma("unroll") for (int m = 0; m < 4; ++m) _Pragma("unroll") for (int n = 0; n < 2; ++n) _Pragma("unroll") for (int k = 0; k < 2; ++k) \
        acc[ai][bj][m][n] = __builtin_amdgcn_mfma_f32_16x16x32_bf16(Bt[n][k], At[m][k], acc[ai][bj][m][n], 0, 0, 0); __builtin_amdgcn_s_setprio(0); } while (0)
#define PG8_WAIT_V(n) asm volatile("s_waitcnt vmcnt(" #n ")" ::: "memory")
#define PG8_WAIT_L(n) asm volatile("s_waitcnt lgkmcnt(" #n ")" ::: "memory")
#define PG8_BAR __builtin_amdgcn_s_barrier()
#define PG8_SCHED __builtin_amdgcn_sched_barrier(0)
    Unit cur, nxt; int ui = 0;
    if (!S.next(0, cur)) return;
    f32x4 acc[2][2][4][2];
#pragma unroll
    for (int a = 0; a < 2; ++a)
#pragma unroll
        for (int b = 0; b < 2; ++b)
#pragma unroll
            for (int m = 0; m < 4; ++m)
#pragma unroll
                for (int n = 0; n < 2; ++n) acc[a][b][m][n] = (f32x4){0.f, 0.f, 0.f, 0.f};
    bf16x8 At[4][2], B0[2][2], B1[2][2];
    const char* cA = (const char*)g.A + (size_t)cur.pm * tstepA; const char* cB = (const char*)g.Bt + (size_t)cur.pn * tstepB;
    S.a_ready(cur);
    if constexpr (SP2) {
        PG8_STAGE(PG8_SB(0, 0), cB, voffB); PG8_STAGE(PG8_SB(0, 1), cB + hstepB, voffB); PG8_STAGE(PG8_SA(0, 0), cA, voffA); PG8_STAGE(PG8_SA(0, 1), cA + hstepA, voffA);
        PG8_STAGE(PG8_SB(1, 0), cB + kstep, voffB); PG8_STAGE(PG8_SA(1, 0), cA + kstep, voffA); PG8_STAGE(PG8_SB(1, 1), cB + hstepB + kstep, voffB);
        if (wr == 1) PG8_BAR;
        PG8_WAIT_V(8); PG8_BAR;
        PG8_WAIT_V(6); PG8_BAR;
    } else {
        PG8_STAGE(PG8_SB(0, 0), cB, voffB); PG8_STAGE(PG8_SA(0, 0), cA, voffA); PG8_STAGE(PG8_SB(0, 1), cB + hstepB, voffB); PG8_STAGE(PG8_SA(0, 1), cA + hstepA, voffA);
        if (wr == 1) PG8_BAR;
        PG8_WAIT_V(4); PG8_BAR;
        PG8_STAGE(PG8_SB(1, 0), cB + kstep, voffB); PG8_STAGE(PG8_SA(1, 0), cA + kstep, voffA); PG8_STAGE(PG8_SB(1, 1), cB + hstepB + kstep, voffB);
        PG8_WAIT_V(6); PG8_BAR;
    }
    for (;;) {
        const bool has_next = S.next(ui + 1, nxt);
        const char* nA = has_next ? (const char*)g.A + (size_t)nxt.pm * tstepA : cA; const char* nB = has_next ? (const char*)g.Bt + (size_t)nxt.pn * tstepB : cB;
        for (int t = 0; t < nt; t += 2) {
            const bool last = (t == nt - 2);
            const char* a1 = cA + (size_t)(t + 1) * kstep;
            const char* a2 = last ? nA : cA + (size_t)(t + 2) * kstep; const char* b2 = last ? nB : cB + (size_t)(t + 2) * kstep;
            const char* a3 = a2 + kstep; const char* b3 = b2 + kstep;
            if constexpr (Epi::MID) { if (t == 16 || t == 32) E.mid(acc, cur, t >> 4, wr, wc, fr, fq); }
            if (last && has_next) S.a_ready(nxt);
            if constexpr (SP2) {
            PG8_LDB(B0, 0, 0); PG8_LDB(B1, 0, 1); PG8_SCHED; PG8_LDA(At, 0, 0); PG8_STAGE(PG8_SA(1, 1), a1 + hstepA, voffA);
            PG8_WAIT_V(8); PG8_WAIT_L(0); PG8_BAR; PG8_MMA(0, 0, At, B0); PG8_MMA(0, 1, At, B1); PG8_BAR; PG8_SCHED;
            PG8_LDA(At, 0, 1); PG8_STAGE(PG8_SB(0, 0), b2, voffB); PG8_STAGE(PG8_SB(0, 1), b2 + hstepB, voffB); PG8_STAGE(PG8_SA(0, 0), a2, voffA);
            PG8_WAIT_V(8); PG8_WAIT_L(0); PG8_BAR; PG8_MMA(1, 0, At, B0); PG8_MMA(1, 1, At, B1); PG8_BAR; PG8_SCHED;
            PG8_LDB(B0, 1, 0); PG8_LDB(B1, 1, 1); PG8_SCHED; PG8_LDA(At, 1, 0); PG8_STAGE(PG8_SA(0, 1), a2 + hstepA, voffA);
            PG8_WAIT_V(8); PG8_WAIT_L(0); PG8_BAR; PG8_MMA(0, 0, At, B0); PG8_MMA(0, 1, At, B1); PG8_BAR; PG8_SCHED;
            PG8_LDA(At, 1, 1); PG8_STAGE(PG8_SB(1, 0), b3, voffB); PG8_STAGE(PG8_SB(1, 1), b3 + hstepB, voffB); PG8_STAGE(PG8_SA(1, 0), a3, voffA);
            PG8_WAIT_V(8); PG8_WAIT_L(0); PG8_BAR; PG8_MMA(1, 0, At, B0); PG8_MMA(1, 1, At, B1); PG8_BAR; PG8_SCHED;
            } else {
            PG8_LDB(B0, 0, 0); PG8_SCHED; PG8_LDA(At, 0, 0); PG8_STAGE(PG8_SA(1, 1), a1 + hstepA, voffA);
            PG8_WAIT_L(8); PG8_BAR; PG8_WAIT_L(0); PG8_MMA(0, 0, At, B0); PG8_BAR; PG8_SCHED;
            PG8_LDB(B1, 0, 1); PG8_STAGE(PG8_SB(0, 0), b2, voffB);
            PG8_BAR; PG8_WAIT_L(0); PG8_MMA(0, 1, At, B1); PG8_BAR;
            PG8_LDA(At, 0, 1); PG8_STAGE(PG8_SA(0, 0), a2, voffA);
            PG8_BAR; PG8_WAIT_L(0); PG8_MMA(1, 0, At, B0); PG8_BAR; PG8_SCHED;
            PG8_STAGE(PG8_SB(0, 1), b2 + hstepB, voffB);
            PG8_WAIT_V(6); PG8_BAR; PG8_MMA(1, 1, At, B1); PG8_BAR;
            PG8_LDB(B0, 1, 0); PG8_SCHED; PG8_LDA(At, 1, 0); PG8_STAGE(PG8_SA(0, 1), a2 + hstepA, voffA);
            PG8_WAIT_L(8); PG8_BAR; PG8_WAIT_L(0); PG8_MMA(0, 0, At, B0); PG8_BAR; PG8_SCHED;
            PG8_LDB(B1, 1, 1); PG8_STAGE(PG8_SB(1, 0), b3, voffB);
            PG8_BAR; PG8_WAIT_L(0); PG8_MMA(0, 1, At, B1); PG8_BAR;
            PG8_LDA(At, 1, 1); PG8_STAGE(PG8_SA(1, 0), a3, voffA);
            PG8_BAR; PG8_WAIT_L(0); PG8_MMA(1, 0, At, B0); PG8_BAR; PG8_SCHED;
            PG8_STAGE(PG8_SB(1, 1), b3 + hstepB, voffB);
            PG8_WAIT_V(6); PG8_BAR; PG8_MMA(1, 1, At, B1); PG8_BAR;
            }
        }
        if constexpr (ALIGN_EPI) { if (wr == 0) PG8_BAR; }
        if constexpr (!Epi::AFTER_DRAIN) { E(acc, cur, wr, wc, fr, fq); S.done(cur); }
        if (!has_next) break;
#pragma unroll
        for (int a = 0; a < 2; ++a)
#pragma unroll
            for (int b = 0; b < 2; ++b)
#pragma unroll
                for (int m = 0; m < 4; ++m)
#pragma unroll
                    for (int n = 0; n < 2; ++n) acc[a][b][m][n] = (f32x4){0.f, 0.f, 0.f, 0.f};
        cur = nxt; cA = nA; cB = nB; ++ui;
        if constexpr (ALIGN_EPI) { if (wr == 1) PG8_BAR; }
    }
    PG8_WAIT_V(0);
    if constexpr (!ALIGN_EPI) { if (wr == 0) PG8_BAR; }
    PG8_BAR;
    if constexpr (Epi::AFTER_DRAIN) { E.fused(acc, cur, wr, wc, fr, fq, lds, wid, lane); S.done(cur); }
#undef PG8_SA
#undef PG8_SB
#undef PG8_STAGE
#undef PG8_LDA
#undef PG8_LDB
#undef PG8_MMA
#undef PG8_WAIT_V
#undef PG8_WAIT_L
#undef PG8_BAR
#undef PG8_SCHED
}
}
using namespace pg8;
#define LAS __attribute__((address_space(3)))
constexpr int DM = 2048, M = 16384, MPR = 8192, MK = M + 512;
constexpr int NMOD = 12288, NIN = 12608, NP2 = 6656, NP2REAL = 6464, NGATE = 6144, NINT = 12800;
constexpr int DFF = 5632, DFF2 = 11264;
constexpr float EPS = 1e-6f;
constexpr size_t O_CKV = 33554432, O_KR = 41943040, O_RF = 42991616, O_RB = 51380224, O_SF = 59768832, O_SB = 60293120, O_END = 60817408;
constexpr size_t MiB = 1u << 20;
constexpr size_t WS_CTL = 0;
constexpr size_t WS_MODS = 1 * MiB, WS_ROPE = 2 * MiB, WS_ABT = 3 * MiB, WS_R1 = 3 * MiB + 524288;
constexpr size_t WS_WIN = 4 * MiB, WS_WGLU = 54 * MiB, WS_WUQ = 56 * MiB, WS_WKV = 59 * MiB, WS_WBR = 61 * MiB, WS_WOUT = 73 * MiB, WS_WUP = 81 * MiB, WS_WDN = 125 * MiB, WS_BTY = 147 * MiB, WS_BTE = 195 * MiB;
constexpr size_t PO = 212 * MiB;
constexpr size_t WS_H = PO, WS_UG = PO + 64 * MiB, WS_Q = PO + 112 * MiB, WS_K = PO + 144 * MiB, WS_V = PO + 176 * MiB, WS_G = PO + 208 * MiB, WS_CQ = PO + 240 * MiB, WS_CKV = PO + 264 * MiB, WS_KR = PO + 281 * MiB;
constexpr size_t WS_ELOC = PO + 284 * MiB, WS_LRET = PO + 316 * MiB, WS_SRET = PO + 444 * MiB, WS_QMLA = PO + 508 * MiB, WS_KVMLA = PO + 556 * MiB;
constexpr size_t WS_YAP = PO + 240 * MiB, WS_Y3 = PO + 284 * MiB, WS_GATES = PO + 380 * MiB;
constexpr int LDY3 = 3072;
constexpr size_t WS_MTMP = PO + 64 * MiB, WS_MERGED = PO + 192 * MiB, WS_MO = PO + 284 * MiB, WS_UF = PO + 64 * MiB, WS_AF = PO + 416 * MiB, WS_DN = PO + 64 * MiB;
constexpr size_t WS_HALO = PO + 200 * MiB;
constexpr size_t WS_G2 = PO + 622 * MiB;
constexpr size_t WS_END = PO + 638 * MiB;
constexpr int CW_BAR = 4096;
constexpr int RING_BYTES = 131072, MISC_OFF = RING_BYTES + 320, XCH_OFF = RING_BYTES + 1024, LDS_BYTES = 147456;

#define XB_TMO      128
#define XB_XCNT(j)  (256  + 64 * (j))
#define XB_XSUB(j)  (1280 + 64 * (j))
#define XB_XGEN(j)  (2304 + 64 * (j))
#define XB_TOP      3328
#define XB_TOPGEN   3392
#define XCD_BAR_WORDS 3456
#define XB_SPIN_CAP (1u << 18)

__device__ __forceinline__ unsigned xb_ld(unsigned* p)              { return __hip_atomic_load(p, __ATOMIC_RELAXED, __HIP_MEMORY_SCOPE_AGENT); }
__device__ __forceinline__ unsigned xb_add(unsigned* p, unsigned v) { return __hip_atomic_fetch_add(p, v, __ATOMIC_RELAXED, __HIP_MEMORY_SCOPE_AGENT); }
__device__ __forceinline__ unsigned xb_xcc_id() { return (unsigned)__builtin_amdgcn_s_getreg((3 << 11) | 20) & 0xFu; }
#define XB_SPIN(cond, bar) do { unsigned _sp = 0; while (cond) { __builtin_amdgcn_s_sleep(1); \
    if ((++_sp & 255u) == 0u) { if (xb_ld(&(bar)[XB_TMO])) break; if (_sp > XB_SPIN_CAP) { atomicAdd(&(bar)[XB_TMO], 1u); break; } } } } while (0)

struct XcdBarrier {
    unsigned* bar; unsigned x;
    volatile LAS unsigned* st;
};

__device__ __forceinline__ XcdBarrier xcd_barrier_post(unsigned* bar, volatile LAS unsigned* st) {
    XcdBarrier b; b.bar = bar; b.x = xb_xcc_id(); b.st = st;
    if (threadIdx.x == 0) (void)xb_add(&bar[XB_XCNT(b.x)], 1u);
    return b;
}
__device__ __forceinline__ void xcd_barrier_complete(unsigned* bar, unsigned x, unsigned& nloc, unsigned& nx) {
    const unsigned G = gridDim.x * gridDim.y * gridDim.z;
    unsigned sum, cnt, mine, sp = 0u;
    for (;;) {
        sum = 0u; cnt = 0u; mine = 0u;
#pragma unroll
        for (unsigned j = 0; j < 16; ++j) { const unsigned c = xb_ld(&bar[XB_XCNT(j)]); sum += c; cnt += (c > 0u) ? 1u : 0u; mine = (j == x) ? c : mine; }
        if (sum == G) break;
        __builtin_amdgcn_s_sleep(1);
        if ((++sp & 255u) == 0u) { if (xb_ld(&bar[XB_TMO])) break; if (sp > XB_SPIN_CAP) { atomicAdd(&bar[XB_TMO], 1u); break; } }
    }
    nloc = mine > 0u ? mine : 1u; nx = cnt > 0u ? cnt : 1u;
}

__device__ __forceinline__ void xcd_barrier(const XcdBarrier& b) {
    asm volatile("s_waitcnt vmcnt(0)" ::: "memory");
    __syncthreads();
    if (threadIdx.x == 0) {
        unsigned* bar = b.bar;
        __builtin_amdgcn_s_waitcnt(0);
        unsigned nloc = b.st[0], nx = b.st[1];
        if (nloc == 0u) { xcd_barrier_complete(bar, b.x, nloc, nx); b.st[0] = nloc; b.st[1] = nx; }
        const unsigned old = xb_add(&bar[XB_XSUB(b.x)], 1u);
        const unsigned gen = old / nloc;
        if (old + 1u == (gen + 1u) * nloc) {
            __builtin_amdgcn_fence(__ATOMIC_RELEASE, "agent");
            asm volatile("s_waitcnt vmcnt(0)" ::: "memory");
            const unsigned og = xb_add(&bar[XB_TOP], 1u);
            const unsigned tg = og / nx;
            if (og + 1u == (tg + 1u) * nx) xb_add(&bar[XB_TOPGEN], 1u);
            else XB_SPIN(xb_ld(&bar[XB_TOPGEN]) == tg, bar);
            __builtin_amdgcn_fence(__ATOMIC_ACQUIRE, "agent");
            xb_add(&bar[XB_XGEN(b.x)], 1u);
            asm volatile("s_waitcnt vmcnt(0)" ::: "memory");
        } else {
            XB_SPIN(xb_ld(&bar[XB_XGEN(b.x)]) == gen, bar);
            __builtin_amdgcn_fence(__ATOMIC_ACQUIRE, "agent");
            asm volatile("s_waitcnt vmcnt(0)" ::: "memory");
        }
    }
    __syncthreads();
}

__device__ __forceinline__ float wave_sum(float v) {
#pragma unroll
    for (int o = 1; o < 64; o <<= 1) v += __shfl_xor(v, o);
    return v;
}
__device__ __forceinline__ void* opaque_uniform(void* p) {
    unsigned lo32 = (unsigned)(uintptr_t)p, hi32 = (unsigned)((uintptr_t)p >> 32); asm volatile("" : "+v"(lo32), "+v"(hi32));
    lo32 = __builtin_amdgcn_readfirstlane(lo32); hi32 = __builtin_amdgcn_readfirstlane(hi32);
    return (void*)(((uintptr_t)hi32 << 32) | (uintptr_t)lo32);
}
struct Ctx {
    unsigned char* lds; unsigned char* ws; float* out; const float* const* in;
    int G, bid;
};
typedef float f32x2 __attribute__((ext_vector_type(2)));

struct TrItem { const float* W; bf16_t* WT; int ldw, K; };
__device__ __forceinline__ void tr_load(const TrItem& t, int lane, f32x4 (&v)[8]) {
    const float* p = t.W + (size_t)(lane >> 3) * t.ldw + (lane & 7) * 4;
#pragma unroll
    for (int i = 0; i < 8; ++i) v[i] = __builtin_nontemporal_load((const f32x4*)(p + (size_t)(8 * i) * t.ldw));
}
__device__ __forceinline__ void tr_store(const TrItem& t, int lane, const f32x4 (&v)[8], float* scr) {
    const int kl = lane >> 3, n4 = (lane & 7) * 4;
#pragma unroll
    for (int i = 0; i < 8; ++i) { float* d = scr + (8 * i + kl) * 33 + n4; d[0] = v[i][0]; d[1] = v[i][1]; d[2] = v[i][2]; d[3] = v[i][3]; }
    asm volatile("s_waitcnt lgkmcnt(0)" ::: "memory");
    const int c = lane & 7;
#pragma unroll
    for (int j = 0; j < 4; ++j) { const int n = (lane >> 3) + 8 * j; const float* s = scr + (8 * c) * 33 + n;
        u32x4 o; o.x = cvt_pk_bf16(s[0 * 33], s[1 * 33]); o.y = cvt_pk_bf16(s[2 * 33], s[3 * 33]); o.z = cvt_pk_bf16(s[4 * 33], s[5 * 33]); o.w = cvt_pk_bf16(s[6 * 33], s[7 * 33]);
        __builtin_nontemporal_store(o, (u32x4*)(t.WT + (size_t)n * t.K + 8 * c)); }
    asm volatile("s_waitcnt lgkmcnt(0)" ::: "memory");
}
constexpr int TI0 = 32 * 202, TI1 = 32 * 192, TI2 = 16 * 32, TI3 = 12 * 48, TI4 = 8 * 32, TI5 = 8 * 32, TI6 = 3 * 16 * 64, TI7 = 32 * 64, TI8 = 32 * 352, TI9 = 88 * 64;
constexpr int TNIT = TI0 + TI1 + TI2 + TI3 + TI4 + TI5 + TI6 + TI7 + TI8 + TI9;
__device__ __forceinline__ TrItem tr_decode(const Ctx& X, int l, int r) {
    const float* W; bf16_t* WT; int ldw, K, kb, sc, dr;
    if (r < TI0) { W = X.in[13] + (size_t)l * 2048 * NIN; WT = (bf16_t*)(X.ws + WS_WIN); ldw = NIN; K = 2048; kb = r / 202; sc = dr = (r % 202) * 32; }
    else if ((r -= TI0) < TI1) { W = X.in[13] + (size_t)l * 2048 * NIN + NP2REAL; WT = (bf16_t*)(X.ws + WS_WIN) + (size_t)NP2 * 2048; ldw = NIN; K = 2048; kb = r / 192; sc = dr = (r % 192) * 32; }
    else if ((r -= TI1) < TI2) { W = X.in[22] + (size_t)l * 1024 * 1024; WT = (bf16_t*)(X.ws + WS_WGLU); ldw = 1024; K = 1024; kb = r / 32; sc = dr = (r % 32) * 32; }
    else if ((r -= TI2) < TI3) { W = X.in[28] + (size_t)l * 768 * 1536; WT = (bf16_t*)(X.ws + WS_WUQ); ldw = 1536; K = 768; kb = r / 48; sc = dr = (r % 48) * 32; }
    else if ((r -= TI3) < TI4) { W = X.in[29] + (size_t)l * 512 * 1024; WT = (bf16_t*)(X.ws + WS_WKV); ldw = 1024; K = 512; kb = r / 32; sc = dr = (r % 32) * 32; }
    else if ((r -= TI4) < TI5) { W = X.in[30] + (size_t)l * 512 * 1024; WT = (bf16_t*)(X.ws + WS_WKV) + (size_t)1024 * 512; ldw = 1024; K = 512; kb = r / 32; sc = dr = (r % 32) * 32; }
    else if ((r -= TI5) < TI6) { const int x = r / 1024, rr = r % 1024; W = X.in[31] + ((size_t)l * 3 + x) * 1024 * 2048; WT = (bf16_t*)(X.ws + WS_WBR) + (size_t)x * 1024; ldw = 2048; K = 3072; kb = rr / 64; sc = dr = (rr % 64) * 32; }
    else if ((r -= TI6) < TI7) { W = X.in[32] + (size_t)l * 2048 * 2048; WT = (bf16_t*)(X.ws + WS_WOUT); ldw = 2048; K = 2048; kb = r / 64; sc = dr = (r % 64) * 32; }
    else if ((r -= TI7) < TI8) { W = X.in[33] + (size_t)l * 2048 * DFF2; WT = (bf16_t*)(X.ws + WS_WUP); ldw = DFF2; K = 2048; kb = r / 352; sc = (r % 352) * 32;
        const int half = sc >= DFF ? 1 : 0, wi = sc - half * DFF; dr = (wi >> 7) * 256 + half * 128 + (wi & 127); }
    else { r -= TI8; W = X.in[36] + (size_t)l * DFF * 2048; WT = (bf16_t*)(X.ws + WS_WDN); ldw = 2048; K = DFF; kb = r / 64; sc = dr = (r % 64) * 32; }
    TrItem t; t.W = W + (size_t)(64 * kb) * ldw + sc; t.WT = WT + (size_t)dr * K + 64 * kb; t.ldw = ldw; t.K = K; return t;
}

__device__ __forceinline__ void phase_pre(const Ctx& X, int l) {
    int tid = threadIdx.x; asm volatile("" : "+v"(tid)); const int lane = tid & 63, wave = __builtin_amdgcn_readfirstlane(tid >> 6);
    float* L = (float*)X.lds;
    const int nmods = (l == 0) ? 384 : 0;
    for (int it = X.bid; it < 128 + nmods; it += X.G) {
      if (it < 128) {
        const int g = it >> 1, hf = it & 1;
        float* Cc = L; float* Bp = L + 2048; float* PW = L + 6144; float* KL = L + 14592;
        const float* lam_re = X.in[14]; const float* lam_im = X.in[15]; const float* log_dt = X.in[16];
        const float* b_re = X.in[17]; const float* b_im = X.in[18]; const float* c_re = X.in[19]; const float* c_im = X.in[20];
        if (tid < 128) {
            const int d = tid >> 6, p = tid & 63;
            const double dt = exp((double)log_dt[(l * 2 + d) * 64 + g]);
            const double lr = (double)lam_re[((l * 2 + d) * 64 + g) * 64 + p], li = (double)lam_im[((l * 2 + d) * 64 + g) * 64 + p];
            const double ar = lr * dt, ai = li * dt, mag = exp(ar);
            const double abr = mag * cos(ai), abi = mag * sin(ai);
            const double nr = abr - 1.0, ni = abi, den = lr * lr + li * li;
            const double cr = (nr * lr + ni * li) / den, ci = (ni * lr - nr * li) / den;
            double zr = 1.0, zi = 0.0;
            for (int n = 0; n <= 32; ++n) { PW[((d * 64 + p) * 33 + n) * 2] = (float)zr; PW[((d * 64 + p) * 33 + n) * 2 + 1] = (float)zi;
                const double t = zr * abr - zi * abi; zi = zr * abi + zi * abr; zr = t; }
            for (int c = 0; c < 16; ++c) { const double br = (double)b_re[((l * 64 + g) * 64 + p) * 16 + c], bi = (double)b_im[((l * 64 + g) * 64 + p) * 16 + c];
                Bp[((d * 64 + p) * 16 + c) * 2] = (float)(cr * br - ci * bi); Bp[((d * 64 + p) * 16 + c) * 2 + 1] = (float)(cr * bi + ci * br); }
        }
        for (int i = tid; i < 1024; i += 512) { Cc[2 * i] = c_re[(size_t)(l * 64 + g) * 1024 + i]; Cc[2 * i + 1] = c_im[(size_t)(l * 64 + g) * 1024 + i]; }
        __syncthreads();
        if (hf == 0 && tid < 128) { const int d = tid >> 6, p = tid & 63; float* abt = (float*)(X.ws + WS_ABT);
            abt[((d * 64 + g) * 64 + p) * 2] = PW[((d * 64 + p) * 33 + 32) * 2]; abt[((d * 64 + g) * 64 + p) * 2 + 1] = PW[((d * 64 + p) * 33 + 32) * 2 + 1]; }
        for (int o = tid; o < 1024; o += 512) { const int d = o >> 9, n = (o >> 4) & 31, c = o & 15; float a[16];
#pragma unroll
            for (int q = 0; q < 16; ++q) a[q] = 0.f;
            for (int p = 0; p < 64; ++p) { const f32x2 C2 = *(const f32x2*)(Cc + (c * 64 + p) * 2), P2 = *(const f32x2*)(PW + ((d * 64 + p) * 33 + n) * 2);
                const float Wr = C2[0] * P2[0] - C2[1] * P2[1], Wi = C2[0] * P2[1] + C2[1] * P2[0];
                const f32x4* bp = (const f32x4*)(Bp + ((d * 64 + p) * 16) * 2);
#pragma unroll
                for (int q = 0; q < 8; ++q) { const f32x4 b = bp[q]; a[2 * q] += Wr * b[0] - Wi * b[1]; a[2 * q + 1] += Wr * b[2] - Wi * b[3]; } }
#pragma unroll
            for (int q = 0; q < 4; ++q) *(f32x4*)(KL + (d * 32 + n) * 256 + c * 16 + 4 * q) = (f32x4){a[4 * q], a[4 * q + 1], a[4 * q + 2], a[4 * q + 3]}; }
        __syncthreads();
        bf16_t* BTY = (bf16_t*)(X.ws + WS_BTY); bf16_t* BTE = (bf16_t*)(X.ws + WS_BTE);
        for (int seg = tid; seg < 256 * 64; seg += 512) { const int nidx = 256 * hf + (seg >> 6), ks = seg & 63, t = nidx >> 4, c = nidx & 15, ta = ks >> 1, cp0 = (ks & 1) * 8; float v[8];
#pragma unroll
            for (int e = 0; e < 8; ++e) { float val = 0.f;
                if (t >= ta) val += KL[((t - ta)) * 256 + c * 16 + cp0 + e];
                if (t <= ta) val += KL[(32 + (ta - t)) * 256 + c * 16 + cp0 + e];
                v[e] = val; }
            u32x4 w; w.x = cvt_pk_bf16(v[0], v[1]); w.y = cvt_pk_bf16(v[2], v[3]); w.z = cvt_pk_bf16(v[4], v[5]); w.w = cvt_pk_bf16(v[6], v[7]);
            *(u32x4*)(BTY + ((size_t)(g * 512 + nidx)) * 768 + ks * 8) = w; }
        for (int seg = tid; seg < 256 * 32; seg += 512) { const int nidx = 256 * hf + (seg >> 5), ks = seg & 31, t = nidx >> 4, c = nidx & 15, d = ks >> 4, p0 = (ks & 15) * 4, ex = d == 0 ? t + 1 : 32 - t; float v[8];
#pragma unroll
            for (int e = 0; e < 4; ++e) { const int p = p0 + e; const float Cr = Cc[(c * 64 + p) * 2], Ci = Cc[(c * 64 + p) * 2 + 1], Pr = PW[((d * 64 + p) * 33 + ex) * 2], Pi = PW[((d * 64 + p) * 33 + ex) * 2 + 1];
                v[2 * e] = Cr * Pr - Ci * Pi; v[2 * e + 1] = -(Cr * Pi + Ci * Pr); }
            u32x4 w; w.x = cvt_pk_bf16(v[0], v[1]); w.y = cvt_pk_bf16(v[2], v[3]); w.z = cvt_pk_bf16(v[4], v[5]); w.w = cvt_pk_bf16(v[6], v[7]);
            *(u32x4*)(BTY + ((size_t)(g * 512 + nidx)) * 768 + 512 + ks * 8) = w; }
        for (int seg = tid; seg < 128 * 64; seg += 512) { const int er = 128 * hf + (seg >> 6), ks = seg & 63, d = er >> 7, p = (er & 127) >> 1, ri = er & 1; float v[8];
#pragma unroll
            for (int e = 0; e < 8; ++e) { const int kidx = ks * 8 + e, ta = kidx >> 4, cp = kidx & 15, ex = d == 0 ? 31 - ta : ta;
                const float Pr = PW[((d * 64 + p) * 33 + ex) * 2], Pi = PW[((d * 64 + p) * 33 + ex) * 2 + 1], Br = Bp[((d * 64 + p) * 16 + cp) * 2], Bi = Bp[((d * 64 + p) * 16 + cp) * 2 + 1];
                v[e] = ri ? (Pr * Bi + Pi * Br) : (Pr * Br - Pi * Bi); }
            u32x4 w; w.x = cvt_pk_bf16(v[0], v[1]); w.y = cvt_pk_bf16(v[2], v[3]); w.z = cvt_pk_bf16(v[4], v[5]); w.w = cvt_pk_bf16(v[6], v[7]);
            *(u32x4*)(BTE + ((size_t)(g * 256 + er)) * 512 + ks * 8) = w; }
        __syncthreads();
      } else {
        const int mi = it - 128, ml = mi / 192, cb = mi - ml * 192;
        float* sv = L; float* part = L + 6144;
        const float* cc = X.in[8]; const float* cctx = X.in[9]; const float* ada_w = X.in[10]; const float* ada_b = X.in[11];
        for (int i = tid; i < 6144; i += 512) { const int cv = i >> 11, k = i & 2047; const float x = cv == 0 ? cctx[k] : cc[(cv - 1) * 2048 + k]; sv[i] = x / (1.f + expf(-x)); }
        __syncthreads();
        const int ks = tid >> 4, c4 = (tid & 15) * 4; f32x4 a0 = (f32x4){0.f, 0.f, 0.f, 0.f}, a1 = a0, a2 = a0;
        const float* wp = ada_w + ((size_t)ml * 2048 + ks * 64) * NMOD + cb * 64 + c4;
#pragma unroll 8
        for (int k = 0; k < 64; ++k) { const f32x4 w = *(const f32x4*)(wp + (size_t)k * NMOD); a0 += w * sv[ks * 64 + k]; a1 += w * sv[2048 + ks * 64 + k]; a2 += w * sv[4096 + ks * 64 + k]; }
        *(f32x4*)(part + (ks * 3 + 0) * 64 + c4) = a0; *(f32x4*)(part + (ks * 3 + 1) * 64 + c4) = a1; *(f32x4*)(part + (ks * 3 + 2) * 64 + c4) = a2;
        __syncthreads();
        if (tid < 192) { const int cv = tid >> 6, c2 = tid & 63; float s2 = ada_b[ml * NMOD + cb * 64 + c2];
            for (int k2 = 0; k2 < 32; ++k2) s2 += part[(k2 * 3 + cv) * 64 + c2];
            ((float*)(X.ws + WS_MODS))[(size_t)(ml * 3 + cv) * NMOD + cb * 64 + c2] = s2; }
        __syncthreads();
      }
    }
    {
        float* scr = (float*)(X.lds + wave * 16384);
        unsigned* ctr = (unsigned*)(X.ws + WS_CTL) + 16 + 64 * l;
        for (;;) {
            unsigned base = 0u; if (lane == 0) base = __hip_atomic_fetch_add(ctr, 8u, __ATOMIC_RELAXED, __HIP_MEMORY_SCOPE_AGENT);
            base = __builtin_amdgcn_readfirstlane(base);
            if (base >= (unsigned)TNIT) break;
            const int i0 = (int)base, i1 = (i0 + 8 < TNIT) ? i0 + 8 : TNIT;
            f32x4 va[8], vb[8]; TrItem ta = tr_decode(X, l, i0), tb = ta; tr_load(ta, lane, va);
            for (int it = i0; it < i1; it += 2) {
                if (it + 1 < i1) { tb = tr_decode(X, l, it + 1); tr_load(tb, lane, vb); }
                tr_store(ta, lane, va, scr);
                if (it + 1 < i1) { if (it + 2 < i1) { ta = tr_decode(X, l, it + 2); tr_load(ta, lane, va); } tr_store(tb, lane, vb, scr); }
            }
        }
        __syncthreads();
    }
    {
        const size_t gt = (size_t)X.bid * 512 + tid, NT = (size_t)X.G * 512;
        bf16_t* WIN = (bf16_t*)(X.ws + WS_WIN);
        for (size_t i = gt; i < (size_t)192 * 2048 / 8; i += NT) *(u32x4*)(WIN + (size_t)NP2REAL * 2048 + i * 8) = (u32x4){0u, 0u, 0u, 0u};
        bf16_t* CKV = (bf16_t*)(X.ws + WS_CKV); bf16_t* KR = (bf16_t*)(X.ws + WS_KR);
        const float* cck = X.in[2]; const float* ckr = X.in[3];
        for (size_t i = gt; i < (size_t)512 * 512; i += NT) { const int rr = (int)(i >> 9), c = (int)(i & 511), b = rr >> 8, t = rr & 255;
            CKV[(size_t)(M + rr) * 512 + c] = f2bf(cck[((size_t)(b * 2 + l) * 256 + t) * 512 + c]); }
        for (size_t i = gt; i < (size_t)512 * 64; i += NT) { const int rr = (int)(i >> 6), c = (int)(i & 63), b = rr >> 8, t = rr & 255;
            KR[(size_t)(M + rr) * 64 + c] = f2bf(ckr[((size_t)(b * 2 + l) * 256 + t) * 64 + c]); }
        if (l == 0) {
            float* rope = (float*)(X.ws + WS_ROPE);
            for (size_t i = gt; i < (size_t)4096 * 32; i += NT) { const int pos = (int)(i >> 5), j = (int)(i & 31);
                const double inv = exp2(-(double)(j & 15) / 16.0 * 13.287712379549449), ang = (double)(j < 16 ? (pos >> 6) : (pos & 63)) * inv;
                rope[i * 2] = (float)cos(ang); rope[i * 2 + 1] = (float)sin(ang); }
        }
    }
}

template <int MODE> __device__ __forceinline__ void phase_norm(const Ctx& X, int l, const bf16_t* src) {
    int tid = threadIdx.x; asm volatile("" : "+v"(tid)); const int lane = tid & 63, wave = __builtin_amdgcn_readfirstlane(tid >> 6); (void)lane; (void)wave;
    const int gw = X.bid * 8 + wave, NGW = X.G * 8;
    const float* ng = X.in[12] + (size_t)l * 4 * DM; bf16_t* H = (bf16_t*)(X.ws + WS_H);
#pragma unroll 2
    for (int r = gw; r < M; r += NGW) {
        const int cv = r < MPR ? 0 : 1 + ((r - MPR) >> 12);
        const float* mb = (const float*)(X.ws + WS_MODS) + (size_t)(l * 3 + cv) * NMOD;
        float* xr = X.out + (size_t)r * DM;
        const float* xs = (l == 0) ? (r < MPR ? X.in[0] + (size_t)r * DM : X.in[1] + (size_t)(r - MPR) * DM) : xr;
        f32x4 v[8];
        if (MODE == 0) {
            float ss = 0.f;
#pragma unroll
            for (int j = 0; j < 8; ++j) { v[j] = *(const f32x4*)(xs + j * 256 + lane * 4); ss += v[j][0] * v[j][0] + v[j][1] * v[j][1] + v[j][2] * v[j][2] + v[j][3] * v[j][3]; }
            const float rs = rsqrtf(wave_sum(ss) * (1.f / DM) + EPS);
#pragma unroll
            for (int j = 0; j < 8; ++j) { const int c = j * 256 + lane * 4; const f32x4 g = *(const f32x4*)(ng + c), sc = *(const f32x4*)(mb + 2048 + c), sh = *(const f32x4*)(mb + c);
                f32x4 h; for (int e = 0; e < 4; ++e) h[e] = v[j][e] * rs * g[e] * (1.f + sc[e]) + sh[e];
                u32x2 w; w.x = cvt_pk_bf16(h[0], h[1]); w.y = cvt_pk_bf16(h[2], h[3]); *(u32x2*)(H + (size_t)r * DM + c) = w; }
        } else {
            const bf16_t* sr = src + (size_t)r * DM; float ss = 0.f;
#pragma unroll
            for (int j = 0; j < 8; ++j) { const u32x2 w = *(const u32x2*)(sr + j * 256 + lane * 4); v[j] = (f32x4){bflo(w.x), bfhi(w.x), bflo(w.y), bfhi(w.y)}; }
            f32x4 xv[8];
#pragma unroll
            for (int j = 0; j < 8; ++j) xv[j] = __builtin_nontemporal_load((const f32x4*)(xs + j * 256 + lane * 4));
#pragma unroll
            for (int j = 0; j < 8; ++j) ss += v[j][0] * v[j][0] + v[j][1] * v[j][1] + v[j][2] * v[j][2] + v[j][3] * v[j][3];
            const float rs = rsqrtf(wave_sum(ss) * (1.f / DM) + EPS);
            const float* ngp = ng + (MODE == 1 ? 1 : 3) * DM; const float* gp = mb + (MODE == 1 ? 2 : 5) * 2048;
            float* R1 = (float*)(X.ws + WS_R1);
            if (MODE == 1) { if (lane == 0) R1[r] = rs; }
            if (MODE == 2) {
                const bf16_t* mr = (const bf16_t*)(X.ws + WS_MO) + (size_t)r * DM; const float r1 = R1[r];
#pragma unroll
                for (int j = 0; j < 8; ++j) { const int c = j * 256 + lane * 4; const u32x2 w = *(const u32x2*)(mr + c); const f32x4 g = *(const f32x4*)(ng + DM + c), gt = *(const f32x4*)(mb + 2 * 2048 + c);
                    xv[j][0] += gt[0] * (bflo(w.x) * r1 * g[0]); xv[j][1] += gt[1] * (bfhi(w.x) * r1 * g[1]); xv[j][2] += gt[2] * (bflo(w.y) * r1 * g[2]); xv[j][3] += gt[3] * (bfhi(w.y) * r1 * g[3]); } }
            float s2 = 0.f;
#pragma unroll
            for (int j = 0; j < 8; ++j) { const int c = j * 256 + lane * 4; const f32x4 g = *(const f32x4*)(ngp + c), gt = *(const f32x4*)(gp + c), x0 = xv[j];
                for (int e = 0; e < 4; ++e) v[j][e] = x0[e] + gt[e] * (v[j][e] * rs * g[e]);
                if (MODE == 2) __builtin_nontemporal_store(v[j], (f32x4*)(xr + c));
                s2 += v[j][0] * v[j][0] + v[j][1] * v[j][1] + v[j][2] * v[j][2] + v[j][3] * v[j][3]; }
            if (MODE == 2 && l == 0) {
                const float r2 = rsqrtf(wave_sum(s2) * (1.f / DM) + EPS); const float* mb1 = mb + 3 * NMOD; const float* ng1 = ng + 4 * DM;
#pragma unroll
                for (int j = 0; j < 8; ++j) { const int c = j * 256 + lane * 4; const f32x4 g = *(const f32x4*)(ng1 + c), sc = *(const f32x4*)(mb1 + 2048 + c), sh = *(const f32x4*)(mb1 + c);
                    f32x4 h; for (int e = 0; e < 4; ++e) h[e] = v[j][e] * r2 * g[e] * (1.f + sc[e]) + sh[e];
                    u32x2 w; w.x = cvt_pk_bf16(h[0], h[1]); w.y = cvt_pk_bf16(h[2], h[3]); *(u32x2*)(H + (size_t)r * DM + c) = w; }
            }
            if (MODE == 1) {
                const float r2 = rsqrtf(wave_sum(s2) * (1.f / DM) + EPS);
#pragma unroll
                for (int j = 0; j < 8; ++j) { const int c = j * 256 + lane * 4; const f32x4 g = *(const f32x4*)(ng + 2 * DM + c), sc = *(const f32x4*)(mb + 4 * 2048 + c), sh = *(const f32x4*)(mb + 3 * 2048 + c);
                    f32x4 h; for (int e = 0; e < 4; ++e) h[e] = v[j][e] * r2 * g[e] * (1.f + sc[e]) + sh[e];
                    u32x2 w; w.x = cvt_pk_bf16(h[0], h[1]); w.y = cvt_pk_bf16(h[2], h[3]); *(u32x2*)(H + (size_t)r * DM + c) = w; }
            }
        }
    }
}

__device__ __forceinline__ void phase_mla_norm(const Ctx& X, int l) {
    int tid = threadIdx.x; asm volatile("" : "+v"(tid)); const int lane = tid & 63, wave = __builtin_amdgcn_readfirstlane(tid >> 6); (void)lane; (void)wave;
    const int gw = X.bid * 8 + wave, NGW = X.G * 8;
    bf16_t* CQ = (bf16_t*)(X.ws + WS_CQ); bf16_t* CKV = (bf16_t*)(X.ws + WS_CKV); bf16_t* KR = (bf16_t*)(X.ws + WS_KR);
    const float* gq = X.in[26] + l * 768; const float* gkv = X.in[27] + l * 512; const float* rope = (const float*)(X.ws + WS_ROPE);
    const bool evenG = (X.G & 1) == 0, lowh = X.bid < X.G / 2; const int RA = evenG ? 5632 : 0;
    const int r_lo = evenG ? (lowh ? 0 : RA) : 0, r_hi = evenG ? (lowh ? RA : M) : M, wi = evenG ? (lowh ? X.bid : X.bid - X.G / 2) * 8 + wave : gw, NW = evenG ? (X.G / 2) * 8 : NGW;
#pragma unroll 2
    for (int r = r_lo + wi; r < r_hi; r += NW) {
        {
            u32x2 w[3]; float ss = 0.f;
#pragma unroll
            for (int j = 0; j < 3; ++j) { w[j] = *(const u32x2*)(CQ + (size_t)r * 768 + (j * 64 + lane) * 4); const float a = bflo(w[j].x), b = bfhi(w[j].x), c = bflo(w[j].y), d = bfhi(w[j].y); ss += a * a + b * b + c * c + d * d; }
            const float rs = rsqrtf(wave_sum(ss) * (1.f / 768.f) + EPS);
#pragma unroll
            for (int j = 0; j < 3; ++j) { const int c0 = (j * 64 + lane) * 4; const f32x4 g = *(const f32x4*)(gq + c0);
                u32x2 o; o.x = cvt_pk_bf16(bflo(w[j].x) * rs * g[0], bfhi(w[j].x) * rs * g[1]); o.y = cvt_pk_bf16(bflo(w[j].y) * rs * g[2], bfhi(w[j].y) * rs * g[3]);
                *(u32x2*)(CQ + (size_t)r * 768 + c0) = o; }
        }
        {
            const u32x4 w = *(const u32x4*)(CKV + (size_t)r * 512 + lane * 8);
            float x[8] = {bflo(w.x), bfhi(w.x), bflo(w.y), bfhi(w.y), bflo(w.z), bfhi(w.z), bflo(w.w), bfhi(w.w)}; float ss = 0.f;
#pragma unroll
            for (int e = 0; e < 8; ++e) ss += x[e] * x[e];
            const float rs = rsqrtf(wave_sum(ss) * (1.f / 512.f) + EPS);
            const f32x4 g0 = *(const f32x4*)(gkv + lane * 8), g1 = *(const f32x4*)(gkv + lane * 8 + 4);
#pragma unroll
            for (int e = 0; e < 4; ++e) { x[e] = x[e] * rs * g0[e]; x[4 + e] = x[4 + e] * rs * g1[e]; }
            u32x4 o; o.x = cvt_pk_bf16(x[0], x[1]); o.y = cvt_pk_bf16(x[2], x[3]); o.z = cvt_pk_bf16(x[4], x[5]); o.w = cvt_pk_bf16(x[6], x[7]);
            *(u32x4*)(CKV + (size_t)r * 512 + lane * 8) = o;
            if (r < MPR) { const int b = r >> 8, t = r & 255; float* op = X.out + O_CKV + ((size_t)(b * 2 + l) * 256 + t) * 512 + lane * 8;
                *(f32x4*)op = (f32x4){x[0], x[1], x[2], x[3]}; *(f32x4*)(op + 4) = (f32x4){x[4], x[5], x[6], x[7]}; }
        }
        {
            const float v = bf2f(KR[(size_t)r * 64 + lane]);
            if (r < MPR) { const int b = r >> 8, t = r & 255; X.out[O_KR + ((size_t)(b * 2 + l) * 256 + t) * 64 + lane] = v; }
            else { const int pos = (r - MPR) & 4095, i = lane >> 1; const float cs = rope[((size_t)pos * 32 + i) * 2], sn = rope[((size_t)pos * 32 + i) * 2 + 1];
                const float pv = __shfl_xor(v, 1); const float o = (lane & 1) ? (pv * sn + v * cs) : (v * cs - pv * sn);
                KR[(size_t)r * 64 + lane] = f2bf(o); }
        }
    }
}

constexpr int RLD = 136;
constexpr float RET_SC = 0.08838834764831845f;
typedef float f32x4v __attribute__((ext_vector_type(4)));
__device__ __forceinline__ void ret_stage_T(const bf16_t* src, int ld, bf16_t* dstT, int mode, float lg, int tid) {
#pragma unroll
    for (int it = 0; it < 4; ++it) { const int seg = tid + it * 512, t = seg >> 4, s = seg & 15;
        const u32x4 w = *(const u32x4*)(src + (size_t)t * ld + s * 8);
        const float sc = mode == 0 ? 1.f : RET_SC * exp2f(lg * (float)(mode == 1 ? 127 - t : t));
        bf16_t* d = dstT + (s * 8) * RLD + t;
        d[0 * RLD] = f2bf(bflo(w.x) * sc); d[1 * RLD] = f2bf(bfhi(w.x) * sc); d[2 * RLD] = f2bf(bflo(w.y) * sc); d[3 * RLD] = f2bf(bfhi(w.y) * sc);
        d[4 * RLD] = f2bf(bflo(w.z) * sc); d[5 * RLD] = f2bf(bfhi(w.z) * sc); d[6 * RLD] = f2bf(bflo(w.w) * sc); d[7 * RLD] = f2bf(bfhi(w.w) * sc); }
}
__device__ __forceinline__ float ret_lg(const Ctx& X, int l, int d, int h) { return -expf(X.in[24][(l * 2 + d) * 8 + h]) * 1.4426950408889634f; }

__device__ __forceinline__ void phase_ret_prefix(const Ctx& X, int l) {
    int tid = threadIdx.x; asm volatile("" : "+v"(tid));
    const bf16_t* LR = (const bf16_t*)(X.ws + WS_LRET); bf16_t* SR = (bf16_t*)(X.ws + WS_SRET);
    constexpr int WS_ = 2 * 8 * 2 * 128 * 32, WP_ = 32 * 8 * 2 * 128 * 32;
    for (int id = X.bid * 512 + tid; id < WS_; id += X.G * 512) {
        const int dk4 = id & 31, dv = (id >> 5) & 127, d = (id >> 12) & 1, h = (id >> 13) & 7, s = id >> 16, c0 = 64 + 32 * s;
        const float g128 = exp2f(ret_lg(X, l, d, h) * 128.f);
        f32x4 S; { const float* s0 = X.in[d ? 5 : 4] + ((size_t)(s * 2 + l) * 8 + h) * 16384;
#pragma unroll
            for (int e = 0; e < 4; ++e) S[e] = s0[(size_t)(dk4 * 4 + e) * 128 + dv]; }
#define PFX_LD(LV, J0) do { _Pragma("unroll") for (int q = 0; q < 8; ++q) { const int ci = c0 + (d ? 31 - ((J0) + q) : (J0) + q); LV[q] = *(const u32x2*)(LR + ((size_t)((ci * 8 + h) * 2 + d) * 128 + dv) * 128 + dk4 * 4); } \
            __builtin_amdgcn_sched_barrier(0); } while (0)
#define PFX_RUN(LV, J0) do { _Pragma("unroll") for (int q = 0; q < 8; ++q) { const int ci = c0 + (d ? 31 - ((J0) + q) : (J0) + q); const size_t o = ((size_t)((ci * 8 + h) * 2 + d) * 128 + dv) * 128 + dk4 * 4; \
                u32x2 w; w.x = cvt_pk_bf16(S[0], S[1]); w.y = cvt_pk_bf16(S[2], S[3]); *(u32x2*)(SR + o) = w; S = S * g128 + (f32x4){bflo(LV[q].x), bfhi(LV[q].x), bflo(LV[q].y), bfhi(LV[q].y)}; } } while (0)
        { u32x2 La[8], Lb[8];
          PFX_LD(La, 0); PFX_LD(Lb, 8); PFX_RUN(La, 0); PFX_LD(La, 16); PFX_RUN(Lb, 8); PFX_LD(Lb, 24); PFX_RUN(La, 16); PFX_RUN(Lb, 24); }
#undef PFX_LD
#undef PFX_RUN
    }
    const bool evenG2 = (X.G & 1) == 0, lowh2 = X.bid < X.G / 2; constexpr int PA = WP_ / 32 * 9;
    const int p_lo = evenG2 ? (lowh2 ? 0 : PA) : 0, p_hi = evenG2 ? (lowh2 ? PA : WP_) : WP_, pt = evenG2 ? (lowh2 ? X.bid : X.bid - X.G / 2) * 512 + tid : X.bid * 512 + tid, PS = evenG2 ? (X.G / 2) * 512 : X.G * 512;
    for (int id = p_lo + pt; id < p_hi; id += PS) {
        const int dk4 = id & 31, dv = (id >> 5) & 127, d = (id >> 12) & 1, h = (id >> 13) & 7, s = id >> 16;
        const float g128 = exp2f(ret_lg(X, l, d, h) * 128.f);
        const int cA = 2 * s + (d ? 1 : 0), cB = 2 * s + (d ? 0 : 1);
        const size_t oA = ((size_t)((cA * 8 + h) * 2 + d) * 128 + dv) * 128 + dk4 * 4, oB = ((size_t)((cB * 8 + h) * 2 + d) * 128 + dv) * 128 + dk4 * 4;
        const u32x2 wA = *(const u32x2*)(LR + oA), wB = *(const u32x2*)(LR + oB);
        const f32x4 LA = (f32x4){bflo(wA.x), bfhi(wA.x), bflo(wA.y), bfhi(wA.y)}, LB = (f32x4){bflo(wB.x), bfhi(wB.x), bflo(wB.y), bfhi(wB.y)};
        *(u32x2*)(SR + oA) = (u32x2){0u, 0u};
        *(u32x2*)(SR + oB) = wA;
        const f32x4 S = LA * g128 + LB;
        float* op = X.out + (d ? O_RB : O_RF) + ((size_t)(s * 2 + l) * 8 + h) * 16384;
#pragma unroll
        for (int e = 0; e < 4; ++e) op[(size_t)(dk4 * 4 + e) * 128 + dv] = S[e];
    }
}
__device__ __forceinline__ bf16x8 scale_frag(bf16x8 q, float s) {
    const u32x4 w = __builtin_bit_cast(u32x4, q); u32x4 o;
    o.x = cvt_pk_bf16(bflo(w.x) * s, bfhi(w.x) * s); o.y = cvt_pk_bf16(bflo(w.y) * s, bfhi(w.y) * s); o.z = cvt_pk_bf16(bflo(w.z) * s, bfhi(w.z) * s); o.w = cvt_pk_bf16(bflo(w.w) * s, bfhi(w.w) * s);
    return __builtin_bit_cast(bf16x8, o);
}
__device__ __forceinline__ void phase_s5_carry(const Ctx& X, int l) {
    int tid = threadIdx.x; asm volatile("" : "+v"(tid)); const int lane = tid & 63, wave = __builtin_amdgcn_readfirstlane(tid >> 6);
    const int gw = wave * X.G + X.bid, NGW = X.G * 8, p = lane;
    const float* EL = (const float*)(X.ws + WS_ELOC); bf16_t* UG = (bf16_t*)(X.ws + WS_UG); const float* abt = (const float*)(X.ws + WS_ABT);
    for (int it = gw; it < 34 * 128; it += NGW) {
        const int d = it & 1, g = (it >> 1) & 63, sq = it >> 7;
        const bool smp = sq < 2; const int s = smp ? sq : sq - 2, nc = smp ? 128 : 8, c0 = smp ? 256 + 128 * s : 8 * s;
        const float ar = abt[((d * 64 + g) * 64 + p) * 2], ai = abt[((d * 64 + g) * 64 + p) * 2 + 1];
        float sr = 0.f, si = 0.f;
        if (smp) { const float* s0 = X.in[d ? 7 : 6] + (((size_t)(s * 2 + l) * 64 + g) * 64 + p) * 2; sr = s0[0]; si = s0[1]; }
#define CARRY_LD(EV, J0, NB) do { _Pragma("unroll") for (int q = 0; q < (NB); ++q) { const int ch = c0 + (d ? nc - 1 - ((J0) + q) : (J0) + q); EV[q] = *(const f32x2*)(EL + (size_t)(g * 512 + ch) * 256 + d * 128 + 2 * p); } \
            __builtin_amdgcn_sched_barrier(0); } while (0)
#define CARRY_RUN(EV, J0, NB) do { _Pragma("unroll") for (int q = 0; q < (NB); ++q) { const int ch = c0 + (d ? nc - 1 - ((J0) + q) : (J0) + q); \
                *(unsigned*)(UG + (size_t)(g * 512 + ch) * 768 + 512 + d * 128 + 2 * p) = cvt_pk_bf16(sr, si); \
                const float tr = ar * sr - ai * si + EV[q][0]; si = ar * si + ai * sr + EV[q][1]; sr = tr; } } while (0)
        if (smp) {
            f32x2 ea[16], eb[16];
            CARRY_LD(ea, 0, 16);
            for (int jb = 0; jb < 128; jb += 32) {
                CARRY_LD(eb, jb + 16, 16); CARRY_RUN(ea, jb, 16);
                if (jb + 32 < 128) CARRY_LD(ea, jb + 32, 16);
                CARRY_RUN(eb, jb + 16, 16); }
        } else { f32x2 ev[8]; CARRY_LD(ev, 0, 8); CARRY_RUN(ev, 0, 8); }
#undef CARRY_LD
#undef CARRY_RUN
        if (!smp) { float* op = X.out + (d ? O_SB : O_SF) + (((size_t)(s * 2 + l) * 64 + g) * 64 + p) * 2; op[0] = sr; op[1] = si; }
    }
}

__device__ __forceinline__ void phase_convfix(const Ctx& X, int l) {
    int tid = threadIdx.x; asm volatile("" : "+v"(tid));
    const float* HALO = (const float*)(X.ws + WS_HALO); bf16_t* AF = (bf16_t*)(X.ws + WS_AF);
    const float* cw = X.in[34] + (size_t)l * 3 * DFF2; const float* cb = X.in[35] + (size_t)l * DFF2;
    for (int idx = X.bid * 512 + tid; idx < 32 * 2 * 1408; idx += X.G * 512) {
        const int cq = idx % 1408, wrw = (idx / 1408) & 1, pm = 32 + idx / 2816, ts = pm & 15, ch = cq * 4;
        if ((wrw == 0 && ts == 0) || (wrw == 1 && ts == 15)) continue;
        const int hc = (ch >> 7) * 256 + (ch & 127);
        const float* pu = HALO + (size_t)(wrw == 0 ? (pm - 1) * 4 + 3 : pm * 4 + 2) * DFF2 + hc;
        const float* pc = HALO + (size_t)(wrw == 0 ? pm * 4 + 0 : pm * 4 + 3) * DFF2 + hc;
        const float* pd = HALO + (size_t)(wrw == 0 ? pm * 4 + 1 : (pm + 1) * 4 + 0) * DFF2 + hc;
        f32x4 res[2];
#pragma unroll
        for (int part = 0; part < 2; ++part) { const int cc = ch + part * DFF;
            const f32x4 a = *(const f32x4*)(pu + part * 128), b = *(const f32x4*)(pc + part * 128), c = *(const f32x4*)(pd + part * 128);
            const f32x4 w0 = *(const f32x4*)(cw + cc), w1 = *(const f32x4*)(cw + DFF2 + cc), w2 = *(const f32x4*)(cw + 2 * DFF2 + cc), bb = *(const f32x4*)(cb + cc);
            res[part] = w0 * a + w1 * b + w2 * c + bb; }
        const int r = pm * 256 + (wrw ? 255 : 0);
        u32x2 w; w.x = cvt_pk_bf16(res[1][0] * sigm(res[1][0]) * res[0][0], res[1][1] * sigm(res[1][1]) * res[0][1]); w.y = cvt_pk_bf16(res[1][2] * sigm(res[1][2]) * res[0][2], res[1][3] * sigm(res[1][3]) * res[0][3]);
        *(u32x2*)(AF + (size_t)r * DFF + ch) = w;
    }
}

namespace att {
using s16x4  = __attribute__((ext_vector_type(4))) short;
using f32x16 = __attribute__((ext_vector_type(16))) float;
constexpr float SCALE = 0.07216878364870322f, THR = 8.f;
constexpr int K_BYTES = 64 * 400, V_BYTES = 64 * 256;
#define KSW(row, colB) ((row) * 400 + (colB))
#define SBAR() __builtin_amdgcn_sched_barrier(0)
__device__ __forceinline__ int crow(int r, int hi) { return (r & 3) + 8 * (r >> 2) + 4 * hi; }
__device__ __forceinline__ void partialSM(f32x16& p0, f32x16& p1, float& m_reg, float& mn, float& alpha) {
  constexpr float C = SCALE * 1.4426950408889634f;
  float pmax = p0[0];
#pragma unroll
  for (int r = 1; r < 16; ++r) pmax = fmaxf(pmax, p0[r]);
#pragma unroll
  for (int r = 0; r < 16; ++r) pmax = fmaxf(pmax, p1[r]);
  { auto rr = __builtin_amdgcn_permlane32_swap(__float_as_uint(pmax), __float_as_uint(pmax), false, false);
    pmax = fmaxf(__uint_as_float(rr[0]), __uint_as_float(rr[1])); }
  if (__builtin_expect(__all(pmax - m_reg <= THR / SCALE), 1)) { mn = m_reg; alpha = 1.f; }
  else { mn = fmaxf(m_reg, pmax); alpha = __builtin_amdgcn_exp2f((m_reg - mn) * C); m_reg = mn; }
  const float mnC = -mn * C;
#pragma unroll
  for (int r = 0; r < 16; ++r) p0[r] = __builtin_amdgcn_exp2f(fmaf(p0[r], C, mnC));
#pragma unroll
  for (int r = 0; r < 16; ++r) p1[r] = __builtin_amdgcn_exp2f(fmaf(p1[r], C, mnC));
}
__device__ __forceinline__ void sm_max(const f32x16& p0, const f32x16& p1, float& m_reg, float& mnC, float& alpha) {
  constexpr float C = SCALE * 1.4426950408889634f;
  float pmax = p0[0];
#pragma unroll
  for (int r = 1; r < 16; ++r) pmax = fmaxf(pmax, p0[r]);
#pragma unroll
  for (int r = 0; r < 16; ++r) pmax = fmaxf(pmax, p1[r]);
  { auto rr = __builtin_amdgcn_permlane32_swap(__float_as_uint(pmax), __float_as_uint(pmax), false, false);
    pmax = fmaxf(__uint_as_float(rr[0]), __uint_as_float(rr[1])); }
  float mn;
  if (__builtin_expect(__all(pmax - m_reg <= THR / SCALE), 1)) { mn = m_reg; alpha = 1.f; }
  else { mn = fmaxf(m_reg, pmax); alpha = __builtin_amdgcn_exp2f((m_reg - mn) * C); m_reg = mn; }
  mnC = -mn * C;
}
template <int BASE> __device__ __forceinline__ void sm_exp8(f32x16& p, float mnC) {
  constexpr float C = SCALE * 1.4426950408889634f;
#pragma unroll
  for (int r = BASE; r < BASE + 8; ++r) p[r] = __builtin_amdgcn_exp2f(fmaf(p[r], C, mnC));
#pragma unroll
  for (int r = BASE; r < BASE + 8; ++r) { float t = p[r]; asm volatile("" : "+v"(t)); p[r] = t; }
}
__device__ __forceinline__ void finishSM(f32x16& p0, f32x16& p1, float alpha, float& l_reg, bf16x8& pa0, bf16x8& pa1, bf16x8& pa2, bf16x8& pa3) {
  float ps = 0;
#pragma unroll
  for (int r = 0; r < 16; ++r) ps += p0[r];
#pragma unroll
  for (int r = 0; r < 16; ++r) ps += p1[r];
  { auto rr = __builtin_amdgcn_permlane32_swap(__float_as_uint(ps), __float_as_uint(ps), false, false);
    ps = __uint_as_float(rr[0]) + __uint_as_float(rr[1]); }
  l_reg = l_reg * alpha + ps;
#define PK4(P, BASE, OUT) do { unsigned a0 = cvt_pk_bf16(P[BASE + 0], P[BASE + 1]), a1 = cvt_pk_bf16(P[BASE + 2], P[BASE + 3]);   \
    unsigned b0 = cvt_pk_bf16(P[BASE + 4], P[BASE + 5]), b1 = cvt_pk_bf16(P[BASE + 6], P[BASE + 7]);                              \
    auto r0 = __builtin_amdgcn_permlane32_swap(a0, b0, false, false); auto r1 = __builtin_amdgcn_permlane32_swap(a1, b1, false, false); \
    u32x4 w = {r0[0], r1[0], r0[1], r1[1]}; OUT = __builtin_bit_cast(bf16x8, w); } while (0)
  PK4(p0, 0, pa0); PK4(p0, 8, pa1); PK4(p1, 0, pa2); PK4(p1, 8, pa3);
#undef PK4
}
__device__ __forceinline__ int v_st(int k, int c) { const int kk = (k & ~0xC) | ((k & 4) << 1) | ((k & 8) >> 1); return ((kk >> 3) * 4 + (c >> 5)) * 512 + ((kk & 7) * 32 + (c & 31)) * 2; }
__device__ __forceinline__ int v_rd_base(int lane) { return ((lane & 3) << 3) | (((lane >> 2) & 3) << 6) | (((lane >> 4) & 1) << 5) | (((lane >> 5) & 1) << 8); }
constexpr int v_rd_off(int d0, int ks, int half) { return d0 * 512 + ks * 4096 + half * 2048; }
template <int OFF> __device__ __forceinline__ s16x4 tr_read(int vb) {
  s16x4 r; asm volatile("ds_read_b64_tr_b16 %0, %1 offset:%2" : "=&v"(r) : "v"(vb), "i"(OFF) : "memory"); return r;
}
template <int D0> __device__ __forceinline__ void pv_one(f32x16& od, int vb, bf16x8 pa0, bf16x8 pa1, bf16x8 pa2, bf16x8 pa3) {
  const s16x4 l0 = tr_read<v_rd_off(D0, 0, 0)>(vb), h0 = tr_read<v_rd_off(D0, 0, 1)>(vb), l1 = tr_read<v_rd_off(D0, 1, 0)>(vb), h1 = tr_read<v_rd_off(D0, 1, 1)>(vb);
  const s16x4 l2 = tr_read<v_rd_off(D0, 2, 0)>(vb), h2 = tr_read<v_rd_off(D0, 2, 1)>(vb), l3 = tr_read<v_rd_off(D0, 3, 0)>(vb), h3 = tr_read<v_rd_off(D0, 3, 1)>(vb);
  asm volatile("s_waitcnt lgkmcnt(0)" ::: "memory"); SBAR();
#define PK(L, H) (bf16x8){L[0], L[1], L[2], L[3], H[0], H[1], H[2], H[3]}
  od = __builtin_amdgcn_mfma_f32_32x32x16_bf16(pa0, PK(l0, h0), od, 0, 0, 0);
  od = __builtin_amdgcn_mfma_f32_32x32x16_bf16(pa1, PK(l1, h1), od, 0, 0, 0);
  od = __builtin_amdgcn_mfma_f32_32x32x16_bf16(pa2, PK(l2, h2), od, 0, 0, 0);
  od = __builtin_amdgcn_mfma_f32_32x32x16_bf16(pa3, PK(l3, h3), od, 0, 0, 0);
#undef PK
}
__device__ __forceinline__ void attn_unit(const Ctx& X, bool smp, int b, int h, int qb) {
  const bf16_t* QM = (const bf16_t*)(X.ws + WS_QMLA); const bf16_t* KV = (const bf16_t*)(X.ws + WS_KVMLA); const bf16_t* KR = (const bf16_t*)(X.ws + WS_KR);
  bf16_t* YC = (bf16_t*)(X.ws + WS_Y3) + 2048; const float* rope = (const float*)(X.ws + WS_ROPE);
  int tid = threadIdx.x; asm volatile("" : "+v"(tid)); const int lane = tid & 63, wave = __builtin_amdgcn_readfirstlane(tid >> 6); (void)lane; (void)wave;
  const int wid = wave, r32 = lane & 31, hi = lane >> 5;
  constexpr int BUF = K_BYTES + V_BYTES;
  char* K_lds = (char*)X.lds; char* V_lds = (char*)X.lds + K_BYTES;
  float* wsl = (float*)(X.lds + 3 * BUF) + wid * 64; float* li_l = wsl; float* al_l = wsl + 32;
  const int row0 = smp ? MPR + b * 4096 + qb * 256 : b * 256, NT = smp ? 68 : 4;
  float m_reg = -1e30f, l_reg = 0.f; f32x16 o[4] = {}; bf16x8 qr[12];
  const int vb0 = (int)(uintptr_t)V_lds + v_rd_base(lane);
  int rel[6]; bool isr[4];
#pragma unroll
  for (int i = 0; i < 4; ++i) { const int off = (wid + 8 * i) * 1024 + lane * 16, row = off / 400, colB = off - row * 400;
    isr[i] = colB >= 256; rel[i] = isr[i] ? row * 64 + ((colB - 256) >> 1) : row * 2048 + h * 128 + (colB >> 1); }
#pragma unroll
  for (int i = 4; i < 6; ++i) { const int off = (wid + 8 * (i - 4)) * 1024 + lane * 16, st = off >> 9, rem = off & 511, kk = (st >> 2) * 8 + (rem >> 6), cc = (st & 3) * 32 + ((rem & 63) >> 1);
    const int k = (kk & ~0xC) | ((kk & 4) << 1) | ((kk & 8) >> 1); rel[i] = k * 2048 + 1024 + h * 128 + cc; }
#define ATT_DMA(KT, B) do { const int kt_ = (KT); const int kv0 = smp ? (kt_ < 64 ? MPR + b * 4096 + 64 * kt_ : M + b * 256 + 64 * (kt_ - 64)) : b * 256 + 64 * kt_; \
    const bf16_t* kvb = KV + (size_t)kv0 * 2048; const bf16_t* krb = KR + (size_t)kv0 * 64; \
    _Pragma("unroll") for (int i = 0; i < 3; ++i) __builtin_amdgcn_global_load_lds((const unsigned*)(isr[i] ? krb + rel[i] : kvb + rel[i]), (LAS unsigned*)(K_lds + (B) * BUF + (wid + 8 * i) * 1024), 16, 0, 0); \
    if (wid == 0) __builtin_amdgcn_global_load_lds((const unsigned*)(isr[3] ? krb + rel[3] : kvb + rel[3]), (LAS unsigned*)(K_lds + (B) * BUF + 24 * 1024), 16, 0, 0); \
    _Pragma("unroll") for (int i = 4; i < 6; ++i) __builtin_amdgcn_global_load_lds((const unsigned*)(kvb + rel[i]), (LAS unsigned*)(V_lds + (B) * BUF + (wid + 8 * (i - 4)) * 1024), 16, 0, 0); } while (0)
#define ATT_SYNC() do { asm volatile("s_waitcnt vmcnt(0)" ::: "memory"); __syncthreads(); } while (0)
  f32x16 pA0, pA1, pB0, pB1; float alA = 1.f, alB = 1.f, mnx;
#define ATT_QK(BI, P0, P1) do { const char* Kc = K_lds + (BI) * BUF; P0 = f32x16{}; P1 = f32x16{}; \
    _Pragma("unroll") for (int d0 = 0; d0 < 12; ++d0) { const int cb = (d0 * 16 + hi * 8) * 2; \
      const bf16x8 b0 = *(const bf16x8*)(Kc + KSW(r32, cb)), b1 = *(const bf16x8*)(Kc + KSW(32 + r32, cb)); \
      P0 = __builtin_amdgcn_mfma_f32_32x32x16_bf16(b0, qr[d0], P0, 0, 0, 0); P1 = __builtin_amdgcn_mfma_f32_32x32x16_bf16(b1, qr[d0], P1, 0, 0, 0); } } while (0)
#define ATT_PV(BI) do { const int vbc = vb0 + (BI) * BUF; \
    pv_one<0>(o[0], vbc, pa0, pa1, pa2, pa3); pv_one<1>(o[1], vbc, pa0, pa1, pa2, pa3); pv_one<2>(o[2], vbc, pa0, pa1, pa2, pa3); pv_one<3>(o[3], vbc, pa0, pa1, pa2, pa3); } while (0)
#define ATT_PVX(BI, P0, P1, AL) do { const int vbc = vb0 + (BI) * BUF; float mnC_; sm_max(P0, P1, m_reg, mnC_, AL); \
    pv_one<0>(o[0], vbc, pa0, pa1, pa2, pa3); sm_exp8<0>(P0, mnC_); pv_one<1>(o[1], vbc, pa0, pa1, pa2, pa3); sm_exp8<8>(P0, mnC_); \
    pv_one<2>(o[2], vbc, pa0, pa1, pa2, pa3); sm_exp8<0>(P1, mnC_); pv_one<3>(o[3], vbc, pa0, pa1, pa2, pa3); sm_exp8<8>(P1, mnC_); } while (0)
#define ATT_RESC(AL) do { if (__any((AL) < 1.f)) { if (hi == 0) al_l[r32] = (AL); asm volatile("s_waitcnt lgkmcnt(0)" ::: "memory"); \
      _Pragma("unroll") for (int d = 0; d < 4; ++d) _Pragma("unroll") for (int r = 0; r < 16; ++r) o[d][r] *= al_l[crow(r, hi)]; } } while (0)
#define ATT_STAGE(KT) do { if ((KT) + 1 < NT) ATT_DMA((KT) + 1, bnext); } while (0)
#define ATT_ROT() do { const int t_ = bprev; bprev = bcur; bcur = bnext; bnext = t_; } while (0)
  bf16x8 pa0, pa1, pa2, pa3;
  ATT_DMA(0, 0);
  {
    const int qrow = row0 + wid * 32 + r32; const bf16_t* Qw = QM + (size_t)qrow * 1536 + h * 192 + hi * 8;
#pragma unroll
    for (int d0 = 0; d0 < 12; ++d0) qr[d0] = *(const bf16x8*)(Qw + d0 * 16);
    if (smp) { const int pos = qb * 256 + wid * 32 + r32;
#pragma unroll
      for (int d0 = 8; d0 < 12; ++d0) { const int i0 = 8 * (d0 - 8) + 4 * hi; const float* rp = rope + ((size_t)pos * 32 + i0) * 2;
        const f32x4 c01 = *(const f32x4*)rp, c23 = *(const f32x4*)(rp + 4);
        const u32x4 w = __builtin_bit_cast(u32x4, qr[d0]); u32x4 ow;
        { const float x1 = bflo(w.x), x2 = bfhi(w.x); ow.x = cvt_pk_bf16(x1 * c01[0] - x2 * c01[1], x1 * c01[1] + x2 * c01[0]); }
        { const float x1 = bflo(w.y), x2 = bfhi(w.y); ow.y = cvt_pk_bf16(x1 * c01[2] - x2 * c01[3], x1 * c01[3] + x2 * c01[2]); }
        { const float x1 = bflo(w.z), x2 = bfhi(w.z); ow.z = cvt_pk_bf16(x1 * c23[0] - x2 * c23[1], x1 * c23[1] + x2 * c23[0]); }
        { const float x1 = bflo(w.w), x2 = bfhi(w.w); ow.w = cvt_pk_bf16(x1 * c23[2] - x2 * c23[3], x1 * c23[3] + x2 * c23[2]); }
        qr[d0] = __builtin_bit_cast(bf16x8, ow); } }
  }
  ATT_SYNC();
  int bprev = 2, bcur = 0, bnext = 1;
  ATT_STAGE(0); SBAR(); ATT_QK(bcur, pA0, pA1); partialSM(pA0, pA1, m_reg, mnx, alA); ATT_RESC(alA); ATT_SYNC(); ATT_ROT();
#pragma unroll 1
  for (int kt = 1; kt + 1 < NT; kt += 2) {
    ATT_STAGE(kt); SBAR(); ATT_QK(bcur, pB0, pB1); finishSM(pA0, pA1, alA, l_reg, pa0, pa1, pa2, pa3); SBAR();
    ATT_PVX(bprev, pB0, pB1, alB); ATT_RESC(alB); ATT_SYNC(); ATT_ROT();
    ATT_STAGE(kt + 1); SBAR(); ATT_QK(bcur, pA0, pA1); finishSM(pB0, pB1, alB, l_reg, pa0, pa1, pa2, pa3); SBAR();
    ATT_PVX(bprev, pA0, pA1, alA); ATT_RESC(alA); ATT_SYNC(); ATT_ROT();
  }
  ATT_STAGE(NT - 1); SBAR(); ATT_QK(bcur, pB0, pB1); finishSM(pA0, pA1, alA, l_reg, pa0, pa1, pa2, pa3); SBAR();
  ATT_PVX(bprev, pB0, pB1, alB); ATT_RESC(alB); ATT_SYNC(); ATT_ROT();
  finishSM(pB0, pB1, alB, l_reg, pa0, pa1, pa2, pa3); ATT_PV(bprev);
#undef ATT_QK
#undef ATT_PV
#undef ATT_PVX
#undef ATT_RESC
#undef ATT_STAGE
#undef ATT_ROT
#undef ATT_DMA
#undef ATT_SYNC
  if (hi == 0) li_l[r32] = l_reg; asm volatile("s_waitcnt lgkmcnt(0)" ::: "memory");
  bf16_t* Ow = YC + (size_t)(row0 + wid * 32) * LDY3 + h * 128;
#pragma unroll
  for (int r = 0; r < 16; ++r) { const int orow = crow(r, hi); const float rl = __builtin_amdgcn_rcpf(li_l[orow]);
#pragma unroll
    for (int d0 = 0; d0 < 4; ++d0) Ow[(size_t)orow * LDY3 + d0 * 32 + r32] = f2bf(o[d0][r] * rl); }
  __syncthreads();
}
__device__ __forceinline__ void phase_attn(const Ctx& X) {
  for (int u = X.bid; u < 512; u += X.G) {
    if (u < 256) { const int pr = (X.G == 256) ? (u & 7) * 2 + (u >> 7) : u >> 4, qb = (X.G == 256) ? (u >> 3) & 15 : u & 15;
      attn_unit(X, true, pr >> 3, pr & 7, qb); }
    else { const int v = u - 256; attn_unit(X, false, v >> 3, v & 7, 0); }
  }
}
}

namespace ret {
using att::s16x4; using att::f32x16; using att::tr_read; using att::v_st; using att::v_rd_base; using att::v_rd_off; using att::crow;
#define KS256(row, colB) ((row) * 256 + ((colB) ^ (((row) & 7) << 4)))
#define RPK(L, H) (bf16x8){L[0], L[1], L[2], L[3], H[0], H[1], H[2], H[3]}
__device__ __forceinline__ void phase_ret_pass1(const Ctx& X, int l) {
    int tid = threadIdx.x; asm volatile("" : "+v"(tid)); const int lane = tid & 63, w = __builtin_amdgcn_readfirstlane(tid >> 6), r32 = lane & 31, hi = lane >> 5;
    char* VL = (char*)X.lds; char* KF = VL + 32768; char* KB = VL + 65536;
    const bf16_t* Kb = (const bf16_t*)(X.ws + WS_K); const bf16_t* Vb = (const bf16_t*)(X.ws + WS_V); bf16_t* LR = (bf16_t*)(X.ws + WS_LRET);
    const int dvb = w & 3, dk0 = 2 * (w >> 2);
    const int va = (int)(uintptr_t)VL + v_rd_base(lane) + dvb * 512, kfa = (int)(uintptr_t)KF + v_rd_base(lane) + dk0 * 512, kba = (int)(uintptr_t)KB + v_rd_base(lane) + dk0 * 512;
    for (int u = X.bid; u < 1024; u += X.G) {
        const int ci = u >> 3, h = u & 7, r0 = ci * 128;
        const float lgf = ret_lg(X, l, 0, h), lgb = ret_lg(X, l, 1, h);
#pragma unroll
        for (int it = 0; it < 4; ++it) { const int seg = tid + it * 512, t = seg >> 4, sg = seg & 15, off = (t >> 6) * 16384 + v_st(t & 63, sg * 8);
            const u32x4 vv = *(const u32x4*)(Vb + (size_t)(r0 + t) * 1024 + h * 128 + sg * 8), kk = *(const u32x4*)(Kb + (size_t)(r0 + t) * 1024 + h * 128 + sg * 8);
            *(u32x4*)(VL + off) = vv;
            const float sf = RET_SC * __builtin_amdgcn_exp2f(lgf * (float)(127 - t)), sb = RET_SC * __builtin_amdgcn_exp2f(lgb * (float)t);
            u32x4 a, b; a.x = cvt_pk_bf16(bflo(kk.x) * sf, bfhi(kk.x) * sf); a.y = cvt_pk_bf16(bflo(kk.y) * sf, bfhi(kk.y) * sf); a.z = cvt_pk_bf16(bflo(kk.z) * sf, bfhi(kk.z) * sf); a.w = cvt_pk_bf16(bflo(kk.w) * sf, bfhi(kk.w) * sf);
            b.x = cvt_pk_bf16(bflo(kk.x) * sb, bfhi(kk.x) * sb); b.y = cvt_pk_bf16(bflo(kk.y) * sb, bfhi(kk.y) * sb); b.z = cvt_pk_bf16(bflo(kk.z) * sb, bfhi(kk.z) * sb); b.w = cvt_pk_bf16(bflo(kk.w) * sb, bfhi(kk.w) * sb);
            *(u32x4*)(KF + off) = a; *(u32x4*)(KB + off) = b; }
        __syncthreads();
        f32x16 acc[2][2] = {};
#define RP1_STEP(T, KS) do { \
            const s16x4 al = tr_read<(T) * 16384 + v_rd_off(0, KS, 0)>(va), ah = tr_read<(T) * 16384 + v_rd_off(0, KS, 1)>(va); \
            const s16x4 f0l = tr_read<(T) * 16384 + v_rd_off(0, KS, 0)>(kfa), f0h = tr_read<(T) * 16384 + v_rd_off(0, KS, 1)>(kfa), f1l = tr_read<(T) * 16384 + v_rd_off(1, KS, 0)>(kfa), f1h = tr_read<(T) * 16384 + v_rd_off(1, KS, 1)>(kfa); \
            const s16x4 b0l = tr_read<(T) * 16384 + v_rd_off(0, KS, 0)>(kba), b0h = tr_read<(T) * 16384 + v_rd_off(0, KS, 1)>(kba), b1l = tr_read<(T) * 16384 + v_rd_off(1, KS, 0)>(kba), b1h = tr_read<(T) * 16384 + v_rd_off(1, KS, 1)>(kba); \
            asm volatile("s_waitcnt lgkmcnt(0)" ::: "memory"); __builtin_amdgcn_sched_barrier(0); \
            const bf16x8 A = RPK(al, ah); \
            acc[0][0] = __builtin_amdgcn_mfma_f32_32x32x16_bf16(A, RPK(f0l, f0h), acc[0][0], 0, 0, 0); acc[0][1] = __builtin_amdgcn_mfma_f32_32x32x16_bf16(A, RPK(f1l, f1h), acc[0][1], 0, 0, 0); \
            acc[1][0] = __builtin_amdgcn_mfma_f32_32x32x16_bf16(A, RPK(b0l, b0h), acc[1][0], 0, 0, 0); acc[1][1] = __builtin_amdgcn_mfma_f32_32x32x16_bf16(A, RPK(b1l, b1h), acc[1][1], 0, 0, 0); } while (0)
        RP1_STEP(0, 0); RP1_STEP(0, 1); RP1_STEP(0, 2); RP1_STEP(0, 3); RP1_STEP(1, 0); RP1_STEP(1, 1); RP1_STEP(1, 2); RP1_STEP(1, 3);
#undef RP1_STEP
#pragma unroll
        for (int dir = 0; dir < 2; ++dir)
#pragma unroll
            for (int q = 0; q < 2; ++q) { bf16_t* o = LR + ((size_t)(u * 2 + dir) * 128 + 32 * dvb) * 128 + 32 * (dk0 + q) + r32;
#pragma unroll
                for (int r = 0; r < 16; ++r) o[(size_t)crow(r, hi) * 128] = f2bf(acc[dir][q][r]); }
        __syncthreads();
    }
}
template <int D0> __device__ __forceinline__ void pv128(f32x16& od, int vb, const bf16x8 (&pa)[8]) {
    att::pv_one<D0>(od, vb, pa[0], pa[1], pa[2], pa[3]); att::pv_one<D0>(od, vb + 16384, pa[4], pa[5], pa[6], pa[7]);
}
__device__ __forceinline__ void phase_ret_pass2(const Ctx& X, int l) {
    int tid = threadIdx.x; asm volatile("" : "+v"(tid)); const int lane = tid & 63, w = __builtin_amdgcn_readfirstlane(tid >> 6), r32 = lane & 31, hi = lane >> 5;
    char* KL = (char*)X.lds; char* VL = KL + 32768; char* SF = KL + 65536; char* SB = KL + 98304; float* ST = (float*)(X.lds + XCH_OFF);
    const bf16_t* Qb = (const bf16_t*)(X.ws + WS_Q); const bf16_t* Kb = (const bf16_t*)(X.ws + WS_K); const bf16_t* Vb = (const bf16_t*)(X.ws + WS_V); const bf16_t* Gb = (const bf16_t*)(X.ws + WS_G);
    const bf16_t* SR = (const bf16_t*)(X.ws + WS_SRET); bf16_t* YB = (bf16_t*)(X.ws + WS_Y3) + 1024; const float* gain = X.in[25] + l * 1024;
    const int rq = w & 3, ch = w >> 2, vb = (int)(uintptr_t)VL + v_rd_base(lane);
#define RP2_DMA_A(U) do { const int u_ = (U), r0_ = (u_ >> 3) * 128, h_ = u_ & 7; const bf16_t* kb_ = Kb + (size_t)r0_ * 1024 + h_ * 128; const bf16_t* vb_ = Vb + (size_t)r0_ * 1024 + h_ * 128; \
        _Pragma("unroll") for (int i = 0; i < 4; ++i) { const int off = (w + 8 * i) * 1024 + ln * 16, row = off >> 8, cB = (off & 255) ^ ((row & 7) << 4); \
            __builtin_amdgcn_global_load_lds((const unsigned*)(kb_ + row * 1024 + (cB >> 1)), (LAS unsigned*)(KL + (w + 8 * i) * 1024), 16, 0, 0); } \
        _Pragma("unroll") for (int i = 0; i < 4; ++i) { const int off = (w + 8 * i) * 1024 + ln * 16, t_ = off >> 14, o2 = off & 16383, st = o2 >> 9, rem = o2 & 511, kk = (st >> 2) * 8 + (rem >> 6), cc = (st & 3) * 32 + ((rem & 63) >> 1); \
            const int k_ = ((kk & ~0xC) | ((kk & 4) << 1) | ((kk & 8) >> 1)) + 64 * t_; \
            __builtin_amdgcn_global_load_lds((const unsigned*)(vb_ + k_ * 1024 + cc), (LAS unsigned*)(VL + (w + 8 * i) * 1024), 16, 0, 0); } } while (0)
#define RP2_DMA_B(U) do { const bf16_t* sf_ = SR + (size_t)((U) * 2) * 16384; \
        _Pragma("unroll") for (int i = 0; i < 4; ++i) { const int off = (w + 8 * i) * 1024 + ln * 16, row = off >> 8, cB = (off & 255) ^ ((row & 7) << 4); \
            __builtin_amdgcn_global_load_lds((const unsigned*)(sf_ + row * 128 + (cB >> 1)), (LAS unsigned*)(SF + (w + 8 * i) * 1024), 16, 0, 0); \
            __builtin_amdgcn_global_load_lds((const unsigned*)(sf_ + 16384 + row * 128 + (cB >> 1)), (LAS unsigned*)(SB + (w + 8 * i) * 1024), 16, 0, 0); } } while (0)
    { int ln = lane; asm volatile("" : "+v"(ln)); if (X.bid < 1024) RP2_DMA_A(X.bid); }
    bf16x8 qr[8];
#define RP2_LDQ(U) do { const int u_ = (U); const bf16_t* Qw = Qb + (size_t)((u_ >> 3) * 128 + 32 * rq + r32) * 1024 + (u_ & 7) * 128 + hi * 8; \
        _Pragma("unroll") for (int d0 = 0; d0 < 8; ++d0) qr[d0] = *(const bf16x8*)(Qw + d0 * 16); } while (0)
    if (X.bid < 1024) RP2_LDQ(X.bid);
    asm volatile("s_waitcnt vmcnt(0)" ::: "memory"); __syncthreads();
    for (int u = X.bid; u < 1024; u += X.G) {
        const int ci = u >> 3, h = u & 7, r0 = ci * 128;
        const float lgf = ret_lg(X, l, 0, h), lgb = ret_lg(X, l, 1, h);
        int ln = lane; asm volatile("" : "+v"(ln));
        RP2_DMA_B(u);
        unsigned gq[16][2];
#pragma unroll
        for (int r = 0; r < 16; ++r)
#pragma unroll
            for (int dd = 0; dd < 2; ++dd) gq[r][dd] = Gb[(size_t)(r0 + 32 * rq + crow(r, hi)) * 1024 + h * 128 + 32 * (2 * ch + dd) + r32];
        __builtin_amdgcn_sched_barrier(0);
        bf16x8 pa[8];
        { int i = 32 * rq + r32, hq = hi; asm volatile("" : "+v"(i), "+v"(hq));
#pragma unroll
          for (int kb = 0; kb < 4; ++kb) { f32x16 p = {};
#pragma unroll
            for (int d0 = 0; d0 < 8; ++d0) { const bf16x8 kf = *(const bf16x8*)(KL + KS256(32 * kb + r32, (d0 * 16 + hi * 8) * 2)); p = __builtin_amdgcn_mfma_f32_32x32x16_bf16(kf, qr[d0], p, 0, 0, 0); }
#pragma unroll
            for (int r = 0; r < 16; ++r) { const int dl = i - (32 * kb + crow(r, hq)); const float ex = __builtin_amdgcn_exp2f(dl >= 0 ? lgf * (float)dl : -lgb * (float)dl); p[r] *= (dl == 0 ? 2.f * RET_SC : RET_SC) * ex; }
#define RPK4(P, BASE, OUT) do { unsigned a0 = cvt_pk_bf16(P[BASE + 0], P[BASE + 1]), a1 = cvt_pk_bf16(P[BASE + 2], P[BASE + 3]), b0 = cvt_pk_bf16(P[BASE + 4], P[BASE + 5]), b1 = cvt_pk_bf16(P[BASE + 6], P[BASE + 7]); \
            auto x0 = __builtin_amdgcn_permlane32_swap(a0, b0, false, false); auto x1 = __builtin_amdgcn_permlane32_swap(a1, b1, false, false); u32x4 wv = {x0[0], x1[0], x0[1], x1[1]}; OUT = __builtin_bit_cast(bf16x8, wv); } while (0)
            RPK4(p, 0, pa[2 * kb]); RPK4(p, 8, pa[2 * kb + 1]);
            asm volatile("" ::: "memory"); __builtin_amdgcn_sched_barrier(0);
#undef RPK4
          } }
        f32x16 o[2] = {};
        if (ch == 0) { pv128<0>(o[0], vb, pa); pv128<1>(o[1], vb, pa); } else { pv128<2>(o[0], vb, pa); pv128<3>(o[1], vb, pa); }
        asm volatile("s_waitcnt vmcnt(0)" ::: "memory"); __syncthreads();
        if (u + X.G < 1024) RP2_DMA_A(u + X.G);
        { const int i = 32 * rq + r32; const float scf = exp2f(lgf * (float)(i + 1)), scb = exp2f(lgb * (float)(128 - i));
#pragma unroll
          for (int ks = 0; ks < 8; ++ks) { const bf16x8 qf = scale_frag(qr[ks], scf), qb = scale_frag(qr[ks], scb);
#pragma unroll
            for (int dd = 0; dd < 2; ++dd) { const int row = 32 * (2 * ch + dd) + r32, cb = (ks * 16 + hi * 8) * 2;
                const bf16x8 sfv = *(const bf16x8*)(SF + KS256(row, cb)), sbv = *(const bf16x8*)(SB + KS256(row, cb));
                o[dd] = __builtin_amdgcn_mfma_f32_32x32x16_bf16(qf, sfv, o[dd], 0, 0, 0); o[dd] = __builtin_amdgcn_mfma_f32_32x32x16_bf16(qb, sbv, o[dd], 0, 0, 0); }
            asm volatile("" ::: "memory"); __builtin_amdgcn_sched_barrier(0); } }
        if (u + X.G < 1024) RP2_LDQ(u + X.G);
        __builtin_amdgcn_sched_barrier(0);
        float s1[16], s2[16];
#pragma unroll
        for (int r = 0; r < 16; ++r) { float a = o[0][r] + o[1][r], b = o[0][r] * o[0][r] + o[1][r] * o[1][r];
#pragma unroll
            for (int m = 1; m < 32; m <<= 1) { a += __shfl_xor(a, m); b += __shfl_xor(b, m); }
            s1[r] = a; s2[r] = b; }
        if (r32 == 0) {
#pragma unroll
            for (int r = 0; r < 16; ++r) { ST[(w * 32 + crow(r, hi)) * 2] = s1[r]; ST[(w * 32 + crow(r, hi)) * 2 + 1] = s2[r]; } }
        __syncthreads();
#pragma unroll
        for (int r = 0; r < 16; ++r) { const int row = crow(r, hi); const float a = s1[r] + ST[((w ^ 4) * 32 + row) * 2], b = s2[r] + ST[((w ^ 4) * 32 + row) * 2 + 1];
            const float mu = a * (1.f / 128.f), var = b * (1.f / 128.f) - mu * mu, rstd = rsqrtf(fmaxf(var, 0.f) + EPS);
            const size_t ro = (size_t)(r0 + 32 * rq + row) * 1024 + h * 128;
#pragma unroll
            for (int dd = 0; dd < 2; ++dd) { const int c = 32 * (2 * ch + dd) + r32; const float gv = __uint_as_float(gq[r][dd] << 16);
                YB[(size_t)(r0 + 32 * rq + row) * LDY3 + h * 128 + c] = f2bf(gv * sigm(gv) * ((o[dd][r] - mu) * rstd) * gain[h * 128 + c]); } }
        asm volatile("s_waitcnt vmcnt(0)" ::: "memory"); __syncthreads();
    }
#undef RP2_DMA_A
#undef RP2_DMA_B
#undef RP2_LDQ
}
}

#ifndef GA
#define GA true
#endif
#ifndef GS
#define GS true
#endif
#ifndef MK_PER_PHASE
#define MK_PER_PHASE 0
#endif
constexpr int NPH = 14, NPHASES = 2 * NPH;
struct Args { const float* in[37]; float* out; unsigned char* ws; int ph_lo, ph_hi, li, pad; };
template <int l> __device__ __forceinline__ void run_layer(const Args& args, unsigned char* lds, const XcdBarrier& bar, const int lo, const int hi, PG8_LAS unsigned char* ring) {
#define PHASE_CTX Ctx X; { unsigned char* w_ = args.ws; float* o_ = args.out; const float* const* i_ = args.in; w_ = (unsigned char*)opaque_uniform(w_); o_ = (float*)opaque_uniform(o_); \
        X.ws = w_; X.out = o_; X.in = i_; X.lds = lds; X.G = gridDim.x; X.bid = blockIdx.x; } unsigned char* ws = X.ws; const int G = X.G, bid = X.bid; (void)ws; (void)G; (void)bid;
        const int pb = l * NPH;
#ifndef SUBMASK
#define SUBMASK 0xFF
#endif
#define SUB(j) (((SUBMASK) >> (j)) & 1)
#ifndef PHMASK
#define PHMASK 0xFFFF
#endif
#define IN(k) ((((PHMASK) >> (k)) & 1) && lo <= pb + (k) && pb + (k) < hi)
#ifndef PROBE_MASK
#define PROBE_MASK 0
#endif
#define REP(id) for (int rep_ = 0; rep_ < ((((PROBE_MASK) >> (id)) & 1) ? 2 : 1); ++rep_)
#define SEAM(k) do { if (pb + (k) + 1 < hi) xcd_barrier(bar); } while (0)
        if (l == 0 && IN(0)) { PHASE_CTX  phase_pre(X, 0); SEAM(0); }
        if (l == 0 && IN(1)) { PHASE_CTX  phase_norm<0>(X, 0, nullptr); SEAM(1); }
        if (IN(2)) { PHASE_CTX
            Gemm g{(const bf16_t*)(ws + WS_H), (const bf16_t*)(ws + WS_WIN), 2048, 2048, 2048}; StaticOrder S; S.init(M, NP2 + 512, G, bid);
            EpiP2 E{(bf16_t*)(ws + WS_UG), (bf16_t*)(ws + WS_Q), (bf16_t*)(ws + WS_K), (bf16_t*)(ws + WS_V), (bf16_t*)(ws + WS_G), (bf16_t*)(ws + WS_CQ), (bf16_t*)(ws + WS_CKV), (bf16_t*)(ws + WS_KR), (bf16_t*)(ws + WS_G2)};
            REP(2) gemm_phase<EpiP2, StaticOrder, GA, GS>(ring, g, S, E); SEAM(2); }
        if (IN(3)) { PHASE_CTX
            { Gemm g{(const bf16_t*)(ws + WS_UG), (const bf16_t*)(ws + WS_BTE), 768, 512, 512}; OrderS5E S{G, bid}; EpiS5E E{(float*)(ws + WS_ELOC)};
              REP(3) gemm_phase<EpiS5E, OrderS5E, GA, GS>(ring, g, S, E); }
            __syncthreads();
            REP(4) ret::phase_ret_pass1(X, l);
            phase_mla_norm(X, l); SEAM(3); }
        if (IN(4)) { PHASE_CTX
            { Gemm g{(const bf16_t*)(ws + WS_CQ), (const bf16_t*)(ws + WS_WUQ), 768, 768, 768}; StaticOrder S; S.init(M, 1536, G, bid); EpiBf16Plain E{(bf16_t*)(ws + WS_QMLA), 1536};
              REP(5) gemm_phase<EpiBf16Plain, StaticOrder, GA, GS>(ring, g, S, E); }
            { Gemm g{(const bf16_t*)(ws + WS_CKV), (const bf16_t*)(ws + WS_WKV), 512, 512, 512}; StaticOrder S; S.init(MK, 2048, G, (bid + G / 2) % G); EpiBf16Plain E{(bf16_t*)(ws + WS_KVMLA), 2048};
              REP(5) gemm_phase<EpiBf16Plain, StaticOrder, GA, GS>(ring, g, S, E); }
            REP(6) phase_s5_carry(X, l);
            REP(7) phase_ret_prefix(X, l); SEAM(4); }
        if (IN(5)) { PHASE_CTX
            { Gemm g{(const bf16_t*)(ws + WS_UG), (const bf16_t*)(ws + WS_BTY), 768, 768, 768}; OrderS5Y S{G, bid}; EpiS5Y E{(const bf16_t*)(ws + WS_UG), X.in[21] + l * 1024, (bf16_t*)(ws + WS_YAP)};
              REP(8) gemm_phase<EpiS5Y, OrderS5Y, GA, GS>(ring, g, S, E); }
            __syncthreads();
            REP(9) att::phase_attn(X);
            REP(10) ret::phase_ret_pass2(X, l); SEAM(5); }
        if (IN(6)) { PHASE_CTX
            const bool up = bid >= G / 2;
            Gemm gg{(const bf16_t*)(ws + WS_YAP), (const bf16_t*)(ws + WS_WGLU), 1024, 1024, 1024}; StaticOrder SG; SG.init(M, 1024, G - G / 2, up ? bid - G / 2 : 0);
            EpiGlu EG{(const bf16_t*)(ws + WS_YAP), X.in[23] + l * 1024, (bf16_t*)(ws + WS_Y3), LDY3};
            if (up) { OrderSlice S0{SG, 0, 1}; gemm_phase<EpiGlu, OrderSlice, GA, GS>(ring, gg, S0, EG); }
            { Gemm g{(const bf16_t*)(ws + WS_H), (const bf16_t*)(ws + WS_WIN) + (size_t)(NP2 + 512) * 2048, 2048, 2048, 2048}; StaticOrder S; S.init(M, NGATE - 512, G, bid); EpiBf16Plain E{(bf16_t*)(ws + WS_GATES) + 512, NGATE};
              gemm_phase<EpiBf16Plain, StaticOrder, GA, GS>(ring, g, S, E); }
            if (up) { OrderSlice S1{SG, 1, 1}; gemm_phase<EpiGlu, OrderSlice, GA, GS>(ring, gg, S1, EG); }
            SEAM(6); }
        if (IN(7)) { PHASE_CTX
            Gemm g{(const bf16_t*)(ws + WS_Y3), (const bf16_t*)(ws + WS_WBR), LDY3, 3072, 3072}; StaticOrder S; S.init(M, 2048, G, bid);
            EpiBranch3 E{(const bf16_t*)(ws + WS_GATES), (const bf16_t*)(ws + WS_G2), (bf16_t*)(ws + WS_MERGED)};
            REP(13) gemm_phase<EpiBranch3, StaticOrder, GA, GS>(ring, g, S, E); SEAM(7); }
        if (IN(8)) { PHASE_CTX
            Gemm g{(const bf16_t*)(ws + WS_MERGED), (const bf16_t*)(ws + WS_WOUT), 2048, 2048, 2048}; StaticOrder S; S.init(M, 2048, G, bid); EpiBf16Plain E{(bf16_t*)(ws + WS_MO), 2048};
            REP(14) gemm_phase<EpiBf16Plain, StaticOrder, GA, GS>(ring, g, S, E); SEAM(8); }
        if (IN(9)) { PHASE_CTX  phase_norm<1>(X, l, (const bf16_t*)(ws + WS_MO)); SEAM(9); }
        if (IN(10)) { PHASE_CTX
            Gemm g{(const bf16_t*)(ws + WS_H), (const bf16_t*)(ws + WS_WUP), 2048, 2048, 2048}; StaticOrder S; S.init(M, DFF2, G, bid); EpiUpConv E{X.in[34] + (size_t)l * 3 * DFF2, X.in[35] + (size_t)l * DFF2, (bf16_t*)(ws + WS_AF), (float*)(ws + WS_HALO), (PG8_LAS float*)(ring + XCH_OFF)};
            REP(15) gemm_phase<EpiUpConv, StaticOrder, true, true>(ring, g, S, E); SEAM(10); }
        if (IN(11)) { PHASE_CTX  phase_convfix(X, l); SEAM(11); }
        if (IN(12)) { PHASE_CTX
            Gemm g{(const bf16_t*)(ws + WS_AF), (const bf16_t*)(ws + WS_WDN), DFF, DFF, DFF}; StaticOrder S; S.init(M, 2048, G, bid); EpiBf16Plain E{(bf16_t*)(ws + WS_DN), 2048};
            REP(17) gemm_phase<EpiBf16Plain, StaticOrder, GA, GS>(ring, g, S, E); SEAM(12); }
        if (IN(13)) { PHASE_CTX  phase_norm<2>(X, l, (const bf16_t*)(ws + WS_DN)); if (l == 0) phase_pre(X, 1); if (l == 0 && pb + 16 < hi) xcd_barrier(bar); }
#undef IN
#undef SEAM
#undef PHASE_CTX
}
__global__ void __launch_bounds__(512, 2) mk_fwd(Args args) {
    extern __shared__ __attribute__((aligned(16))) unsigned char lds[];
    volatile LAS unsigned* MISC = (volatile LAS unsigned*)((LAS unsigned char*)lds + MISC_OFF);
    if (threadIdx.x < 32) MISC[threadIdx.x] = 0u;
    __syncthreads();
    XcdBarrier bar = xcd_barrier_post((unsigned*)(args.ws + WS_CTL) + CW_BAR + args.li * XCD_BAR_WORDS, MISC + 8);
    const int lo = args.ph_lo, hi = args.ph_hi;
    PG8_LAS unsigned char* ring = (PG8_LAS unsigned char*)lds;
    run_layer<0>(args, lds, bar, lo, hi, ring);
    run_layer<1>(args, lds, bar, lo, hi, ring);
}

extern "C" void kernel_launch(void* const* d_in, const int* in_sizes, int n_in, void* d_out, int out_size, void* d_ws, size_t ws_size, hipStream_t stream) {
    static int grid = 0;
    if (grid == 0) {
        if (n_in != 37 || (size_t)out_size != O_END || ws_size < WS_END) { fprintf(stderr, "kernel_launch: unexpected shapes: n_in %d out %d ws %zu (need %zu)\n", n_in, out_size, ws_size, (size_t)WS_END); grid = -1; return; }
        int dev = 0, cus = 0;
        if (hipGetDevice(&dev) != hipSuccess || hipDeviceGetAttribute(&cus, hipDeviceAttributeMultiprocessorCount, dev) != hipSuccess) { grid = -1; return; }
        if (hipFuncSetAttribute((const void*)mk_fwd, hipFuncAttributeMaxDynamicSharedMemorySize, LDS_BYTES) != hipSuccess) { fprintf(stderr, "kernel_launch: hipFuncSetAttribute failed\n"); grid = -1; return; }
        int per_cu = 0;
        if (hipOccupancyMaxActiveBlocksPerMultiprocessor(&per_cu, (const void*)mk_fwd, 512, LDS_BYTES) != hipSuccess || per_cu < 1) fprintf(stderr, "kernel_launch: occupancy query reports %d\n", per_cu);
        (void)hipGetLastError();
        grid = cus;
    }
    if (grid < 0) return;
    (void)hipMemsetAsync((char*)d_ws + WS_CTL, 0, MK_PER_PHASE ? 1 * MiB : 32 * 1024, stream);
    Args a{};
    for (int i = 0; i < 37; ++i) a.in[i] = (const float*)d_in[i];
    a.out = (float*)d_out; a.ws = (unsigned char*)d_ws; a.pad = 0;
#if MK_PER_PHASE
    for (int p = 0; p < NPHASES; ++p) { a.ph_lo = p; a.ph_hi = p + 1; a.li = p; hipLaunchKernelGGL(mk_fwd, dim3(grid), dim3(512), LDS_BYTES, stream, a); }
#else
    a.ph_lo = 0; a.ph_hi = NPHASES; a.li = 0; hipLaunchKernelGGL(mk_fwd, dim3(grid), dim3(512), LDS_BYTES, stream, a);
#endif
    const hipError_t le = hipPeekAtLastError();
    if (le != hipSuccess) fprintf(stderr, "kernel_launch: launch failed: %s\n", hipGetErrorName(le));
}
```

```cpp
#include <hip/hip_runtime.h>
#include <cstdio>
#include <cstdint>
namespace pg8 {
#define PG8_LAS __attribute__((address_space(3)))
typedef unsigned short bf16_t;
typedef short bf16x8 __attribute__((ext_vector_type(8)));
typedef float f32x4 __attribute__((ext_vector_type(4)));
typedef unsigned u32x4 __attribute__((ext_vector_type(4)));
typedef unsigned u32x2 __attribute__((ext_vector_type(2)));
constexpr int BM = 256, BK = 64, HALF = 128, HTB = HALF * BK * 2  , STAGE_BYTES = 8 * HTB, NXCD = 8, WGM = 8;

__host__ __device__ __forceinline__ int lds_byte(int r, int c) { const int st = (r >> 4) * 2 + (c >> 5), rr = r & 15, cc = c & 31, ob = rr * 64 + cc * 2; return st * 1024 + (ob ^ (((ob >> 9) & 1) << 5)); }
__host__ __device__ __forceinline__ void stage_rc(int b, int& R, int& C) { const int st = b / 1024, sb = b % 1024, swz = sb ^ (((sb >> 9) & 1) << 5); R = (st >> 1) * 16 + swz / 64; C = (st & 1) * 32 + (swz % 64) / 2; }
__host__ __device__ __forceinline__ int perm32(int rho) { const int n = rho >> 4, i = rho & 15; return 8 * (i >> 2) + 4 * n + (i & 3); }

struct Unit { int pm, pn; };
struct Gemm { const bf16_t* A; const bf16_t* Bt; int lda, ldb, K; };

struct StaticOrder {
    int nM, nN, nwg, G, c;
    __host__ __device__ void init(int M, int N, int G_, int c_) { nM = M / BM; nN = N / BM; nwg = nM * nN; G = G_; c = c_; }
    __host__ __device__ bool next(int i, Unit& u) const {
        const long L = (long)i * G + c; if (L >= nwg) return false;
        int wgid = (int)L; { const int q = nwg / NXCD, r = nwg % NXCD, xcd = wgid % NXCD, off = wgid / NXCD; wgid = (xcd < r ? xcd * (q + 1) : r * (q + 1) + (xcd - r) * q) + off; }
        const int nig = WGM * nN, gid = wgid / nig, fm = gid * WGM, gsz = (nM - fm) < WGM ? (nM - fm) : WGM;
        u.pm = fm + ((wgid % nig) % gsz); u.pn = (wgid % nig) / gsz; return true;
    }
    __device__ __forceinline__ void a_ready(const Unit&) const {}
    __device__ __forceinline__ void done(const Unit&) const {}
};
struct OrderSlice {
    StaticOrder base; int first, count;
    __device__ bool next(int i, Unit& u) const { if (i >= count) return false; return base.next(first + i, u); }
    __device__ __forceinline__ void a_ready(const Unit&) const {}
    __device__ __forceinline__ void done(const Unit&) const {}
};
struct OrderS5E {
    int G, c;
    __device__ bool next(int i, Unit& u) const { const int L = i * G + c; if (L >= 128) return false; u.pm = L; u.pn = L >> 1; return true; }
    __device__ __forceinline__ void a_ready(const Unit&) const {}
    __device__ __forceinline__ void done(const Unit&) const {}
};
struct OrderS5Y {
    int G, c;
    __device__ bool next(int i, Unit& u) const { const int L = i * G + c; if (L >= 256) return false; const int g = L >> 2; u.pm = 2 * g + ((L >> 1) & 1); u.pn = 2 * g + (L & 1); return true; }
    __device__ __forceinline__ void a_ready(const Unit&) const {}
    __device__ __forceinline__ void done(const Unit&) const {}
};
__device__ __forceinline__ unsigned cvt_pk_bf16(float lo, float hi) { unsigned r; asm volatile("v_cvt_pk_bf16_f32 %0, %1, %2" : "=v"(r) : "v"(lo), "v"(hi)); return r; }
__device__ __forceinline__ float bflo(unsigned w) { return __uint_as_float(w << 16); }
__device__ __forceinline__ float bfhi(unsigned w) { return __uint_as_float(w & 0xffff0000u); }
__device__ __forceinline__ float bf2f(bf16_t v) { return __uint_as_float(((unsigned)v) << 16); }
__device__ __forceinline__ bf16_t f2bf(float f) { unsigned u = __float_as_uint(f); u += 0x7fffu + ((u >> 16) & 1u); return (bf16_t)(u >> 16); }
__device__ __forceinline__ float sigm(float x) { return __builtin_amdgcn_rcpf(1.f + __expf(-x)); }
__device__ __forceinline__ float gelu_tanh(float x) { const float z = 1.5957691216f * (x + 0.044715f * x * x * x); return x * __builtin_amdgcn_rcpf(1.f + __expf(-z)); }

#define GAS1 __attribute__((address_space(1)))
__device__ __forceinline__ void gstore16(bf16_t* p, u32x4 w) { *(GAS1 u32x4*)(GAS1 void*)p = w; }
__device__ __forceinline__ u32x4 gload16(const bf16_t* p) { return *(const GAS1 u32x4*)(const GAS1 void*)p; }
__device__ __forceinline__ u32x4 xl(u32x4 w, int src4) { u32x4 r; r.x = (unsigned)__builtin_amdgcn_ds_bpermute(src4, (int)w.x); r.y = (unsigned)__builtin_amdgcn_ds_bpermute(src4, (int)w.y);
    r.z = (unsigned)__builtin_amdgcn_ds_bpermute(src4, (int)w.z); r.w = (unsigned)__builtin_amdgcn_ds_bpermute(src4, (int)w.w); return r; }
struct EpiBf16Plain {
    static constexpr bool PERM = true, AFTER_DRAIN = false, MID = false;
    bf16_t* O; int ldc;
    __device__ __forceinline__ void operator()(const f32x4 (&acc)[2][2][4][2], const Unit& u, int wr, int wc, int fr, int fq) const {
        const int lane = fq * 16 + fr, fr2 = lane >> 2, fq2 = lane & 3, src4 = (fq2 * 16 + fr2) * 4;
        const int row0 = u.pm * BM + wr * 64 + fr2, col0 = u.pn * BM + wc * 32 + 8 * fq2;
#pragma unroll
        for (int ai = 0; ai < 2; ++ai)
#pragma unroll
            for (int m = 0; m < 4; ++m) { bf16_t* rowp = O + (size_t)(row0 + ai * HALF + m * 16) * ldc + col0;
#pragma unroll
                for (int bj = 0; bj < 2; ++bj) { const f32x4 v0 = acc[ai][bj][m][0], v1 = acc[ai][bj][m][1];
                    u32x4 w; w.x = cvt_pk_bf16(v0[0], v0[1]); w.y = cvt_pk_bf16(v0[2], v0[3]); w.z = cvt_pk_bf16(v1[0], v1[1]); w.w = cvt_pk_bf16(v1[2], v1[3]);
                    gstore16(rowp + bj * HALF, xl(w, src4)); } }
    }
};
struct EpiF32Plain {
    static constexpr bool PERM = false, AFTER_DRAIN = false, MID = false;
    float* C; int ldc;
    __device__ __forceinline__ void operator()(const f32x4 (&acc)[2][2][4][2], const Unit& u, int wr, int wc, int fr, int fq) const {
        const int row0 = u.pm * BM + wr * 64 + fr, col0 = u.pn * BM + wc * 32 + 4 * fq;
#pragma unroll
        for (int ai = 0; ai < 2; ++ai)
#pragma unroll
            for (int m = 0; m < 4; ++m) { float* rowp = C + (size_t)(row0 + ai * HALF + m * 16) * ldc + col0;
#pragma unroll
                for (int bj = 0; bj < 2; ++bj)
#pragma unroll
                    for (int n = 0; n < 2; ++n) *(f32x4*)(rowp + bj * HALF + n * 16) = acc[ai][bj][m][n]; }
    }
};
struct EpiP2 {
    static constexpr bool PERM = true, AFTER_DRAIN = false, MID = false;
    bf16_t *UG, *Q, *K, *V, *Gt, *CQ, *CKV, *KR, *GATES;
    __device__ __forceinline__ void operator()(const f32x4 (&acc)[2][2][4][2], const Unit& u, int wr, int wc, int fr, int fq) const {
        const int pn = u.pn, row0 = u.pm * BM + wr * 64 + fr, cl = wc * 32 + 8 * fq;
        if (pn < 4) {
#pragma unroll
            for (int ai = 0; ai < 2; ++ai)
#pragma unroll
                for (int m = 0; m < 4; ++m) { const int r = row0 + ai * HALF + m * 16, chunk = r >> 5, tt = r & 31;
#pragma unroll
                    for (int bj = 0; bj < 2; ++bj) { const int c = pn * 256 + bj * HALF + cl, g = c >> 4, cp = c & 15;
                        const f32x4 v0 = acc[ai][bj][m][0], v1 = acc[ai][bj][m][1];
                        u32x4 w; w.x = cvt_pk_bf16(v0[0], v0[1]); w.y = cvt_pk_bf16(v0[2], v0[3]); w.z = cvt_pk_bf16(v1[0], v1[1]); w.w = cvt_pk_bf16(v1[2], v1[3]);
                        gstore16(UG + ((size_t)(g * 512 + chunk)) * 768 + tt * 16 + cp, w); } }
        } else {
            bf16_t* base; int ldc, colt;
            if (pn < 8) { base = Q; ldc = 1024; colt = (pn - 4) * 256; }
            else if (pn < 12) { base = K; ldc = 1024; colt = (pn - 8) * 256; }
            else if (pn < 16) { base = V; ldc = 1024; colt = (pn - 12) * 256; }
            else if (pn < 20) { base = Gt; ldc = 1024; colt = (pn - 16) * 256; }
            else if (pn < 23) { base = CQ; ldc = 768; colt = (pn - 20) * 256; }
            else if (pn < 25) { base = CKV; ldc = 512; colt = (pn - 23) * 256; }
            else if (pn == 25) { base = KR; ldc = 64; colt = 0; }
            else { base = GATES; ldc = 512; colt = (pn - 26) * 256; }
            const bool narrow = (pn == 25);
#pragma unroll
            for (int ai = 0; ai < 2; ++ai)
#pragma unroll
                for (int m = 0; m < 4; ++m) { bf16_t* rowp = base + (size_t)(row0 + ai * HALF + m * 16) * ldc + colt + cl;
#pragma unroll
                    for (int bj = 0; bj < 2; ++bj) { if (narrow && (bj * HALF + cl) >= 64) continue;
                        const f32x4 v0 = acc[ai][bj][m][0], v1 = acc[ai][bj][m][1];
                        u32x4 w; w.x = cvt_pk_bf16(v0[0], v0[1]); w.y = cvt_pk_bf16(v0[2], v0[3]); w.z = cvt_pk_bf16(v1[0], v1[1]); w.w = cvt_pk_bf16(v1[2], v1[3]);
                        gstore16(rowp + bj * HALF, w); } }
        }
    }
};
struct EpiS5E {
    static constexpr bool PERM = false, AFTER_DRAIN = false, MID = false;
    float* C;
    __device__ __forceinline__ void operator()(const f32x4 (&acc)[2][2][4][2], const Unit& u, int wr, int wc, int fr, int fq) const {
        const int row0 = u.pm * BM + wr * 64 + fr, col0 = wc * 32 + 4 * fq;
#pragma unroll
        for (int ai = 0; ai < 2; ++ai)
#pragma unroll
            for (int m = 0; m < 4; ++m) { float* rowp = C + (size_t)(row0 + ai * HALF + m * 16) * 256 + col0;
#pragma unroll
                for (int bj = 0; bj < 2; ++bj)
#pragma unroll
                    for (int n = 0; n < 2; ++n) *(f32x4*)(rowp + bj * HALF + n * 16) = acc[ai][bj][m][n]; }
    }
};
struct EpiS5Y {
    static constexpr bool PERM = true, AFTER_DRAIN = false, MID = false;
    const bf16_t* UG; const float* Dv; bf16_t* YA;
    __device__ __forceinline__ void operator()(const f32x4 (&acc)[2][2][4][2], const Unit& u, int wr, int wc, int fr, int fq) const {
        const int g = u.pm >> 1, a0 = (u.pm & 1) * 256 + wr * 64 + fr, ncl = (u.pn & 1) * 256 + wc * 32 + 8 * fq;
        f32x4 dv[2][2];
#pragma unroll
        for (int bj = 0; bj < 2; ++bj) { const int ch = g * 16 + ((ncl + bj * HALF) & 15); dv[bj][0] = *(const f32x4*)(Dv + ch); dv[bj][1] = *(const f32x4*)(Dv + ch + 4); }
#pragma unroll
        for (int ai = 0; ai < 2; ++ai) { u32x4 uw[4][2];
#pragma unroll
            for (int m = 0; m < 4; ++m)
#pragma unroll
                for (int bj = 0; bj < 2; ++bj) { const int a = a0 + ai * HALF + m * 16, nloc = ncl + bj * HALF; uw[m][bj] = *(const u32x4*)(UG + ((size_t)(g * 512 + a)) * 768 + (nloc >> 4) * 16 + (nloc & 15)); }
            __builtin_amdgcn_sched_barrier(0);
#pragma unroll
            for (int m = 0; m < 4; ++m)
#pragma unroll
                for (int bj = 0; bj < 2; ++bj) { const int a = a0 + ai * HALF + m * 16, nloc = ncl + bj * HALF, t = nloc >> 4, cp = nloc & 15, r = a * 32 + t, ch = g * 16 + cp;
                    const u32x4 x = uw[m][bj]; const f32x4 d0 = dv[bj][0], d1 = dv[bj][1], v0 = acc[ai][bj][m][0], v1 = acc[ai][bj][m][1];
                    const float y0 = gelu_tanh(v0[0] + d0[0] * bflo(x.x)), y1 = gelu_tanh(v0[1] + d0[1] * bfhi(x.x)), y2 = gelu_tanh(v0[2] + d0[2] * bflo(x.y)), y3 = gelu_tanh(v0[3] + d0[3] * bfhi(x.y));
                    const float y4 = gelu_tanh(v1[0] + d1[0] * bflo(x.z)), y5 = gelu_tanh(v1[1] + d1[1] * bfhi(x.z)), y6 = gelu_tanh(v1[2] + d1[2] * bflo(x.w)), y7 = gelu_tanh(v1[3] + d1[3] * bfhi(x.w));
                    u32x4 w; w.x = cvt_pk_bf16(y0, y1); w.y = cvt_pk_bf16(y2, y3); w.z = cvt_pk_bf16(y4, y5); w.w = cvt_pk_bf16(y6, y7);
                    *(u32x4*)(YA + (size_t)r * 1024 + ch) = w; }
            asm volatile("" ::: "memory"); }
    }
};
struct EpiGlu {
    static constexpr bool PERM = true, AFTER_DRAIN = false, MID = false;
    const bf16_t* YP; const float* bias; bf16_t* O; int ldo;
    __device__ __forceinline__ void operator()(const f32x4 (&acc)[2][2][4][2], const Unit& u, int wr, int wc, int fr, int fq) const {
        const int row0 = u.pm * BM + wr * 64 + fr, col0 = u.pn * BM + wc * 32 + 8 * fq;
        f32x4 bv[2][2];
#pragma unroll
        for (int bj = 0; bj < 2; ++bj) { bv[bj][0] = *(const f32x4*)(bias + col0 + bj * HALF); bv[bj][1] = *(const f32x4*)(bias + col0 + bj * HALF + 4); }
#pragma unroll
        for (int ai = 0; ai < 2; ++ai) { u32x4 yw[4][2];
#pragma unroll
            for (int m = 0; m < 4; ++m)
#pragma unroll
                for (int bj = 0; bj < 2; ++bj) yw[m][bj] = *(const u32x4*)(YP + (size_t)(row0 + ai * HALF + m * 16) * 1024 + col0 + bj * HALF);
            __builtin_amdgcn_sched_barrier(0);
#pragma unroll
            for (int m = 0; m < 4; ++m)
#pragma unroll
                for (int bj = 0; bj < 2; ++bj) { const u32x4 y = yw[m][bj]; const f32x4 v0 = acc[ai][bj][m][0] + bv[bj][0], v1 = acc[ai][bj][m][1] + bv[bj][1];
                    u32x4 w; w.x = cvt_pk_bf16(bflo(y.x) * sigm(v0[0]), bfhi(y.x) * sigm(v0[1])); w.y = cvt_pk_bf16(bflo(y.y) * sigm(v0[2]), bfhi(y.y) * sigm(v0[3]));
                    w.z = cvt_pk_bf16(bflo(y.z) * sigm(v1[0]), bfhi(y.z) * sigm(v1[1])); w.w = cvt_pk_bf16(bflo(y.w) * sigm(v1[2]), bfhi(y.w) * sigm(v1[3]));
                    *(u32x4*)(O + (size_t)(row0 + ai * HALF + m * 16) * ldo + col0 + bj * HALF) = w; }
            asm volatile("" ::: "memory"); }
    }
};
template <int ST> struct EpiBranch {
    static constexpr bool PERM = true, AFTER_DRAIN = false, MID = false;
    const bf16_t* GT; bf16_t* OUT; const bf16_t* G2;
    __device__ __forceinline__ void operator()(const f32x4 (&acc)[2][2][4][2], const Unit& u, int wr, int wc, int fr, int fq) const {
        const int row0 = u.pm * BM + wr * 64 + fr, col0 = u.pn * BM + wc * 32 + 8 * fq;
        const bool early = (ST == 0) && u.pn < 2; const bf16_t* gbase = early ? G2 : GT; const int gld = early ? 512 : 6144;
#pragma unroll
        for (int ai = 0; ai < 2; ++ai) {
            u32x4 gw[4][2], tw[4][2];
#pragma unroll
            for (int m = 0; m < 4; ++m)
#pragma unroll
                for (int bj = 0; bj < 2; ++bj) { const int r = row0 + ai * HALF + m * 16, c = col0 + bj * HALF;
                    gw[m][bj] = gload16(gbase + (size_t)r * gld + c);
                    if (ST != 0) tw[m][bj] = gload16(OUT + (size_t)r * 2048 + c); }
#pragma unroll
            for (int m = 0; m < 4; ++m)
#pragma unroll
                for (int bj = 0; bj < 2; ++bj) { const int r = row0 + ai * HALF + m * 16, c = col0 + bj * HALF;
                    const u32x4 g = gw[m][bj]; const f32x4 a0 = acc[ai][bj][m][0], a1 = acc[ai][bj][m][1];
                    float v0 = sigm(bflo(g.x)) * a0[0], v1 = sigm(bfhi(g.x)) * a0[1], v2 = sigm(bflo(g.y)) * a0[2], v3 = sigm(bfhi(g.y)) * a0[3];
                    float v4 = sigm(bflo(g.z)) * a1[0], v5 = sigm(bfhi(g.z)) * a1[1], v6 = sigm(bflo(g.w)) * a1[2], v7 = sigm(bfhi(g.w)) * a1[3];
                    if (ST != 0) { const u32x4 t = tw[m][bj]; v0 += bflo(t.x); v1 += bfhi(t.x); v2 += bflo(t.y); v3 += bfhi(t.y); v4 += bflo(t.z); v5 += bfhi(t.z); v6 += bflo(t.w); v7 += bfhi(t.w); }
                    u32x4 w; w.x = cvt_pk_bf16(v0, v1); w.y = cvt_pk_bf16(v2, v3); w.z = cvt_pk_bf16(v4, v5); w.w = cvt_pk_bf16(v6, v7);
                    gstore16(OUT + (size_t)r * 2048 + c, w); }
            asm volatile("" ::: "memory"); }
    }
};

struct EpiBranch3 {
    static constexpr bool PERM = true, AFTER_DRAIN = false, MID = true;
    const bf16_t* GT; const bf16_t* G2; bf16_t* OUT;
    __device__ __forceinline__ u32x4 gate16(int x, int r, int c) const { return (x == 0 && c < 512) ? gload16(G2 + (size_t)r * 512 + c) : gload16(GT + (size_t)r * 6144 + x * 2048 + c); }
    __device__ __forceinline__ void mid(f32x4 (&acc)[2][2][4][2], const Unit& u, int seg, int wr, int wc, int fr, int fq) const {
        int row0 = u.pm * BM + wr * 64 + fr, col0 = u.pn * BM + wc * 32 + 8 * fq; const int x = seg - 1;
        asm volatile("" : "+v"(row0), "+v"(col0));
#pragma unroll
        for (int ai = 0; ai < 2; ++ai) { u32x4 gn[4][2], gd[4][2];
#pragma unroll
            for (int m = 0; m < 4; ++m)
#pragma unroll
                for (int bj = 0; bj < 2; ++bj) { const int r = row0 + ai * HALF + m * 16, c = col0 + bj * HALF; gn[m][bj] = gate16(x, r, c); gd[m][bj] = gate16(x + 1, r, c); }
            __builtin_amdgcn_sched_barrier(0);
#pragma unroll
            for (int m = 0; m < 4; ++m)
#pragma unroll
                for (int bj = 0; bj < 2; ++bj) { const u32x4 a = gn[m][bj], b = gd[m][bj];
#define CL4(X) (f32x4){__builtin_amdgcn_fmed3f(X[0], -30.f, 30.f), __builtin_amdgcn_fmed3f(X[1], -30.f, 30.f), __builtin_amdgcn_fmed3f(X[2], -30.f, 30.f), __builtin_amdgcn_fmed3f(X[3], -30.f, 30.f)}
#define EX4(X) (f32x4){__builtin_amdgcn_exp2f(X[0]), __builtin_amdgcn_exp2f(X[1]), __builtin_amdgcn_exp2f(X[2]), __builtin_amdgcn_exp2f(X[3])}
#define RC4(X) (f32x4){__builtin_amdgcn_rcpf(X[0]), __builtin_amdgcn_rcpf(X[1]), __builtin_amdgcn_rcpf(X[2]), __builtin_amdgcn_rcpf(X[3])}
                    const f32x4 a0 = (f32x4){bflo(a.x), bfhi(a.x), bflo(a.y), bfhi(a.y)}, a1 = (f32x4){bflo(a.z), bfhi(a.z), bflo(a.w), bfhi(a.w)};
                    const f32x4 b0 = (f32x4){bflo(b.x), bfhi(b.x), bflo(b.y), bfhi(b.y)}, b1 = (f32x4){bflo(b.z), bfhi(b.z), bflo(b.w), bfhi(b.w)};
                    const f32x4 za0 = CL4(a0) * -1.4426950408889634f, za1 = CL4(a1) * -1.4426950408889634f, zb0 = CL4(b0) * -1.4426950408889634f, zb1 = CL4(b1) * -1.4426950408889634f;
                    const f32x4 da0 = EX4(za0) + 1.f, da1 = EX4(za1) + 1.f, nb0 = EX4(zb0) + 1.f, nb1 = EX4(zb1) + 1.f;
                    acc[ai][bj][m][0] *= nb0 * RC4(da0); acc[ai][bj][m][1] *= nb1 * RC4(da1);
#undef CL4
#undef EX4
#undef RC4
                }
            asm volatile("" ::: "memory"); }
    }
    __device__ __forceinline__ void operator()(const f32x4 (&acc)[2][2][4][2], const Unit& u, int wr, int wc, int fr, int fq) const {
        int row0 = u.pm * BM + wr * 64 + fr, col0 = u.pn * BM + wc * 32 + 8 * fq; asm volatile("" : "+v"(row0), "+v"(col0));
#pragma unroll
        for (int ai = 0; ai < 2; ++ai) { u32x4 gw[4][2];
#pragma unroll
            for (int m = 0; m < 4; ++m)
#pragma unroll
                for (int bj = 0; bj < 2; ++bj) gw[m][bj] = gate16(2, row0 + ai * HALF + m * 16, col0 + bj * HALF);
            __builtin_amdgcn_sched_barrier(0);
#pragma unroll
            for (int m = 0; m < 4; ++m)
#pragma unroll
                for (int bj = 0; bj < 2; ++bj) { const u32x4 g = gw[m][bj]; const f32x4 a0 = acc[ai][bj][m][0], a1 = acc[ai][bj][m][1];
                    u32x4 w; w.x = cvt_pk_bf16(sigm(bflo(g.x)) * a0[0], sigm(bfhi(g.x)) * a0[1]); w.y = cvt_pk_bf16(sigm(bflo(g.y)) * a0[2], sigm(bfhi(g.y)) * a0[3]);
                    w.z = cvt_pk_bf16(sigm(bflo(g.z)) * a1[0], sigm(bfhi(g.z)) * a1[1]); w.w = cvt_pk_bf16(sigm(bflo(g.w)) * a1[2], sigm(bfhi(g.w)) * a1[3]);
                    gstore16(OUT + (size_t)(row0 + ai * HALF + m * 16) * 2048 + col0 + bj * HALF, w); }
            asm volatile("" ::: "memory"); }
    }
};
#define DPPF(T, S, W, CTL) "v_fmac_f32_dpp %[" #T "], %[" #S "], %[" #W "] " CTL " row_mask:0xf bank_mask:0xf\n\t"
__device__ __forceinline__ void conv_taps(f32x4& t, const f32x4 c, const f32x4 p, const f32x4 x, const f32x4 a, const f32x4 b, bool hasp, bool hasn) {
    float t0 = t[0], t1 = t[1], t2 = t[2], t3 = t[3];
    asm("s_nop 1\n\t"
        DPPF(t0, c0, a0, "row_shr:1") DPPF(t1, c1, a1, "row_shr:1") DPPF(t2, c2, a2, "row_shr:1") DPPF(t3, c3, a3, "row_shr:1")
        DPPF(t0, c0, b0, "row_shl:1") DPPF(t1, c1, b1, "row_shl:1") DPPF(t2, c2, b2, "row_shl:1") DPPF(t3, c3, b3, "row_shl:1")
        : [t0] "+v"(t0), [t1] "+v"(t1), [t2] "+v"(t2), [t3] "+v"(t3)
        : [c0] "v"(c[0]), [c1] "v"(c[1]), [c2] "v"(c[2]), [c3] "v"(c[3]), [a0] "v"(a[0]), [a1] "v"(a[1]), [a2] "v"(a[2]), [a3] "v"(a[3]), [b0] "v"(b[0]), [b1] "v"(b[1]), [b2] "v"(b[2]), [b3] "v"(b[3]));
    if (hasp) asm("s_nop 1\n\t" DPPF(t0, c0, a0, "row_shl:15") DPPF(t1, c1, a1, "row_shl:15") DPPF(t2, c2, a2, "row_shl:15") DPPF(t3, c3, a3, "row_shl:15")
        : [t0] "+v"(t0), [t1] "+v"(t1), [t2] "+v"(t2), [t3] "+v"(t3) : [c0] "v"(p[0]), [c1] "v"(p[1]), [c2] "v"(p[2]), [c3] "v"(p[3]), [a0] "v"(a[0]), [a1] "v"(a[1]), [a2] "v"(a[2]), [a3] "v"(a[3]));
    if (hasn) asm("s_nop 1\n\t" DPPF(t0, c0, a0, "row_shr:15") DPPF(t1, c1, a1, "row_shr:15") DPPF(t2, c2, a2, "row_shr:15") DPPF(t3, c3, a3, "row_shr:15")
        : [t0] "+v"(t0), [t1] "+v"(t1), [t2] "+v"(t2), [t3] "+v"(t3) : [c0] "v"(x[0]), [c1] "v"(x[1]), [c2] "v"(x[2]), [c3] "v"(x[3]), [a0] "v"(b[0]), [a1] "v"(b[1]), [a2] "v"(b[2]), [a3] "v"(b[3]));
    t[0] = t0; t[1] = t1; t[2] = t2; t[3] = t3;
}
#undef DPPF
template <int CTRL> __device__ __forceinline__ float dppk(float oldv, float src) {
    return __builtin_bit_cast(float, __builtin_amdgcn_update_dpp(__builtin_bit_cast(int, oldv), __builtin_bit_cast(int, src), CTRL, 0xf, 0xf, false)); }
struct EpiUpConv {
    static constexpr bool PERM = true, AFTER_DRAIN = false, MID = false;
    const float* cw; const float* cb; bf16_t* AF; float* HALO; PG8_LAS float* xch;
    __device__ __forceinline__ void operator()(f32x4 (&acc)[2][2][4][2], const Unit& u, int wr, int wc, int fr, int fq) const {
        const int colL = wc * 32 + fq * 8;
#pragma unroll
        for (int ai = 0; ai < 2; ++ai) { const int blk = 2 * ai + wr;
            if (fr == 0) {
#pragma unroll
                for (int bj = 0; bj < 2; ++bj)
#pragma unroll
                    for (int n = 0; n < 2; ++n) *(PG8_LAS f32x4*)(xch + (blk * 2 + 0) * 256 + bj * 128 + colL + 4 * n) = acc[ai][bj][0][n]; }
            if (fr == 15) {
#pragma unroll
                for (int bj = 0; bj < 2; ++bj)
#pragma unroll
                    for (int n = 0; n < 2; ++n) *(PG8_LAS f32x4*)(xch + (blk * 2 + 1) * 256 + bj * 128 + colL + 4 * n) = acc[ai][bj][3][n]; } }
        if (u.pm >= 32) {
            if (wr == 0 && fr < 2) { float* hp = HALO + ((size_t)(u.pm * 4 + fr)) * 11264 + u.pn * 256 + colL;
#pragma unroll
                for (int bj = 0; bj < 2; ++bj)
#pragma unroll
                    for (int n = 0; n < 2; ++n) *(f32x4*)(hp + bj * 128 + 4 * n) = acc[0][bj][0][n]; }
            if (wr == 1 && fr >= 14) { float* hp = HALO + ((size_t)(u.pm * 4 + 2 + (fr - 14))) * 11264 + u.pn * 256 + colL;
#pragma unroll
                for (int bj = 0; bj < 2; ++bj)
#pragma unroll
                    for (int n = 0; n < 2; ++n) *(f32x4*)(hp + bj * 128 + 4 * n) = acc[1][bj][3][n]; }
        }
        asm volatile("s_waitcnt lgkmcnt(0)" ::: "memory"); __builtin_amdgcn_s_barrier(); asm volatile("" ::: "memory");
#pragma unroll
        for (int ai = 0; ai < 2; ++ai) { const int blk = 2 * ai + wr;
#pragma unroll
            for (int bj = 0; bj < 2; ++bj)
#pragma unroll
                for (int n = 0; n < 2; ++n) { const int ch = bj * 5632 + 128 * u.pn + colL + 4 * n;
                    const f32x4 w0 = *(const f32x4*)(cw + ch), w1 = *(const f32x4*)(cw + 11264 + ch), w2 = *(const f32x4*)(cw + 2 * 11264 + ch), bb = *(const f32x4*)(cb + ch);
                    f32x4 xu = (f32x4){0.f, 0.f, 0.f, 0.f}, xd = (f32x4){0.f, 0.f, 0.f, 0.f};
                    if (fr == 0 && blk > 0) xu = *(const PG8_LAS f32x4*)(xch + ((blk - 1) * 2 + 1) * 256 + bj * 128 + colL + 4 * n);
                    if (fr == 15 && blk < 3) xd = *(const PG8_LAS f32x4*)(xch + ((blk + 1) * 2 + 0) * 256 + bj * 128 + colL + 4 * n);
                    f32x4 y[4];
#pragma unroll
                    for (int m = 0; m < 4; ++m) { const f32x4 cur = acc[ai][bj][m][n]; f32x4 t;
                        t = w1 * cur + bb;
                        if (m == 0) t = w0 * xu + t;
                        if (m == 3) t = w2 * xd + t;
                        conv_taps(t, cur, acc[ai][bj][m > 0 ? m - 1 : 0][n], acc[ai][bj][m < 3 ? m + 1 : 3][n], w0, w2, m > 0, m < 3);
                        y[m] = t; }
#pragma unroll
                    for (int m = 0; m < 4; ++m) acc[ai][bj][m][n] = y[m];
                    asm volatile("" : "+v"(acc[ai][bj][0][n]), "+v"(acc[ai][bj][1][n]), "+v"(acc[ai][bj][2][n]), "+v"(acc[ai][bj][3][n]) :: "memory"); } }
#pragma unroll
        for (int ai = 0; ai < 2; ++ai)
#pragma unroll
            for (int m = 0; m < 4; ++m) { const int r = u.pm * BM + ai * HALF + wr * 64 + m * 16 + fr;
                const f32x4 v0 = acc[ai][0][m][0], v1 = acc[ai][0][m][1], g0 = acc[ai][1][m][0], g1 = acc[ai][1][m][1];
                const f32x4 p0 = g0 * v0, p1 = g1 * v1, z0 = g0 * -1.4426950408889634f, z1 = g1 * -1.4426950408889634f;
                f32x4 e0, e1;
#pragma unroll
                for (int e = 0; e < 4; ++e) { e0[e] = __builtin_amdgcn_exp2f(z0[e]); e1[e] = __builtin_amdgcn_exp2f(z1[e]); }
                e0 = e0 + 1.f; e1 = e1 + 1.f;
#pragma unroll
                for (int e = 0; e < 4; ++e) { e0[e] = __builtin_amdgcn_rcpf(e0[e]); e1[e] = __builtin_amdgcn_rcpf(e1[e]); }
                const f32x4 s0 = p0 * e0, s1 = p1 * e1;
                u32x4 w; w.x = cvt_pk_bf16(s0[0], s0[1]); w.y = cvt_pk_bf16(s0[2], s0[3]); w.z = cvt_pk_bf16(s1[0], s1[1]); w.w = cvt_pk_bf16(s1[2], s1[3]);
                gstore16(AF + (size_t)r * 5632 + 128 * u.pn + colL, w); }
    }
};

template <class Epi, class Sched, bool ALIGN_EPI = false, bool SP2 = false>
__device__ __forceinline__ void gemm_phase(PG8_LAS unsigned char* lds, const Gemm g, const Sched& S, const Epi& E) {
    int tid = threadIdx.x; asm volatile("" : "+v"(tid));
    const int wid = __builtin_amdgcn_readfirstlane(tid >> 6), lane = tid & 63, wr = wid >> 2, wc = wid & 3, fr = lane & 15, fq = lane >> 4;
    const int K = g.K, nt = K / BK;
    unsigned voffA[2], voffB[2];
#pragma unroll
    for (int i = 0; i < 2; ++i) { int R, C; stage_rc(tid * 16 + i * 8192, R, C); const int Rb = Epi::PERM ? ((R & ~31) + perm32(R & 31)) : R;
        voffA[i] = (unsigned)(R * g.lda + C) * 2u; voffB[i] = (unsigned)(Rb * g.ldb + C) * 2u; }
    const size_t kstep = (size_t)(BK * 2);
    const size_t hstepA = (size_t)HALF * g.lda * 2, hstepB = (size_t)HALF * g.ldb * 2;
    const size_t tstepA = 2 * hstepA, tstepB = 2 * hstepB;
    const unsigned ldsw = (unsigned)wid * 1024u;
    const int aoff = lds_byte(wr * 64 + fr, fq * 8), boff = lds_byte(wc * 32 + fr, fq * 8);
#define PG8_SA(b, h) (((b) * 2 + (h)) * HTB)
#define PG8_SB(b, h) ((4 + (b) * 2 + (h)) * HTB)
#define PG8_STAGE(bufoff, gbase, voff) do { _Pragma("unroll") for (int _i = 0; _i < 2; ++_i) \
        __builtin_amdgcn_global_load_lds((const unsigned*)((const char*)(gbase) + (voff)[_i]), (PG8_LAS unsigned*)(lds + (bufoff) + ldsw + _i * 8192), 16, 0, 0); } while (0)
#define PG8_LDA(dst, b, h) do { _Pragma("unroll") for (int m = 0; m < 4; ++m) _Pragma("unroll") for (int k = 0; k < 2; ++k) dst[m][k] = *(const PG8_LAS bf16x8*)(lds + PG8_SA(b, h) + aoff + m * 2048 + k * 1024); } while (0)
#define PG8_LDB(dst, b, h) do { _Pragma("unroll") for (int n = 0; n < 2; ++n) _Pragma("unroll") for (int k = 0; k < 2; ++k) dst[n][k] = *(const PG8_LAS bf16x8*)(lds + PG8_SB(b, h) + boff + n * 2048 + k * 1024); } while (0)
#define PG8_MMA(ai, bj, At, Bt) do { __builtin_amdgcn_s_setprio(1); _Pragma("unroll") for (int m = 0; m < 4; ++m) _Pragma("unroll") for (int n = 0; n < 2; ++n) _Pragma("unroll") for (int k = 0; k < 2; ++k) \
        acc[ai][bj][m][n] = __builtin_amdgcn_mfma_f32_16x16x32_bf16(Bt[n][k], At[m][k], acc[ai][bj][m][n], 0, 0, 0); __builtin_amdgcn_s_setprio(0); } while (0)
#define PG8_WAIT_V(n) asm volatile("s_waitcnt vmcnt(" #n ")" ::: "memory")
#define PG8_WAIT_L(n) asm volatile("s_waitcnt lgkmcnt(" #n ")" ::: "memory")
#define PG8_BAR __builtin_amdgcn_s_barrier()
#define PG8_SCHED __builtin_amdgcn_sched_barrier(0)
    Unit cur, nxt; int ui = 0;
    if (!S.next(0, cur)) return;
    f32x4 acc[2][2][4][2];
#pragma unroll
    for (int a = 0; a < 2; ++a)
#pragma unroll
        for (int b = 0; b < 2; ++b)
#pragma unroll
            for (int m = 0; m < 4; ++m)
#pragma unroll
                for (int n = 0; n < 2; ++n) acc[a][b][m][n] = (f32x4){0.f, 0.f, 0.f, 0.f};
    bf16x8 At[4][2], B0[2][2], B1[2][2];
    const char* cA = (const char*)g.A + (size_t)cur.pm * tstepA; const char* cB = (const char*)g.Bt + (size_t)cur.pn * tstepB;
    S.a_ready(cur);
    if constexpr (SP2) {
        PG8_STAGE(PG8_SB(0, 0), cB, voffB); PG8_STAGE(PG8_SB(0, 1), cB + hstepB, voffB); PG8_STAGE(PG8_SA(0, 0), cA, voffA); PG8_STAGE(PG8_SA(0, 1), cA + hstepA, voffA);
        PG8_STAGE(PG8_SB(1, 0), cB + kstep, voffB); PG8_STAGE(PG8_SA(1, 0), cA + kstep, voffA); PG8_STAGE(PG8_SB(1, 1), cB + hstepB + kstep, voffB);
        if (wr == 1) PG8_BAR;
        PG8_WAIT_V(8); PG8_BAR;
        PG8_WAIT_V(6); PG8_BAR;
    } else {
        PG8_STAGE(PG8_SB(0, 0), cB, voffB); PG8_STAGE(PG8_SA(0, 0), cA, voffA); PG8_STAGE(PG8_SB(0, 1), cB + hstepB, voffB); PG8_STAGE(PG8_SA(0, 1), cA + hstepA, voffA);
        if (wr == 1) PG8_BAR;
        PG8_WAIT_V(4); PG8_BAR;
        PG8_STAGE(PG8_SB(1, 0), cB + kstep, voffB); PG8_STAGE(PG8_SA(1, 0), cA + kstep, voffA); PG8_STAGE(PG8_SB(1, 1), cB + hstepB + kstep, voffB);
        PG8_WAIT_V(6); PG8_BAR;
    }
    for (;;) {
        const bool has_next = S.next(ui + 1, nxt);
        const char* nA = has_next ? (const char*)g.A + (size_t)nxt.pm * tstepA : cA; const char* nB = has_next ? (const char*)g.Bt + (size_t)nxt.pn * tstepB : cB;
        for (int t = 0; t < nt; t += 2) {
            const bool last = (t == nt - 2);
            const char* a1 = cA + (size_t)(t + 1) * kstep;
            const char* a2 = last ? nA : cA + (size_t)(t + 2) * kstep; const char* b2 = last ? nB : cB + (size_t)(t + 2) * kstep;
            const char* a3 = a2 + kstep; const char* b3 = b2 + kstep;
            if constexpr (Epi::MID) { if (t == 16 || t == 32) E.mid(acc, cur, t >> 4, wr, wc, fr, fq); }
            if (last && has_next) S.a_ready(nxt);
            if constexpr (SP2) {
            PG8_LDB(B0, 0, 0); PG8_LDB(B1, 0, 1); PG8_SCHED; PG8_LDA(At, 0, 0); PG8_STAGE(PG8_SA(1, 1), a1 + hstepA, voffA);
            PG8_WAIT_V(8); PG8_WAIT_L(0); PG8_BAR; PG8_MMA(0, 0, At, B0); PG8_MMA(0, 1, At, B1); PG8_BAR; PG8_SCHED;
            PG8_LDA(At, 0, 1); PG8_STAGE(PG8_SB(0, 0), b2, voffB); PG8_STAGE(PG8_SB(0, 1), b2 + hstepB, voffB); PG8_STAGE(PG8_SA(0, 0), a2, voffA);
            PG8_WAIT_V(8); PG8_WAIT_L(0); PG8_BAR; PG8_MMA(1, 0, At, B0); PG8_MMA(1, 1, At, B1); PG8_BAR; PG8_SCHED;
            PG8_LDB(B0, 1, 0); PG8_LDB(B1, 1, 1); PG8_SCHED; PG8_LDA(At, 1, 0); PG8_STAGE(PG8_SA(0, 1), a2 + hstepA, voffA);
            PG8_WAIT_V(8); PG8_WAIT_L(0); PG8_BAR; PG8_MMA(0, 0, At, B0); PG8_MMA(0, 1, At, B1); PG8_BAR; PG8_SCHED;
            PG8_LDA(At, 1, 1); PG8_STAGE(PG8_SB(1, 0), b3, voffB); PG8_STAGE(PG8_SB(1, 1), b3 + hstepB, voffB); PG8_STAGE(PG8_SA(1, 0), a3, voffA);
            PG8_WAIT_V(8); PG8_WAIT_L(0); PG8_BAR; PG8_MMA(1, 0, At, B0); PG8_MMA(1, 1, At, B1); PG8_BAR; PG8_SCHED;
            } else {
            PG8_LDB(B0, 0, 0); PG8_SCHED; PG8_LDA(At, 0, 0); PG8_STAGE(PG8_SA(1, 1), a1 + hstepA, voffA);
            PG8_WAIT_L(8); PG8_BAR; PG8_WAIT_L(0); PG8_MMA(0, 0, At, B0); PG8_BAR; PG8_SCHED;
            PG8_LDB(B1, 0, 1); PG8_STAGE(PG8_SB(0, 0), b2, voffB);
            PG8_BAR; PG8_WAIT_L(0); PG8_MMA(0, 1, At, B1); PG8_BAR;
            PG8_LDA(At, 0, 1); PG8_STAGE(PG8_SA(0, 0), a2, voffA);
            PG8_BAR; PG8_WAIT_L(0); PG8_MMA(1, 0, At, B0); PG8_BAR; PG8_SCHED;
            PG8_STAGE(PG8_SB(0, 1), b2 + hstepB, voffB);
            PG8_WAIT_V(6); PG8_BAR; PG8_MMA(1, 1, At, B1); PG8_BAR;
            PG8_LDB(B0, 1, 0); PG8_SCHED; PG8_LDA(At, 1, 0); PG8_STAGE(PG8_SA(0, 1), a2 + hstepA, voffA);
            PG8_WAIT_L(8); PG8_BAR; PG8_WAIT_L(0); PG8_MMA(0, 0, At, B0); PG8_BAR; PG8_SCHED;
            PG8_LDB(B1, 1, 1); PG8_STAGE(PG8_SB(1, 0), b3, voffB);
            PG8_BAR; PG8_WAIT_L(0); PG8_MMA(0, 1, At, B1); PG8_BAR;
            PG8_LDA(At, 1, 1); PG8_STAGE(PG8_SA(1, 0), a3, voffA);
            PG8_BAR; PG8_WAIT_L(0); PG8_MMA(1, 0, At, B0); PG8_BAR; PG8_SCHED;
            PG8_STAGE(PG8_SB(1, 1), b3 + hstepB, voffB);
            PG8_WAIT_V(6); PG8_BAR; PG8_MMA(1, 1, At, B1); PG8_BAR;
            }
        }
        if constexpr (ALIGN_EPI) { if (wr == 0) PG8_BAR; }
        if constexpr (!Epi::AFTER_DRAIN) { E(acc, cur, wr, wc, fr, fq); S.done(cur); }
        if (!has_next) break;
#pragma unroll
        for (int a = 0; a < 2; ++a)
#pragma unroll
            for (int b = 0; b < 2; ++b)
#pragma unroll
                for (int m = 0; m < 4; ++m)
#pragma unroll
                    for (int n = 0; n < 2; ++n) acc[a][b][m][n] = (f32x4){0.f, 0.f, 0.f, 0.f};
        cur = nxt; cA = nA; cB = nB; ++ui;
        if constexpr (ALIGN_EPI) { if (wr == 1) PG8_BAR; }
    }
    PG8_WAIT_V(0);
    if constexpr (!ALIGN_EPI) { if (wr == 0) PG8_BAR; }
    PG8_BAR;
    if constexpr (Epi::AFTER_DRAIN) { E.fused(acc, cur, wr, wc, fr, fq, lds, wid, lane); S.done(cur); }
#undef PG8_SA
#undef PG8_SB
#undef PG8_STAGE
#undef PG8_LDA
#undef PG8_LDB
#undef PG8_MMA
#undef PG8_WAIT_V
#undef PG8_WAIT_L
#undef PG8_BAR
#undef PG8_SCHED
}
}
using namespace pg8;
#define LAS __attribute__((address_space(3)))
constexpr int DM = 2048, M = 16384, MPR = 8192, MK = M + 512;
constexpr int NMOD = 12288, NIN = 12608, NP2 = 6656, NP2REAL = 6464, NGATE = 6144, NINT = 12800;
constexpr int DFF = 5632, DFF2 = 11264;
constexpr float EPS = 1e-6f;
constexpr size_t O_CKV = 33554432, O_KR = 41943040, O_RF = 42991616, O_RB = 51380224, O_SF = 59768832, O_SB = 60293120, O_END = 60817408;
constexpr size_t MiB = 1u << 20;
constexpr size_t WS_CTL = 0;
constexpr size_t WS_MODS = 1 * MiB, WS_ROPE = 2 * MiB, WS_ABT = 3 * MiB, WS_R1 = 3 * MiB + 524288;
constexpr size_t WS_WIN = 4 * MiB, WS_WGLU = 54 * MiB, WS_WUQ = 56 * MiB, WS_WKV = 59 * MiB, WS_WBR = 61 * MiB, WS_WOUT = 73 * MiB, WS_WUP = 81 * MiB, WS_WDN = 125 * MiB, WS_BTY = 147 * MiB, WS_BTE = 195 * MiB;
constexpr size_t PO = 212 * MiB;
constexpr size_t WS_H = PO, WS_UG = PO + 64 * MiB, WS_Q = PO + 112 * MiB, WS_K = PO + 144 * MiB, WS_V = PO + 176 * MiB, WS_G = PO + 208 * MiB, WS_CQ = PO + 240 * MiB, WS_CKV = PO + 264 * MiB, WS_KR = PO + 281 * MiB;
constexpr size_t WS_ELOC = PO + 284 * MiB, WS_LRET = PO + 316 * MiB, WS_SRET = PO + 444 * MiB, WS_QMLA = PO + 508 * MiB, WS_KVMLA = PO + 556 * MiB;
constexpr size_t WS_YAP = PO + 240 * MiB, WS_Y3 = PO + 284 * MiB, WS_GATES = PO + 380 * MiB;
constexpr int LDY3 = 3072;
constexpr size_t WS_MTMP = PO + 64 * MiB, WS_MERGED = PO + 192 * MiB, WS_MO = PO + 284 * MiB, WS_UF = PO + 64 * MiB, WS_AF = PO + 416 * MiB, WS_DN = PO + 64 * MiB;
constexpr size_t WS_HALO = PO + 200 * MiB;
constexpr size_t WS_G2 = PO + 622 * MiB;
constexpr size_t WS_END = PO + 638 * MiB;
constexpr int CW_BAR = 4096;
constexpr int RING_BYTES = 131072, MISC_OFF = RING_BYTES + 320, XCH_OFF = RING_BYTES + 1024, LDS_BYTES = 147456;

#define XB_TMO      128
#define XB_XCNT(j)  (256  + 64 * (j))
#define XB_XSUB(j)  (1280 + 64 * (j))
#define XB_XGEN(j)  (2304 + 64 * (j))
#define XB_TOP      3328
#define XB_TOPGEN   3392
#define XCD_BAR_WORDS 3456
#define XB_SPIN_CAP (1u << 18)

__device__ __forceinline__ unsigned xb_ld(unsigned* p)              { return __hip_atomic_load(p, __ATOMIC_RELAXED, __HIP_MEMORY_SCOPE_AGENT); }
__device__ __forceinline__ unsigned xb_add(unsigned* p, unsigned v) { return __hip_atomic_fetch_add(p, v, __ATOMIC_RELAXED, __HIP_MEMORY_SCOPE_AGENT); }
__device__ __forceinline__ unsigned xb_xcc_id() { return (unsigned)__builtin_amdgcn_s_getreg((3 << 11) | 20) & 0xFu; }
#define XB_SPIN(cond, bar) do { unsigned _sp = 0; while (cond) { __builtin_amdgcn_s_sleep(1); \
    if ((++_sp & 255u) == 0u) { if (xb_ld(&(bar)[XB_TMO])) break; if (_sp > XB_SPIN_CAP) { atomicAdd(&(bar)[XB_TMO], 1u); break; } } } } while (0)

struct XcdBarrier {
    unsigned* bar; unsigned x;
    volatile LAS unsigned* st;
};

__device__ __forceinline__ XcdBarrier xcd_barrier_post(unsigned* bar, volatile LAS unsigned* st) {
    XcdBarrier b; b.bar = bar; b.x = xb_xcc_id(); b.st = st;
    if (threadIdx.x == 0) (void)xb_add(&bar[XB_XCNT(b.x)], 1u);
    return b;
}
__device__ __forceinline__ void xcd_barrier_complete(unsigned* bar, unsigned x, unsigned& nloc, unsigned& nx) {
    const unsigned G = gridDim.x * gridDim.y * gridDim.z;
    unsigned sum, cnt, mine, sp = 0u;
    for (;;) {
        sum = 0u; cnt = 0u; mine = 0u;
#pragma unroll
        for (unsigned j = 0; j < 16; ++j) { const unsigned c = xb_ld(&bar[XB_XCNT(j)]); sum += c; cnt += (c > 0u) ? 1u : 0u; mine = (j == x) ? c : mine; }
        if (sum == G) break;
        __builtin_amdgcn_s_sleep(1);
        if ((++sp & 255u) == 0u) { if (xb_ld(&bar[XB_TMO])) break; if (sp > XB_SPIN_CAP) { atomicAdd(&bar[XB_TMO], 1u); break; } }
    }
    nloc = mine > 0u ? mine : 1u; nx = cnt > 0u ? cnt : 1u;
}

__device__ __forceinline__ void xcd_barrier(const XcdBarrier& b) {
    asm volatile("s_waitcnt vmcnt(0)" ::: "memory");
    __syncthreads();
    if (threadIdx.x == 0) {
        unsigned* bar = b.bar;
        __builtin_amdgcn_s_waitcnt(0);
        unsigned nloc = b.st[0], nx = b.st[1];
        if (nloc == 0u) { xcd_barrier_complete(bar, b.x, nloc, nx); b.st[0] = nloc; b.st[1] = nx; }
        const unsigned old = xb_add(&bar[XB_XSUB(b.x)], 1u);
        const unsigned gen = old / nloc;
        if (old + 1u == (gen + 1u) * nloc) {
            __builtin_amdgcn_fence(__ATOMIC_RELEASE, "agent");
            asm volatile("s_waitcnt vmcnt(0)" ::: "memory");
            const unsigned og = xb_add(&bar[XB_TOP], 1u);
            const unsigned tg = og / nx;
            if (og + 1u == (tg + 1u) * nx) xb_add(&bar[XB_TOPGEN], 1u);
            else XB_SPIN(xb_ld(&bar[XB_TOPGEN]) == tg, bar);
            __builtin_amdgcn_fence(__ATOMIC_ACQUIRE, "agent");
            xb_add(&bar[XB_XGEN(b.x)], 1u);
            asm volatile("s_waitcnt vmcnt(0)" ::: "memory");
        } else {
            XB_SPIN(xb_ld(&bar[XB_XGEN(b.x)]) == gen, bar);
            __builtin_amdgcn_fence(__ATOMIC_ACQUIRE, "agent");
            asm volatile("s_waitcnt vmcnt(0)" ::: "memory");
        }
    }
    __syncthreads();
}

__device__ __forceinline__ float wave_sum(float v) {
#pragma unroll
    for (int o = 1; o < 64; o <<= 1) v += __shfl_xor(v, o);
    return v;
}
__device__ __forceinline__ void* opaque_uniform(void* p) {
    unsigned lo32 = (unsigned)(uintptr_t)p, hi32 = (unsigned)((uintptr_t)p >> 32); asm volatile("" : "+v"(lo32), "+v"(hi32));
    lo32 = __builtin_amdgcn_readfirstlane(lo32); hi32 = __builtin_amdgcn_readfirstlane(hi32);
    return (void*)(((uintptr_t)hi32 << 32) | (uintptr_t)lo32);
}
struct Ctx {
    unsigned char* lds; unsigned char* ws; float* out; const float* const* in;
    int G, bid;
};
typedef float f32x2 __attribute__((ext_vector_type(2)));

struct TrItem { const float* W; bf16_t* WT; int ldw, K; };
__device__ __forceinline__ void tr_load(const TrItem& t, int lane, f32x4 (&v)[8]) {
    const float* p = t.W + (size_t)(lane >> 3) * t.ldw + (lane & 7) * 4;
#pragma unroll
    for (int i = 0; i < 8; ++i) v[i] = __builtin_nontemporal_load((const f32x4*)(p + (size_t)(8 * i) * t.ldw));
}
__device__ __forceinline__ void tr_store(const TrItem& t, int lane, const f32x4 (&v)[8], float* scr) {
    const int kl = lane >> 3, n4 = (lane & 7) * 4;
#pragma unroll
    for (int i = 0; i < 8; ++i) { float* d = scr + (8 * i + kl) * 33 + n4; d[0] = v[i][0]; d[1] = v[i][1]; d[2] = v[i][2]; d[3] = v[i][3]; }
    asm volatile("s_waitcnt lgkmcnt(0)" ::: "memory");
    const int c = lane & 7;
#pragma unroll
    for (int j = 0; j < 4; ++j) { const int n = (lane >> 3) + 8 * j; const float* s = scr + (8 * c) * 33 + n;
        u32x4 o; o.x = cvt_pk_bf16(s[0 * 33], s[1 * 33]); o.y = cvt_pk_bf16(s[2 * 33], s[3 * 33]); o.z = cvt_pk_bf16(s[4 * 33], s[5 * 33]); o.w = cvt_pk_bf16(s[6 * 33], s[7 * 33]);
        __builtin_nontemporal_store(o, (u32x4*)(t.WT + (size_t)n * t.K + 8 * c)); }
    asm volatile("s_waitcnt lgkmcnt(0)" ::: "memory");
}
constexpr int TI0 = 32 * 202, TI1 = 32 * 192, TI2 = 16 * 32, TI3 = 12 * 48, TI4 = 8 * 32, TI5 = 8 * 32, TI6 = 3 * 16 * 64, TI7 = 32 * 64, TI8 = 32 * 352, TI9 = 88 * 64;
constexpr int TNIT = TI0 + TI1 + TI2 + TI3 + TI4 + TI5 + TI6 + TI7 + TI8 + TI9;
__device__ __forceinline__ TrItem tr_decode(const Ctx& X, int l, int r) {
    const float* W; bf16_t* WT; int ldw, K, kb, sc, dr;
    if (r < TI0) { W = X.in[13] + (size_t)l * 2048 * NIN; WT = (bf16_t*)(X.ws + WS_WIN); ldw = NIN; K = 2048; kb = r / 202; sc = dr = (r % 202) * 32; }
    else if ((r -= TI0) < TI1) { W = X.in[13] + (size_t)l * 2048 * NIN + NP2REAL; WT = (bf16_t*)(X.ws + WS_WIN) + (size_t)NP2 * 2048; ldw = NIN; K = 2048; kb = r / 192; sc = dr = (r % 192) * 32; }
    else if ((r -= TI1) < TI2) { W = X.in[22] + (size_t)l * 1024 * 1024; WT = (bf16_t*)(X.ws + WS_WGLU); ldw = 1024; K = 1024; kb = r / 32; sc = dr = (r % 32) * 32; }
    else if ((r -= TI2) < TI3) { W = X.in[28] + (size_t)l * 768 * 1536; WT = (bf16_t*)(X.ws + WS_WUQ); ldw = 1536; K = 768; kb = r / 48; sc = dr = (r % 48) * 32; }
    else if ((r -= TI3) < TI4) { W = X.in[29] + (size_t)l * 512 * 1024; WT = (bf16_t*)(X.ws + WS_WKV); ldw = 1024; K = 512; kb = r / 32; sc = dr = (r % 32) * 32; }
    else if ((r -= TI4) < TI5) { W = X.in[30] + (size_t)l * 512 * 1024; WT = (bf16_t*)(X.ws + WS_WKV) + (size_t)1024 * 512; ldw = 1024; K = 512; kb = r / 32; sc = dr = (r % 32) * 32; }
    else if ((r -= TI5) < TI6) { const int x = r / 1024, rr = r % 1024; W = X.in[31] + ((size_t)l * 3 + x) * 1024 * 2048; WT = (bf16_t*)(X.ws + WS_WBR) + (size_t)x * 1024; ldw = 2048; K = 3072; kb = rr / 64; sc = dr = (rr % 64) * 32; }
    else if ((r -= TI6) < TI7) { W = X.in[32] + (size_t)l * 2048 * 2048; WT = (bf16_t*)(X.ws + WS_WOUT); ldw = 2048; K = 2048; kb = r / 64; sc = dr = (r % 64) * 32; }
    else if ((r -= TI7) < TI8) { W = X.in[33] + (size_t)l * 2048 * DFF2; WT = (bf16_t*)(X.ws + WS_WUP); ldw = DFF2; K = 2048; kb = r / 352; sc = (r % 352) * 32;
        const int half = sc >= DFF ? 1 : 0, wi = sc - half * DFF; dr = (wi >> 7) * 256 + half * 128 + (wi & 127); }
    else { r -= TI8; W = X.in[36] + (size_t)l * DFF * 2048; WT = (bf16_t*)(X.ws + WS_WDN); ldw = 2048; K = DFF; kb = r / 64; sc = dr = (r % 64) * 32; }
    TrItem t; t.W = W + (size_t)(64 * kb) * ldw + sc; t.WT = WT + (size_t)dr * K + 64 * kb; t.ldw = ldw; t.K = K; return t;
}

__device__ __forceinline__ void phase_pre(const Ctx& X, int l) {
    int tid = threadIdx.x; asm volatile("" : "+v"(tid)); const int lane = tid & 63, wave = __builtin_amdgcn_readfirstlane(tid >> 6);
    float* L = (float*)X.lds;
    const int nmods = (l == 0) ? 384 : 0;
    for (int it = X.bid; it < 128 + nmods; it += X.G) {
      if (it < 128) {
        const int g = it >> 1, hf = it & 1;
        float* Cc = L; float* Bp = L + 2048; float* PW = L + 6144; float* KL = L + 14592;
        const float* lam_re = X.in[14]; const float* lam_im = X.in[15]; const float* log_dt = X.in[16];
        const float* b_re = X.in[17]; const float* b_im = X.in[18]; const float* c_re = X.in[19]; const float* c_im = X.in[20];
        if (tid < 128) {
            const int d = tid >> 6, p = tid & 63;
            const double dt = exp((double)log_dt[(l * 2 + d) * 64 + g]);
            const double lr = (double)lam_re[((l * 2 + d) * 64 + g) * 64 + p], li = (double)lam_im[((l * 2 + d) * 64 + g) * 64 + p];
            const double ar = lr * dt, ai = li * dt, mag = exp(ar);
            const double abr = mag * cos(ai), abi = mag * sin(ai);
            const double nr = abr - 1.0, ni = abi, den = lr * lr + li * li;
            const double cr = (nr * lr + ni * li) / den, ci = (ni * lr - nr * li) / den;
            double zr = 1.0, zi = 0.0;
            for (int n = 0; n <= 32; ++n) { PW[((d * 64 + p) * 33 + n) * 2] = (float)zr; PW[((d * 64 + p) * 33 + n) * 2 + 1] = (float)zi;
                const double t = zr * abr - zi * abi; zi = zr * abi + zi * abr; zr = t; }
            for (int c = 0; c < 16; ++c) { const double br = (double)b_re[((l * 64 + g) * 64 + p) * 16 + c], bi = (double)b_im[((l * 64 + g) * 64 + p) * 16 + c];
                Bp[((d * 64 + p) * 16 + c) * 2] = (float)(cr * br - ci * bi); Bp[((d * 64 + p) * 16 + c) * 2 + 1] = (float)(cr * bi + ci * br); }
        }
        for (int i = tid; i < 1024; i += 512) { Cc[2 * i] = c_re[(size_t)(l * 64 + g) * 1024 + i]; Cc[2 * i + 1] = c_im[(size_t)(l * 64 + g) * 1024 + i]; }
        __syncthreads();
        if (hf == 0 && tid < 128) { const int d = tid >> 6, p = tid & 63; float* abt = (float*)(X.ws + WS_ABT);
            abt[((d * 64 + g) * 64 + p) * 2] = PW[((d * 64 + p) * 33 + 32) * 2]; abt[((d * 64 + g) * 64 + p) * 2 + 1] = PW[((d * 64 + p) * 33 + 32) * 2 + 1]; }
        for (int o = tid; o < 1024; o += 512) { const int d = o >> 9, n = (o >> 4) & 31, c = o & 15; float a[16];
#pragma unroll
            for (int q = 0; q < 16; ++q) a[q] = 0.f;
            for (int p = 0; p < 64; ++p) { const f32x2 C2 = *(const f32x2*)(Cc + (c * 64 + p) * 2), P2 = *(const f32x2*)(PW + ((d * 64 + p) * 33 + n) * 2);
                const float Wr = C2[0] * P2[0] - C2[1] * P2[1], Wi = C2[0] * P2[1] + C2[1] * P2[0];
                const f32x4* bp = (const f32x4*)(Bp + ((d * 64 + p) * 16) * 2);
#pragma unroll
                for (int q = 0; q < 8; ++q) { const f32x4 b = bp[q]; a[2 * q] += Wr * b[0] - Wi * b[1]; a[2 * q + 1] += Wr * b[2] - Wi * b[3]; } }
#pragma unroll
            for (int q = 0; q < 4; ++q) *(f32x4*)(KL + (d * 32 + n) * 256 + c * 16 + 4 * q) = (f32x4){a[4 * q], a[4 * q + 1], a[4 * q + 2], a[4 * q + 3]}; }
        __syncthreads();
        bf16_t* BTY = (bf16_t*)(X.ws + WS_BTY); bf16_t* BTE = (bf16_t*)(X.ws + WS_BTE);
        for (int seg = tid; seg < 256 * 64; seg += 512) { const int nidx = 256 * hf + (seg >> 6), ks = seg & 63, t = nidx >> 4, c = nidx & 15, ta = ks >> 1, cp0 = (ks & 1) * 8; float v[8];
#pragma unroll
            for (int e = 0; e < 8; ++e) { float val = 0.f;
                if (t >= ta) val += KL[((t - ta)) * 256 + c * 16 + cp0 + e];
                if (t <= ta) val += KL[(32 + (ta - t)) * 256 + c * 16 + cp0 + e];
                v[e] = val; }
            u32x4 w; w.x = cvt_pk_bf16(v[0], v[1]); w.y = cvt_pk_bf16(v[2], v[3]); w.z = cvt_pk_bf16(v[4], v[5]); w.w = cvt_pk_bf16(v[6], v[7]);
            *(u32x4*)(BTY + ((size_t)(g * 512 + nidx)) * 768 + ks * 8) = w; }
        for (int seg = tid; seg < 256 * 32; seg += 512) { const int nidx = 256 * hf + (seg >> 5), ks = seg & 31, t = nidx >> 4, c = nidx & 15, d = ks >> 4, p0 = (ks & 15) * 4, ex = d == 0 ? t + 1 : 32 - t; float v[8];
#pragma unroll
            for (int e = 0; e < 4; ++e) { const int p = p0 + e; const float Cr = Cc[(c * 64 + p) * 2], Ci = Cc[(c * 64 + p) * 2 + 1], Pr = PW[((d * 64 + p) * 33 + ex) * 2], Pi = PW[((d * 64 + p) * 33 + ex) * 2 + 1];
                v[2 * e] = Cr * Pr - Ci * Pi; v[2 * e + 1] = -(Cr * Pi + Ci * Pr); }
            u32x4 w; w.x = cvt_pk_bf16(v[0], v[1]); w.y = cvt_pk_bf16(v[2], v[3]); w.z = cvt_pk_bf16(v[4], v[5]); w.w = cvt_pk_bf16(v[6], v[7]);
            *(u32x4*)(BTY + ((size_t)(g * 512 + nidx)) * 768 + 512 + ks * 8) = w; }
        for (int seg = tid; seg < 128 * 64; seg += 512) { const int er = 128 * hf + (seg >> 6), ks = seg & 63, d = er >> 7, p = (er & 127) >> 1, ri = er & 1; float v[8];
#pragma unroll
            for (int e = 0; e < 8; ++e) { const int kidx = ks * 8 + e, ta = kidx >> 4, cp = kidx & 15, ex = d == 0 ? 31 - ta : ta;
                const float Pr = PW[((d * 64 + p) * 33 + ex) * 2], Pi = PW[((d * 64 + p) * 33 + ex) * 2 + 1], Br = Bp[((d * 64 + p) * 16 + cp) * 2], Bi = Bp[((d * 64 + p) * 16 + cp) * 2 + 1];
                v[e] = ri ? (Pr * Bi + Pi * Br) : (Pr * Br - Pi * Bi); }
            u32x4 w; w.x = cvt_pk_bf16(v[0], v[1]); w.y = cvt_pk_bf16(v[2], v[3]); w.z = cvt_pk_bf16(v[4], v[5]); w.w = cvt_pk_bf16(v[6], v[7]);
            *(u32x4*)(BTE + ((size_t)(g * 256 + er)) * 512 + ks * 8) = w; }
        __syncthreads();
      } else {
        const int mi = it - 128, ml = mi / 192, cb = mi - ml * 192;
        float* sv = L; float* part = L + 6144;
        const float* cc = X.in[8]; const float* cctx = X.in[9]; const float* ada_w = X.in[10]; const float* ada_b = X.in[11];
        for (int i = tid; i < 6144; i += 512) { const int cv = i >> 11, k = i & 2047; const float x = cv == 0 ? cctx[k] : cc[(cv - 1) * 2048 + k]; sv[i] = x / (1.f + expf(-x)); }
        __syncthreads();
        const int ks = tid >> 4, c4 = (tid & 15) * 4; f32x4 a0 = (f32x4){0.f, 0.f, 0.f, 0.f}, a1 = a0, a2 = a0;
        const float* wp = ada_w + ((size_t)ml * 2048 + ks * 64) * NMOD + cb * 64 + c4;
#pragma unroll 8
        for (int k = 0; k < 64; ++k) { const f32x4 w = *(const f32x4*)(wp + (size_t)k * NMOD); a0 += w * sv[ks * 64 + k]; a1 += w * sv[2048 + ks * 64 + k]; a2 += w * sv[4096 + ks * 64 + k]; }
        *(f32x4*)(part + (ks * 3 + 0) * 64 + c4) = a0; *(f32x4*)(part + (ks * 3 + 1) * 64 + c4) = a1; *(f32x4*)(part + (ks * 3 + 2) * 64 + c4) = a2;
        __syncthreads();
        if (tid < 192) { const int cv = tid >> 6, c2 = tid & 63; float s2 = ada_b[ml * NMOD + cb * 64 + c2];
            for (int k2 = 0; k2 < 32; ++k2) s2 += part[(k2 * 3 + cv) * 64 + c2];
            ((float*)(X.ws + WS_MODS))[(size_t)(ml * 3 + cv) * NMOD + cb * 64 + c2] = s2; }
        __syncthreads();
      }
    }
    {
        float* scr = (float*)(X.lds + wave * 16384);
        unsigned* ctr = (unsigned*)(X.ws + WS_CTL) + 16 + 64 * l;
        for (;;) {
            unsigned base = 0u; if (lane == 0) base = __hip_atomic_fetch_add(ctr, 8u, __ATOMIC_RELAXED, __HIP_MEMORY_SCOPE_AGENT);
            base = __builtin_amdgcn_readfirstlane(base);
            if (base >= (unsigned)TNIT) break;
            const int i0 = (int)base, i1 = (i0 + 8 < TNIT) ? i0 + 8 : TNIT;
            f32x4 va[8], vb[8]; TrItem ta = tr_decode(X, l, i0), tb = ta; tr_load(ta, lane, va);
            for (int it = i0; it < i1; it += 2) {
                if (it + 1 < i1) { tb = tr_decode(X, l, it + 1); tr_load(tb, lane, vb); }
                tr_store(ta, lane, va, scr);
                if (it + 1 < i1) { if (it + 2 < i1) { ta = tr_decode(X, l, it + 2); tr_load(ta, lane, va); } tr_store(tb, lane, vb, scr); }
            }
        }
        __syncthreads();
    }
    {
        const size_t gt = (size_t)X.bid * 512 + tid, NT = (size_t)X.G * 512;
        bf16_t* WIN = (bf16_t*)(X.ws + WS_WIN);
        for (size_t i = gt; i < (size_t)192 * 2048 / 8; i += NT) *(u32x4*)(WIN + (size_t)NP2REAL * 2048 + i * 8) = (u32x4){0u, 0u, 0u, 0u};
        bf16_t* CKV = (bf16_t*)(X.ws + WS_CKV); bf16_t* KR = (bf16_t*)(X.ws + WS_KR);
        const float* cck = X.in[2]; const float* ckr = X.in[3];
        for (size_t i = gt; i < (size_t)512 * 512; i += NT) { const int rr = (int)(i >> 9), c = (int)(i & 511), b = rr >> 8, t = rr & 255;
            CKV[(size_t)(M + rr) * 512 + c] = f2bf(cck[((size_t)(b * 2 + l) * 256 + t) * 512 + c]); }
        for (size_t i = gt; i < (size_t)512 * 64; i += NT) { const int rr = (int)(i >> 6), c = (int)(i & 63), b = rr >> 8, t = rr & 255;
            KR[(size_t)(M + rr) * 64 + c] = f2bf(ckr[((size_t)(b * 2 + l) * 256 + t) * 64 + c]); }
        if (l == 0) {
            float* rope = (float*)(X.ws + WS_ROPE);
            for (size_t i = gt; i < (size_t)4096 * 32; i += NT) { const int pos = (int)(i >> 5), j = (int)(i & 31);
                const double inv = exp2(-(double)(j & 15) / 16.0 * 13.287712379549449), ang = (double)(j < 16 ? (pos >> 6) : (pos & 63)) * inv;
                rope[i * 2] = (float)cos(ang); rope[i * 2 + 1] = (float)sin(ang); }
        }
    }
}

template <int MODE> __device__ __forceinline__ void phase_norm(const Ctx& X, int l, const bf16_t* src) {
    int tid = threadIdx.x; asm volatile("" : "+v"(tid)); const int lane = tid & 63, wave = __builtin_amdgcn_readfirstlane(tid >> 6); (void)lane; (void)wave;
    const int gw = X.bid * 8 + wave, NGW = X.G * 8;
    const float* ng = X.in[12] + (size_t)l * 4 * DM; bf16_t* H = (bf16_t*)(X.ws + WS_H);
#pragma unroll 2
    for (int r = gw; r < M; r += NGW) {
        const int cv = r < MPR ? 0 : 1 + ((r - MPR) >> 12);
        const float* mb = (const float*)(X.ws + WS_MODS) + (size_t)(l * 3 + cv) * NMOD;
        float* xr = X.out + (size_t)r * DM;
        const float* xs = (l == 0) ? (r < MPR ? X.in[0] + (size_t)r * DM : X.in[1] + (size_t)(r - MPR) * DM) : xr;
        f32x4 v[8];
        if (MODE == 0) {
            float ss = 0.f;
#pragma unroll
            for (int j = 0; j < 8; ++j) { v[j] = *(const f32x4*)(xs + j * 256 + lane * 4); ss += v[j][0] * v[j][0] + v[j][1] * v[j][1] + v[j][2] * v[j][2] + v[j][3] * v[j][3]; }
            const float rs = rsqrtf(wave_sum(ss) * (1.f / DM) + EPS);
#pragma unroll
            for (int j = 0; j < 8; ++j) { const int c = j * 256 + lane * 4; const f32x4 g = *(const f32x4*)(ng + c), sc = *(const f32x4*)(mb + 2048 + c), sh = *(const f32x4*)(mb + c);
                f32x4 h; for (int e = 0; e < 4; ++e) h[e] = v[j][e] * rs * g[e] * (1.f + sc[e]) + sh[e];
                u32x2 w; w.x = cvt_pk_bf16(h[0], h[1]); w.y = cvt_pk_bf16(h[2], h[3]); *(u32x2*)(H + (size_t)r * DM + c) = w; }
        } else {
            const bf16_t* sr = src + (size_t)r * DM; float ss = 0.f;
#pragma unroll
            for (int j = 0; j < 8; ++j) { const u32x2 w = *(const u32x2*)(sr + j * 256 + lane * 4); v[j] = (f32x4){bflo(w.x), bfhi(w.x), bflo(w.y), bfhi(w.y)}; }
            f32x4 xv[8];
#pragma unroll
            for (int j = 0; j < 8; ++j) xv[j] = __builtin_nontemporal_load((const f32x4*)(xs + j * 256 + lane * 4));
#pragma unroll
            for (int j = 0; j < 8; ++j) ss += v[j][0] * v[j][0] + v[j][1] * v[j][1] + v[j][2] * v[j][2] + v[j][3] * v[j][3];
            const float rs = rsqrtf(wave_sum(ss) * (1.f / DM) + EPS);
            const float* ngp = ng + (MODE == 1 ? 1 : 3) * DM; const float* gp = mb + (MODE == 1 ? 2 : 5) * 2048;
            float* R1 = (float*)(X.ws + WS_R1);
            if (MODE == 1) { if (lane == 0) R1[r] = rs; }
            if (MODE == 2) {
                const bf16_t* mr = (const bf16_t*)(X.ws + WS_MO) + (size_t)r * DM; const float r1 = R1[r];
#pragma unroll
                for (int j = 0; j < 8; ++j) { const int c = j * 256 + lane * 4; const u32x2 w = *(const u32x2*)(mr + c); const f32x4 g = *(const f32x4*)(ng + DM + c), gt = *(const f32x4*)(mb + 2 * 2048 + c);
                    xv[j][0] += gt[0] * (bflo(w.x) * r1 * g[0]); xv[j][1] += gt[1] * (bfhi(w.x) * r1 * g[1]); xv[j][2] += gt[2] * (bflo(w.y) * r1 * g[2]); xv[j][3] += gt[3] * (bfhi(w.y) * r1 * g[3]); } }
            float s2 = 0.f;
#pragma unroll
            for (int j = 0; j < 8; ++j) { const int c = j * 256 + lane * 4; const f32x4 g = *(const f32x4*)(ngp + c), gt = *(const f32x4*)(gp + c), x0 = xv[j];
                for (int e = 0; e < 4; ++e) v[j][e] = x0[e] + gt[e] * (v[j][e] * rs * g[e]);
                if (MODE == 2) __builtin_nontemporal_store(v[j], (f32x4*)(xr + c));
                s2 += v[j][0] * v[j][0] + v[j][1] * v[j][1] + v[j][2] * v[j][2] + v[j][3] * v[j][3]; }
            if (MODE == 2 && l == 0) {
                const float r2 = rsqrtf(wave_sum(s2) * (1.f / DM) + EPS); const float* mb1 = mb + 3 * NMOD; const float* ng1 = ng + 4 * DM;
#pragma unroll
                for (int j = 0; j < 8; ++j) { const int c = j * 256 + lane * 4; const f32x4 g = *(const f32x4*)(ng1 + c), sc = *(const f32x4*)(mb1 + 2048 + c), sh = *(const f32x4*)(mb1 + c);
                    f32x4 h; for (int e = 0; e < 4; ++e) h[e] = v[j][e] * r2 * g[e] * (1.f + sc[e]) + sh[e];
                    u32x2 w; w.x = cvt_pk_bf16(h[0], h[1]); w.y = cvt_pk_bf16(h[2], h[3]); *(u32x2*)(H + (size_t)r * DM + c) = w; }
            }
            if (MODE == 1) {
                const float r2 = rsqrtf(wave_sum(s2) * (1.f / DM) + EPS);
#pragma unroll
                for (int j = 0; j < 8; ++j) { const int c = j * 256 + lane * 4; const f32x4 g = *(const f32x4*)(ng + 2 * DM + c), sc = *(const f32x4*)(mb + 4 * 2048 + c), sh = *(const f32x4*)(mb + 3 * 2048 + c);
                    f32x4 h; for (int e = 0; e < 4; ++e) h[e] = v[j][e] * r2 * g[e] * (1.f + sc[e]) + sh[e];
                    u32x2 w; w.x = cvt_pk_bf16(h[0], h[1]); w.y = cvt_pk_bf16(h[2], h[3]); *(u32x2*)(H + (size_t)r * DM + c) = w; }
            }
        }
    }
}

__device__ __forceinline__ void phase_mla_norm(const Ctx& X, int l) {
    int tid = threadIdx.x; asm volatile("" : "+v"(tid)); const int lane = tid & 63, wave = __builtin_amdgcn_readfirstlane(tid >> 6); (void)lane; (void)wave;
    const int gw = X.bid * 8 + wave, NGW = X.G * 8;
    bf16_t* CQ = (bf16_t*)(X.ws + WS_CQ); bf16_t* CKV = (bf16_t*)(X.ws + WS_CKV); bf16_t* KR = (bf16_t*)(X.ws + WS_KR);
    const float* gq = X.in[26] + l * 768; const float* gkv = X.in[27] + l * 512; const float* rope = (const float*)(X.ws + WS_ROPE);
    const bool evenG = (X.G & 1) == 0, lowh = X.bid < X.G / 2; const int RA = evenG ? 5632 : 0;
    const int r_lo = evenG ? (lowh ? 0 : RA) : 0, r_hi = evenG ? (lowh ? RA : M) : M, wi = evenG ? (lowh ? X.bid : X.bid - X.G / 2) * 8 + wave : gw, NW = evenG ? (X.G / 2) * 8 : NGW;
#pragma unroll 2
    for (int r = r_lo + wi; r < r_hi; r += NW) {
        {
            u32x2 w[3]; float ss = 0.f;
#pragma unroll
            for (int j = 0; j < 3; ++j) { w[j] = *(const u32x2*)(CQ + (size_t)r * 768 + (j * 64 + lane) * 4); const float a = bflo(w[j].x), b = bfhi(w[j].x), c = bflo(w[j].y), d = bfhi(w[j].y); ss += a * a + b * b + c * c + d * d; }
            const float rs = rsqrtf(wave_sum(ss) * (1.f / 768.f) + EPS);
#pragma unroll
            for (int j = 0; j < 3; ++j) { const int c0 = (j * 64 + lane) * 4; const f32x4 g = *(const f32x4*)(gq + c0);
                u32x2 o; o.x = cvt_pk_bf16(bflo(w[j].x) * rs * g[0], bfhi(w[j].x) * rs * g[1]); o.y = cvt_pk_bf16(bflo(w[j].y) * rs * g[2], bfhi(w[j].y) * rs * g[3]);
                *(u32x2*)(CQ + (size_t)r * 768 + c0) = o; }
        }
        {
            const u32x4 w = *(const u32x4*)(CKV + (size_t)r * 512 + lane * 8);
            float x[8] = {bflo(w.x), bfhi(w.x), bflo(w.y), bfhi(w.y), bflo(w.z), bfhi(w.z), bflo(w.w), bfhi(w.w)}; float ss = 0.f;
#pragma unroll
            for (int e = 0; e < 8; ++e) ss += x[e] * x[e];
            const float rs = rsqrtf(wave_sum(ss) * (1.f / 512.f) + EPS);
            const f32x4 g0 = *(const f32x4*)(gkv + lane * 8), g1 = *(const f32x4*)(gkv + lane * 8 + 4);
#pragma unroll
            for (int e = 0; e < 4; ++e) { x[e] = x[e] * rs * g0[e]; x[4 + e] = x[4 + e] * rs * g1[e]; }
            u32x4 o; o.x = cvt_pk_bf16(x[0], x[1]); o.y = cvt_pk_bf16(x[2], x[3]); o.z = cvt_pk_bf16(x[4], x[5]); o.w = cvt_pk_bf16(x[6], x[7]);
            *(u32x4*)(CKV + (size_t)r * 512 + lane * 8) = o;
            if (r < MPR) { const int b = r >> 8, t = r & 255; float* op = X.out + O_CKV + ((size_t)(b * 2 + l) * 256 + t) * 512 + lane * 8;
                *(f32x4*)op = (f32x4){x[0], x[1], x[2], x[3]}; *(f32x4*)(op + 4) = (f32x4){x[4], x[5], x[6], x[7]}; }
        }
        {
            const float v = bf2f(KR[(size_t)r * 64 + lane]);
            if (r < MPR) { const int b = r >> 8, t = r & 255; X.out[O_KR + ((size_t)(b * 2 + l) * 256 + t) * 64 + lane] = v; }
            else { const int pos = (r - MPR) & 4095, i = lane >> 1; const float cs = rope[((size_t)pos * 32 + i) * 2], sn = rope[((size_t)pos * 32 + i) * 2 + 1];
                const float pv = __shfl_xor(v, 1); const float o = (lane & 1) ? (pv * sn + v * cs) : (v * cs - pv * sn);
                KR[(size_t)r * 64 + lane] = f2bf(o); }
        }
    }
}

constexpr int RLD = 136;
constexpr float RET_SC = 0.08838834764831845f;
typedef float f32x4v __attribute__((ext_vector_type(4)));
__device__ __forceinline__ void ret_stage_T(const bf16_t* src, int ld, bf16_t* dstT, int mode, float lg, int tid) {
#pragma unroll
    for (int it = 0; it < 4; ++it) { const int seg = tid + it * 512, t = seg >> 4, s = seg & 15;
        const u32x4 w = *(const u32x4*)(src + (size_t)t * ld + s * 8);
        const float sc = mode == 0 ? 1.f : RET_SC * exp2f(lg * (float)(mode == 1 ? 127 - t : t));
        bf16_t* d = dstT + (s * 8) * RLD + t;
        d[0 * RLD] = f2bf(bflo(w.x) * sc); d[1 * RLD] = f2bf(bfhi(w.x) * sc); d[2 * RLD] = f2bf(bflo(w.y) * sc); d[3 * RLD] = f2bf(bfhi(w.y) * sc);
        d[4 * RLD] = f2bf(bflo(w.z) * sc); d[5 * RLD] = f2bf(bfhi(w.z) * sc); d[6 * RLD] = f2bf(bflo(w.w) * sc); d[7 * RLD] = f2bf(bfhi(w.w) * sc); }
}
__device__ __forceinline__ float ret_lg(const Ctx& X, int l, int d, int h) { return -expf(X.in[24][(l * 2 + d) * 8 + h]) * 1.4426950408889634f; }

__device__ __forceinline__ void phase_ret_prefix(const Ctx& X, int l) {
    int tid = threadIdx.x; asm volatile("" : "+v"(tid));
    const bf16_t* LR = (const bf16_t*)(X.ws + WS_LRET); bf16_t* SR = (bf16_t*)(X.ws + WS_SRET);
    constexpr int WS_ = 2 * 8 * 2 * 128 * 32, WP_ = 32 * 8 * 2 * 128 * 32;
    for (int id = X.bid * 512 + tid; id < WS_; id += X.G * 512) {
        const int dk4 = id & 31, dv = (id >> 5) & 127, d = (id >> 12) & 1, h = (id >> 13) & 7, s = id >> 16, c0 = 64 + 32 * s;
        const float g128 = exp2f(ret_lg(X, l, d, h) * 128.f);
        f32x4 S; { const float* s0 = X.in[d ? 5 : 4] + ((size_t)(s * 2 + l) * 8 + h) * 16384;
#pragma unroll
            for (int e = 0; e < 4; ++e) S[e] = s0[(size_t)(dk4 * 4 + e) * 128 + dv]; }
#define PFX_LD(LV, J0) do { _Pragma("unroll") for (int q = 0; q < 8; ++q) { const int ci = c0 + (d ? 31 - ((J0) + q) : (J0) + q); LV[q] = *(const u32x2*)(LR + ((size_t)((ci * 8 + h) * 2 + d) * 128 + dv) * 128 + dk4 * 4); } \
            __builtin_amdgcn_sched_barrier(0); } while (0)
#define PFX_RUN(LV, J0) do { _Pragma("unroll") for (int q = 0; q < 8; ++q) { const int ci = c0 + (d ? 31 - ((J0) + q) : (J0) + q); const size_t o = ((size_t)((ci * 8 + h) * 2 + d) * 128 + dv) * 128 + dk4 * 4; \
                u32x2 w; w.x = cvt_pk_bf16(S[0], S[1]); w.y = cvt_pk_bf16(S[2], S[3]); *(u32x2*)(SR + o) = w; S = S * g128 + (f32x4){bflo(LV[q].x), bfhi(LV[q].x), bflo(LV[q].y), bfhi(LV[q].y)}; } } while (0)
        { u32x2 La[8], Lb[8];
          PFX_LD(La, 0); PFX_LD(Lb, 8); PFX_RUN(La, 0); PFX_LD(La, 16); PFX_RUN(Lb, 8); PFX_LD(Lb, 24); PFX_RUN(La, 16); PFX_RUN(Lb, 24); }
#undef PFX_LD
#undef PFX_RUN
    }
    const bool evenG2 = (X.G & 1) == 0, lowh2 = X.bid < X.G / 2; constexpr int PA = WP_ / 32 * 9;
    const int p_lo = evenG2 ? (lowh2 ? 0 : PA) : 0, p_hi = evenG2 ? (lowh2 ? PA : WP_) : WP_, pt = evenG2 ? (lowh2 ? X.bid : X.bid - X.G / 2) * 512 + tid : X.bid * 512 + tid, PS = evenG2 ? (X.G / 2) * 512 : X.G * 512;
    for (int id = p_lo + pt; id < p_hi; id += PS) {
        const int dk4 = id & 31, dv = (id >> 5) & 127, d = (id >> 12) & 1, h = (id >> 13) & 7, s = id >> 16;
        const float g128 = exp2f(ret_lg(X, l, d, h) * 128.f);
        const int cA = 2 * s + (d ? 1 : 0), cB = 2 * s + (d ? 0 : 1);
        const size_t oA = ((size_t)((cA * 8 + h) * 2 + d) * 128 + dv) * 128 + dk4 * 4, oB = ((size_t)((cB * 8 + h) * 2 + d) * 128 + dv) * 128 + dk4 * 4;
        const u32x2 wA = *(const u32x2*)(LR + oA), wB = *(const u32x2*)(LR + oB);
        const f32x4 LA = (f32x4){bflo(wA.x), bfhi(wA.x), bflo(wA.y), bfhi(wA.y)}, LB = (f32x4){bflo(wB.x), bfhi(wB.x), bflo(wB.y), bfhi(wB.y)};
        *(u32x2*)(SR + oA) = (u32x2){0u, 0u};
        *(u32x2*)(SR + oB) = wA;
        const f32x4 S = LA * g128 + LB;
        float* op = X.out + (d ? O_RB : O_RF) + ((size_t)(s * 2 + l) * 8 + h) * 16384;
#pragma unroll
        for (int e = 0; e < 4; ++e) op[(size_t)(dk4 * 4 + e) * 128 + dv] = S[e];
    }
}
__device__ __forceinline__ bf16x8 scale_frag(bf16x8 q, float s) {
    const u32x4 w = __builtin_bit_cast(u32x4, q); u32x4 o;
    o.x = cvt_pk_bf16(bflo(w.x) * s, bfhi(w.x) * s); o.y = cvt_pk_bf16(bflo(w.y) * s, bfhi(w.y) * s); o.z = cvt_pk_bf16(bflo(w.z) * s, bfhi(w.z) * s); o.w = cvt_pk_bf16(bflo(w.w) * s, bfhi(w.w) * s);
    return __builtin_bit_cast(bf16x8, o);
}
__device__ __forceinline__ void phase_s5_carry(const Ctx& X, int l) {
    int tid = threadIdx.x; asm volatile("" : "+v"(tid)); const int lane = tid & 63, wave = __builtin_amdgcn_readfirstlane(tid >> 6);
    const int gw = wave * X.G + X.bid, NGW = X.G * 8, p = lane;
    const float* EL = (const float*)(X.ws + WS_ELOC); bf16_t* UG = (bf16_t*)(X.ws + WS_UG); const float* abt = (const float*)(X.ws + WS_ABT);
    for (int it = gw; it < 34 * 128; it += NGW) {
        const int d = it & 1, g = (it >> 1) & 63, sq = it >> 7;
        const bool smp = sq < 2; const int s = smp ? sq : sq - 2, nc = smp ? 128 : 8, c0 = smp ? 256 + 128 * s : 8 * s;
        const float ar = abt[((d * 64 + g) * 64 + p) * 2], ai = abt[((d * 64 + g) * 64 + p) * 2 + 1];
        float sr = 0.f, si = 0.f;
        if (smp) { const float* s0 = X.in[d ? 7 : 6] + (((size_t)(s * 2 + l) * 64 + g) * 64 + p) * 2; sr = s0[0]; si = s0[1]; }
#define CARRY_LD(EV, J0, NB) do { _Pragma("unroll") for (int q = 0; q < (NB); ++q) { const int ch = c0 + (d ? nc - 1 - ((J0) + q) : (J0) + q); EV[q] = *(const f32x2*)(EL + (size_t)(g * 512 + ch) * 256 + d * 128 + 2 * p); } \
            __builtin_amdgcn_sched_barrier(0); } while (0)
#define CARRY_RUN(EV, J0, NB) do { _Pragma("unroll") for (int q = 0; q < (NB); ++q) { const int ch = c0 + (d ? nc - 1 - ((J0) + q) : (J0) + q); \
                *(unsigned*)(UG + (size_t)(g * 512 + ch) * 768 + 512 + d * 128 + 2 * p) = cvt_pk_bf16(sr, si); \
                const float tr = ar * sr - ai * si + EV[q][0]; si = ar * si + ai * sr + EV[q][1]; sr = tr; } } while (0)
        if (smp) {
            f32x2 ea[16], eb[16];
            CARRY_LD(ea, 0, 16);
            for (int jb = 0; jb < 128; jb += 32) {
                CARRY_LD(eb, jb + 16, 16); CARRY_RUN(ea, jb, 16);
                if (jb + 32 < 128) CARRY_LD(ea, jb + 32, 16);
                CARRY_RUN(eb, jb + 16, 16); }
        } else { f32x2 ev[8]; CARRY_LD(ev, 0, 8); CARRY_RUN(ev, 0, 8); }
#undef CARRY_LD
#undef CARRY_RUN
        if (!smp) { float* op = X.out + (d ? O_SB : O_SF) + (((size_t)(s * 2 + l) * 64 + g) * 64 + p) * 2; op[0] = sr; op[1] = si; }
    }
}

__device__ __forceinline__ void phase_convfix(const Ctx& X, int l) {
    int tid = threadIdx.x; asm volatile("" : "+v"(tid));
    const float* HALO = (const float*)(X.ws + WS_HALO); bf16_t* AF = (bf16_t*)(X.ws + WS_AF);
    const float* cw = X.in[34] + (size_t)l * 3 * DFF2; const float* cb = X.in[35] + (size_t)l * DFF2;
    for (int idx = X.bid * 512 + tid; idx < 32 * 2 * 1408; idx += X.G * 512) {
        const int cq = idx % 1408, wrw = (idx / 1408) & 1, pm = 32 + idx / 2816, ts = pm & 15, ch = cq * 4;
        if ((wrw == 0 && ts == 0) || (wrw == 1 && ts == 15)) continue;
        const int hc = (ch >> 7) * 256 + (ch & 127);
        const float* pu = HALO + (size_t)(wrw == 0 ? (pm - 1) * 4 + 3 : pm * 4 + 2) * DFF2 + hc;
        const float* pc = HALO + (size_t)(wrw == 0 ? pm * 4 + 0 : pm * 4 + 3) * DFF2 + hc;
        const float* pd = HALO + (size_t)(wrw == 0 ? pm * 4 + 1 : (pm + 1) * 4 + 0) * DFF2 + hc;
        f32x4 res[2];
#pragma unroll
        for (int part = 0; part < 2; ++part) { const int cc = ch + part * DFF;
            const f32x4 a = *(const f32x4*)(pu + part * 128), b = *(const f32x4*)(pc + part * 128), c = *(const f32x4*)(pd + part * 128);
            const f32x4 w0 = *(const f32x4*)(cw + cc), w1 = *(const f32x4*)(cw + DFF2 + cc), w2 = *(const f32x4*)(cw + 2 * DFF2 + cc), bb = *(const f32x4*)(cb + cc);
            res[part] = w0 * a + w1 * b + w2 * c + bb; }
        const int r = pm * 256 + (wrw ? 255 : 0);
        u32x2 w; w.x = cvt_pk_bf16(res[1][0] * sigm(res[1][0]) * res[0][0], res[1][1] * sigm(res[1][1]) * res[0][1]); w.y = cvt_pk_bf16(res[1][2] * sigm(res[1][2]) * res[0][2], res[1][3] * sigm(res[1][3]) * res[0][3]);
        *(u32x2*)(AF + (size_t)r * DFF + ch) = w;
    }
}

namespace att {
using s16x4  = __attribute__((ext_vector_type(4))) short;
using f32x16 = __attribute__((ext_vector_type(16))) float;
constexpr float SCALE = 0.07216878364870322f, THR = 8.f;
constexpr int K_BYTES = 64 * 400, V_BYTES = 64 * 256;
#define KSW(row, colB) ((row) * 400 + (colB))
#define SBAR() __builtin_amdgcn_sched_barrier(0)
__device__ __forceinline__ int crow(int r, int hi) { return (r & 3) + 8 * (r >> 2) + 4 * hi; }
__device__ __forceinline__ void partialSM(f32x16& p0, f32x16& p1, float& m_reg, float& mn, float& alpha) {
  constexpr float C = SCALE * 1.4426950408889634f;
  float pmax = p0[0];
#pragma unroll
  for (int r = 1; r < 16; ++r) pmax = fmaxf(pmax, p0[r]);
#pragma unroll
  for (int r = 0; r < 16; ++r) pmax = fmaxf(pmax, p1[r]);
  { auto rr = __builtin_amdgcn_permlane32_swap(__float_as_uint(pmax), __float_as_uint(pmax), false, false);
    pmax = fmaxf(__uint_as_float(rr[0]), __uint_as_float(rr[1])); }
  if (__builtin_expect(__all(pmax - m_reg <= THR / SCALE), 1)) { mn = m_reg; alpha = 1.f; }
  else { mn = fmaxf(m_reg, pmax); alpha = __builtin_amdgcn_exp2f((m_reg - mn) * C); m_reg = mn; }
  const float mnC = -mn * C;
#pragma unroll
  for (int r = 0; r < 16; ++r) p0[r] = __builtin_amdgcn_exp2f(fmaf(p0[r], C, mnC));
#pragma unroll
  for (int r = 0; r < 16; ++r) p1[r] = __builtin_amdgcn_exp2f(fmaf(p1[r], C, mnC));
}
__device__ __forceinline__ void sm_max(const f32x16& p0, const f32x16& p1, float& m_reg, float& mnC, float& alpha) {
  constexpr float C = SCALE * 1.4426950408889634f;
  float pmax = p0[0];
#pragma unroll
  for (int r = 1; r < 16; ++r) pmax = fmaxf(pmax, p0[r]);
#pragma unroll
  for (int r = 0; r < 16; ++r) pmax = fmaxf(pmax, p1[r]);
  { auto rr = __builtin_amdgcn_permlane32_swap(__float_as_uint(pmax), __float_as_uint(pmax), false, false);
    pmax = fmaxf(__uint_as_float(rr[0]), __uint_as_float(rr[1])); }
  float mn;
  if (__builtin_expect(__all(pmax - m_reg <= THR / SCALE), 1)) { mn = m_reg; alpha = 1.f; }
  else { mn = fmaxf(m_reg, pmax); alpha = __builtin_amdgcn_exp2f((m_reg - mn) * C); m_reg = mn; }
  mnC = -mn * C;
}
template <int BASE> __device__ __forceinline__ void sm_exp8(f32x16& p, float mnC) {
  constexpr float C = SCALE * 1.4426950408889634f;
#pragma unroll
  for (int r = BASE; r < BASE + 8; ++r) p[r] = __builtin_amdgcn_exp2f(fmaf(p[r], C, mnC));
#pragma unroll
  for (int r = BASE; r < BASE + 8; ++r) { float t = p[r]; asm volatile("" : "+v"(t)); p[r] = t; }
}
__device__ __forceinline__ void finishSM(f32x16& p0, f32x16& p1, float alpha, float& l_reg, bf16x8& pa0, bf16x8& pa1, bf16x8& pa2, bf16x8& pa3) {
  float ps = 0;
#pragma unroll
  for (int r = 0; r < 16; ++r) ps += p0[r];
#pragma unroll
  for (int r = 0; r < 16; ++r) ps += p1[r];
  { auto rr = __builtin_amdgcn_permlane32_swap(__float_as_uint(ps), __float_as_uint(ps), false, false);
    ps = __uint_as_float(rr[0]) + __uint_as_float(rr[1]); }
  l_reg = l_reg * alpha + ps;
#define PK4(P, BASE, OUT) do { unsigned a0 = cvt_pk_bf16(P[BASE + 0], P[BASE + 1]), a1 = cvt_pk_bf16(P[BASE + 2], P[BASE + 3]);   \
    unsigned b0 = cvt_pk_bf16(P[BASE + 4], P[BASE + 5]), b1 = cvt_pk_bf16(P[BASE + 6], P[BASE + 7]);                              \
    auto r0 = __builtin_amdgcn_permlane32_swap(a0, b0, false, false); auto r1 = __builtin_amdgcn_permlane32_swap(a1, b1, false, false); \
    u32x4 w = {r0[0], r1[0], r0[1], r1[1]}; OUT = __builtin_bit_cast(bf16x8, w); } while (0)
  PK4(p0, 0, pa0); PK4(p0, 8, pa1); PK4(p1, 0, pa2); PK4(p1, 8, pa3);
#undef PK4
}
__device__ __forceinline__ int v_st(int k, int c) { const int kk = (k & ~0xC) | ((k & 4) << 1) | ((k & 8) >> 1); return ((kk >> 3) * 4 + (c >> 5)) * 512 + ((kk & 7) * 32 + (c & 31)) * 2; }
__device__ __forceinline__ int v_rd_base(int lane) { return ((lane & 3) << 3) | (((lane >> 2) & 3) << 6) | (((lane >> 4) & 1) << 5) | (((lane >> 5) & 1) << 8); }
constexpr int v_rd_off(int d0, int ks, int half) { return d0 * 512 + ks * 4096 + half * 2048; }
template <int OFF> __device__ __forceinline__ s16x4 tr_read(int vb) {
  s16x4 r; asm volatile("ds_read_b64_tr_b16 %0, %1 offset:%2" : "=&v"(r) : "v"(vb), "i"(OFF) : "memory"); return r;
}
template <int D0> __device__ __forceinline__ void pv_one(f32x16& od, int vb, bf16x8 pa0, bf16x8 pa1, bf16x8 pa2, bf16x8 pa3) {
  const s16x4 l0 = tr_read<v_rd_off(D0, 0, 0)>(vb), h0 = tr_read<v_rd_off(D0, 0, 1)>(vb), l1 = tr_read<v_rd_off(D0, 1, 0)>(vb), h1 = tr_read<v_rd_off(D0, 1, 1)>(vb);
  const s16x4 l2 = tr_read<v_rd_off(D0, 2, 0)>(vb), h2 = tr_read<v_rd_off(D0, 2, 1)>(vb), l3 = tr_read<v_rd_off(D0, 3, 0)>(vb), h3 = tr_read<v_rd_off(D0, 3, 1)>(vb);
  asm volatile("s_waitcnt lgkmcnt(0)" ::: "memory"); SBAR();
#define PK(L, H) (bf16x8){L[0], L[1], L[2], L[3], H[0], H[1], H[2], H[3]}
  od = __builtin_amdgcn_mfma_f32_32x32x16_bf16(pa0, PK(l0, h0), od, 0, 0, 0);
  od = __builtin_amdgcn_mfma_f32_32x32x16_bf16(pa1, PK(l1, h1), od, 0, 0, 0);
  od = __builtin_amdgcn_mfma_f32_32x32x16_bf16(pa2, PK(l2, h2), od, 0, 0, 0);
  od = __builtin_amdgcn_mfma_f32_32x32x16_bf16(pa3, PK(l3, h3), od, 0, 0, 0);
#undef PK
}
__device__ __forceinline__ void attn_unit(const Ctx& X, bool smp, int b, int h, int qb) {
  const bf16_t* QM = (const bf16_t*)(X.ws + WS_QMLA); const bf16_t* KV = (const bf16_t*)(X.ws + WS_KVMLA); const bf16_t* KR = (const bf16_t*)(X.ws + WS_KR);
  bf16_t* YC = (bf16_t*)(X.ws + WS_Y3) + 2048; const float* rope = (const float*)(X.ws + WS_ROPE);
  int tid = threadIdx.x; asm volatile("" : "+v"(tid)); const int lane = tid & 63, wave = __builtin_amdgcn_readfirstlane(tid >> 6); (void)lane; (void)wave;
  const int wid = wave, r32 = lane & 31, hi = lane >> 5;
  constexpr int BUF = K_BYTES + V_BYTES;
  char* K_lds = (char*)X.lds; char* V_lds = (char*)X.lds + K_BYTES;
  float* wsl = (float*)(X.lds + 3 * BUF) + wid * 64; float* li_l = wsl; float* al_l = wsl + 32;
  const int row0 = smp ? MPR + b * 4096 + qb * 256 : b * 256, NT = smp ? 68 : 4;
  float m_reg = -1e30f, l_reg = 0.f; f32x16 o[4] = {}; bf16x8 qr[12];
  const int vb0 = (int)(uintptr_t)V_lds + v_rd_base(lane);
  int rel[6]; bool isr[4];
#pragma unroll
  for (int i = 0; i < 4; ++i) { const int off = (wid + 8 * i) * 1024 + lane * 16, row = off / 400, colB = off - row * 400;
    isr[i] = colB >= 256; rel[i] = isr[i] ? row * 64 + ((colB - 256) >> 1) : row * 2048 + h * 128 + (colB >> 1); }
#pragma unroll
  for (int i = 4; i < 6; ++i) { const int off = (wid + 8 * (i - 4)) * 1024 + lane * 16, st = off >> 9, rem = off & 511, kk = (st >> 2) * 8 + (rem >> 6), cc = (st & 3) * 32 + ((rem & 63) >> 1);
    const int k = (kk & ~0xC) | ((kk & 4) << 1) | ((kk & 8) >> 1); rel[i] = k * 2048 + 1024 + h * 128 + cc; }
#define ATT_DMA(KT, B) do { const int kt_ = (KT); const int kv0 = smp ? (kt_ < 64 ? MPR + b * 4096 + 64 * kt_ : M + b * 256 + 64 * (kt_ - 64)) : b * 256 + 64 * kt_; \
    const bf16_t* kvb = KV + (size_t)kv0 * 2048; const bf16_t* krb = KR + (size_t)kv0 * 64; \
    _Pragma("unroll") for (int i = 0; i < 3; ++i) __builtin_amdgcn_global_load_lds((const unsigned*)(isr[i] ? krb + rel[i] : kvb + rel[i]), (LAS unsigned*)(K_lds + (B) * BUF + (wid + 8 * i) * 1024), 16, 0, 0); \
    if (wid == 0) __builtin_amdgcn_global_load_lds((const unsigned*)(isr[3] ? krb + rel[3] : kvb + rel[3]), (LAS unsigned*)(K_lds + (B) * BUF + 24 * 1024), 16, 0, 0); \
    _Pragma("unroll") for (int i = 4; i < 6; ++i) __builtin_amdgcn_global_load_lds((const unsigned*)(kvb + rel[i]), (LAS unsigned*)(V_lds + (B) * BUF + (wid + 8 * (i - 4)) * 1024), 16, 0, 0); } while (0)
#define ATT_SYNC() do { asm volatile("s_waitcnt vmcnt(0)" ::: "memory"); __syncthreads(); } while (0)
  f32x16 pA0, pA1, pB0, pB1; float alA = 1.f, alB = 1.f, mnx;
#define ATT_QK(BI, P0, P1) do { const char* Kc = K_lds + (BI) * BUF; P0 = f32x16{}; P1 = f32x16{}; \
    _Pragma("unroll") for (int d0 = 0; d0 < 12; ++d0) { const int cb = (d0 * 16 + hi * 8) * 2; \
      const bf16x8 b0 = *(const bf16x8*)(Kc + KSW(r32, cb)), b1 = *(const bf16x8*)(Kc + KSW(32 + r32, cb)); \
      P0 = __builtin_amdgcn_mfma_f32_32x32x16_bf16(b0, qr[d0], P0, 0, 0, 0); P1 = __builtin_amdgcn_mfma_f32_32x32x16_bf16(b1, qr[d0], P1, 0, 0, 0); } } while (0)
#define ATT_PV(BI) do { const int vbc = vb0 + (BI) * BUF; \
    pv_one<0>(o[0], vbc, pa0, pa1, pa2, pa3); pv_one<1>(o[1], vbc, pa0, pa1, pa2, pa3); pv_one<2>(o[2], vbc, pa0, pa1, pa2, pa3); pv_one<3>(o[3], vbc, pa0, pa1, pa2, pa3); } while (0)
#define ATT_PVX(BI, P0, P1, AL) do { const int vbc = vb0 + (BI) * BUF; float mnC_; sm_max(P0, P1, m_reg, mnC_, AL); \
    pv_one<0>(o[0], vbc, pa0, pa1, pa2, pa3); sm_exp8<0>(P0, mnC_); pv_one<1>(o[1], vbc, pa0, pa1, pa2, pa3); sm_exp8<8>(P0, mnC_); \
    pv_one<2>(o[2], vbc, pa0, pa1, pa2, pa3); sm_exp8<0>(P1, mnC_); pv_one<3>(o[3], vbc, pa0, pa1, pa2, pa3); sm_exp8<8>(P1, mnC_); } while (0)
#define ATT_RESC(AL) do { if (__any((AL) < 1.f)) { if (hi == 0) al_l[r32] = (AL); asm volatile("s_waitcnt lgkmcnt(0)" ::: "memory"); \
      _Pragma("unroll") for (int d = 0; d < 4; ++d) _Pragma("unroll") for (int r = 0; r < 16; ++r) o[d][r] *= al_l[crow(r, hi)]; } } while (0)
#define ATT_STAGE(KT) do { if ((KT) + 1 < NT) ATT_DMA((KT) + 1, bnext); } while (0)
#define ATT_ROT() do { const int t_ = bprev; bprev = bcur; bcur = bnext; bnext = t_; } while (0)
  bf16x8 pa0, pa1, pa2, pa3;
  ATT_DMA(0, 0);
  {
    const int qrow = row0 + wid * 32 + r32; const bf16_t* Qw = QM + (size_t)qrow * 1536 + h * 192 + hi * 8;
#pragma unroll
    for (int d0 = 0; d0 < 12; ++d0) qr[d0] = *(const bf16x8*)(Qw + d0 * 16);
    if (smp) { const int pos = qb * 256 + wid * 32 + r32;
#pragma unroll
      for (int d0 = 8; d0 < 12; ++d0) { const int i0 = 8 * (d0 - 8) + 4 * hi; const float* rp = rope + ((size_t)pos * 32 + i0) * 2;
        const f32x4 c01 = *(const f32x4*)rp, c23 = *(const f32x4*)(rp + 4);
        const u32x4 w = __builtin_bit_cast(u32x4, qr[d0]); u32x4 ow;
        { const float x1 = bflo(w.x), x2 = bfhi(w.x); ow.x = cvt_pk_bf16(x1 * c01[0] - x2 * c01[1], x1 * c01[1] + x2 * c01[0]); }
        { const float x1 = bflo(w.y), x2 = bfhi(w.y); ow.y = cvt_pk_bf16(x1 * c01[2] - x2 * c01[3], x1 * c01[3] + x2 * c01[2]); }
        { const float x1 = bflo(w.z), x2 = bfhi(w.z); ow.z = cvt_pk_bf16(x1 * c23[0] - x2 * c23[1], x1 * c23[1] + x2 * c23[0]); }
        { const float x1 = bflo(w.w), x2 = bfhi(w.w); ow.w = cvt_pk_bf16(x1 * c23[2] - x2 * c23[3], x1 * c23[3] + x2 * c23[2]); }
        qr[d0] = __builtin_bit_cast(bf16x8, ow); } }
  }
  ATT_SYNC();
  int bprev = 2, bcur = 0, bnext = 1;
  ATT_STAGE(0); SBAR(); ATT_QK(bcur, pA0, pA1); partialSM(pA0, pA1, m_reg, mnx, alA); ATT_RESC(alA); ATT_SYNC(); ATT_ROT();
#pragma unroll 1
  for (int kt = 1; kt + 1 < NT; kt += 2) {
    ATT_STAGE(kt); SBAR(); ATT_QK(bcur, pB0, pB1); finishSM(pA0, pA1, alA, l_reg, pa0, pa1, pa2, pa3); SBAR();
    ATT_PVX(bprev, pB0, pB1, alB); ATT_RESC(alB); ATT_SYNC(); ATT_ROT();
    ATT_STAGE(kt + 1); SBAR(); ATT_QK(bcur, pA0, pA1); finishSM(pB0, pB1, alB, l_reg, pa0, pa1, pa2, pa3); SBAR();
    ATT_PVX(bprev, pA0, pA1, alA); ATT_RESC(alA); ATT_SYNC(); ATT_ROT();
  }
  ATT_STAGE(NT - 1); SBAR(); ATT_QK(bcur, pB0, pB1); finishSM(pA0, pA1, alA, l_reg, pa0, pa1, pa2, pa3); SBAR();
  ATT_PVX(bprev, pB0, pB1, alB); ATT_RESC(alB); ATT_SYNC(); ATT_ROT();
  finishSM(pB0, pB1, alB, l_reg, pa0, pa1, pa2, pa3); ATT_PV(bprev);
#undef ATT_QK
#undef ATT_PV
#undef ATT_PVX
#undef ATT_RESC
#undef ATT_STAGE
#undef ATT_ROT
#undef ATT_DMA
#undef ATT_SYNC
  if (hi == 0) li_l[r32] = l_reg; asm volatile("s_waitcnt lgkmcnt(0)" ::: "memory");
  bf16_t* Ow = YC + (size_t)(row0 + wid * 32) * LDY3 + h * 128;
#pragma unroll
  for (int r = 0; r < 16; ++r) { const int orow = crow(r, hi); const float rl = __builtin_amdgcn_rcpf(li_l[orow]);
#pragma unroll
    for (int d0 = 0; d0 < 4; ++d0) Ow[(size_t)orow * LDY3 + d0 * 32 + r32] = f2bf(o[d0][r] * rl); }
  __syncthreads();
}
__device__ __forceinline__ void phase_attn(const Ctx& X) {
  for (int u = X.bid; u < 512; u += X.G) {
    if (u < 256) { const int pr = (X.G == 256) ? (u & 7) * 2 + (u >> 7) : u >> 4, qb = (X.G == 256) ? (u >> 3) & 15 : u & 15;
      attn_unit(X, true, pr >> 3, pr & 7, qb); }
    else { const int v = u - 256; attn_unit(X, false, v >> 3, v & 7, 0); }
  }
}
}

namespace ret {
using att::s16x4; using att::f32x16; using att::tr_read; using att::v_st; using att::v_rd_base; using att::v_rd_off; using att::crow;
#define KS256(row, colB) ((row) * 256 + ((colB) ^ (((row) & 7) << 4)))
#define RPK(L, H) (bf16x8){L[0], L[1], L[2], L[3], H[0], H[1], H[2], H[3]}
__device__ __forceinline__ void phase_ret_pass1(const Ctx& X, int l) {
    int tid = threadIdx.x; asm volatile("" : "+v"(tid)); const int lane = tid & 63, w = __builtin_amdgcn_readfirstlane(tid >> 6), r32 = lane & 31, hi = lane >> 5;
    char* VL = (char*)X.lds; char* KF = VL + 32768; char* KB = VL + 65536;
    const bf16_t* Kb = (const bf16_t*)(X.ws + WS_K); const bf16_t* Vb = (const bf16_t*)(X.ws + WS_V); bf16_t* LR = (bf16_t*)(X.ws + WS_LRET);
    const int dvb = w & 3, dk0 = 2 * (w >> 2);
    const int va = (int)(uintptr_t)VL + v_rd_base(lane) + dvb * 512, kfa = (int)(uintptr_t)KF + v_rd_base(lane) + dk0 * 512, kba = (int)(uintptr_t)KB + v_rd_base(lane) + dk0 * 512;
    for (int u = X.bid; u < 1024; u += X.G) {
        const int ci = u >> 3, h = u & 7, r0 = ci * 128;
        const float lgf = ret_lg(X, l, 0, h), lgb = ret_lg(X, l, 1, h);
#pragma unroll
        for (int it = 0; it < 4; ++it) { const int seg = tid + it * 512, t = seg >> 4, sg = seg & 15, off = (t >> 6) * 16384 + v_st(t & 63, sg * 8);
            const u32x4 vv = *(const u32x4*)(Vb + (size_t)(r0 + t) * 1024 + h * 128 + sg * 8), kk = *(const u32x4*)(Kb + (size_t)(r0 + t) * 1024 + h * 128 + sg * 8);
            *(u32x4*)(VL + off) = vv;
            const float sf = RET_SC * __builtin_amdgcn_exp2f(lgf * (float)(127 - t)), sb = RET_SC * __builtin_amdgcn_exp2f(lgb * (float)t);
            u32x4 a, b; a.x = cvt_pk_bf16(bflo(kk.x) * sf, bfhi(kk.x) * sf); a.y = cvt_pk_bf16(bflo(kk.y) * sf, bfhi(kk.y) * sf); a.z = cvt_pk_bf16(bflo(kk.z) * sf, bfhi(kk.z) * sf); a.w = cvt_pk_bf16(bflo(kk.w) * sf, bfhi(kk.w) * sf);
            b.x = cvt_pk_bf16(bflo(kk.x) * sb, bfhi(kk.x) * sb); b.y = cvt_pk_bf16(bflo(kk.y) * sb, bfhi(kk.y) * sb); b.z = cvt_pk_bf16(bflo(kk.z) * sb, bfhi(kk.z) * sb); b.w = cvt_pk_bf16(bflo(kk.w) * sb, bfhi(kk.w) * sb);
            *(u32x4*)(KF + off) = a; *(u32x4*)(KB + off) = b; }
        __syncthreads();
        f32x16 acc[2][2] = {};
#define RP1_STEP(T, KS) do { \
            const s16x4 al = tr_read<(T) * 16384 + v_rd_off(0, KS, 0)>(va), ah = tr_read<(T) * 16384 + v_rd_off(0, KS, 1)>(va); \
            const s16x4 f0l = tr_read<(T) * 16384 + v_rd_off(0, KS, 0)>(kfa), f0h = tr_read<(T) * 16384 + v_rd_off(0, KS, 1)>(kfa), f1l = tr_read<(T) * 16384 + v_rd_off(1, KS, 0)>(kfa), f1h = tr_read<(T) * 16384 + v_rd_off(1, KS, 1)>(kfa); \
            const s16x4 b0l = tr_read<(T) * 16384 + v_rd_off(0, KS, 0)>(kba), b0h = tr_read<(T) * 16384 + v_rd_off(0, KS, 1)>(kba), b1l = tr_read<(T) * 16384 + v_rd_off(1, KS, 0)>(kba), b1h = tr_read<(T) * 16384 + v_rd_off(1, KS, 1)>(kba); \
            asm volatile("s_waitcnt lgkmcnt(0)" ::: "memory"); __builtin_amdgcn_sched_barrier(0); \
            const bf16x8 A = RPK(al, ah); \
            acc[0][0] = __builtin_amdgcn_mfma_f32_32x32x16_bf16(A, RPK(f0l, f0h), acc[0][0], 0, 0, 0); acc[0][1] = __builtin_amdgcn_mfma_f32_32x32x16_bf16(A, RPK(f1l, f1h), acc[0][1], 0, 0, 0); \
            acc[1][0] = __builtin_amdgcn_mfma_f32_32x32x16_bf16(A, RPK(b0l, b0h), acc[1][0], 0, 0, 0); acc[1][1] = __builtin_amdgcn_mfma_f32_32x32x16_bf16(A, RPK(b1l, b1h), acc[1][1], 0, 0, 0); } while (0)
        RP1_STEP(0, 0); RP1_STEP(0, 1); RP1_STEP(0, 2); RP1_STEP(0, 3); RP1_STEP(1, 0); RP1_STEP(1, 1); RP1_STEP(1, 2); RP1_STEP(1, 3);
#undef RP1_STEP
#pragma unroll
        for (int dir = 0; dir < 2; ++dir)
#pragma unroll
            for (int q = 0; q < 2; ++q) { bf16_t* o = LR + ((size_t)(u * 2 + dir) * 128 + 32 * dvb) * 128 + 32 * (dk0 + q) + r32;
#pragma unroll
                for (int r = 0; r < 16; ++r) o[(size_t)crow(r, hi) * 128] = f2bf(acc[dir][q][r]); }
        __syncthreads();
    }
}
template <int D0> __device__ __forceinline__ void pv128(f32x16& od, int vb, const bf16x8 (&pa)[8]) {
    att::pv_one<D0>(od, vb, pa[0], pa[1], pa[2], pa[3]); att::pv_one<D0>(od, vb + 16384, pa[4], pa[5], pa[6], pa[7]);
}
__device__ __forceinline__ void phase_ret_pass2(const Ctx& X, int l) {
    int tid = threadIdx.x; asm volatile("" : "+v"(tid)); const int lane = tid & 63, w = __builtin_amdgcn_readfirstlane(tid >> 6), r32 = lane & 31, hi = lane >> 5;
    char* KL = (char*)X.lds; char* VL = KL + 32768; char* SF = KL + 65536; char* SB = KL + 98304; float* ST = (float*)(X.lds + XCH_OFF);
    const bf16_t* Qb = (const bf16_t*)(X.ws + WS_Q); const bf16_t* Kb = (const bf16_t*)(X.ws + WS_K); const bf16_t* Vb = (const bf16_t*)(X.ws + WS_V); const bf16_t* Gb = (const bf16_t*)(X.ws + WS_G);
    const bf16_t* SR = (const bf16_t*)(X.ws + WS_SRET); bf16_t* YB = (bf16_t*)(X.ws + WS_Y3) + 1024; const float* gain = X.in[25] + l * 1024;
    const int rq = w & 3, ch = w >> 2, vb = (int)(uintptr_t)VL + v_rd_base(lane);
#define RP2_DMA_A(U) do { const int u_ = (U), r0_ = (u_ >> 3) * 128, h_ = u_ & 7; const bf16_t* kb_ = Kb + (size_t)r0_ * 1024 + h_ * 128; const bf16_t* vb_ = Vb + (size_t)r0_ * 1024 + h_ * 128; \
        _Pragma("unroll") for (int i = 0; i < 4; ++i) { const int off = (w + 8 * i) * 1024 + ln * 16, row = off >> 8, cB = (off & 255) ^ ((row & 7) << 4); \
            __builtin_amdgcn_global_load_lds((const unsigned*)(kb_ + row * 1024 + (cB >> 1)), (LAS unsigned*)(KL + (w + 8 * i) * 1024), 16, 0, 0); } \
        _Pragma("unroll") for (int i = 0; i < 4; ++i) { const int off = (w + 8 * i) * 1024 + ln * 16, t_ = off >> 14, o2 = off & 16383, st = o2 >> 9, rem = o2 & 511, kk = (st >> 2) * 8 + (rem >> 6), cc = (st & 3) * 32 + ((rem & 63) >> 1); \
            const int k_ = ((kk & ~0xC) | ((kk & 4) << 1) | ((kk & 8) >> 1)) + 64 * t_; \
            __builtin_amdgcn_global_load_lds((const unsigned*)(vb_ + k_ * 1024 + cc), (LAS unsigned*)(VL + (w + 8 * i) * 1024), 16, 0, 0); } } while (0)
#define RP2_DMA_B(U) do { const bf16_t* sf_ = SR + (size_t)((U) * 2) * 16384; \
        _Pragma("unroll") for (int i = 0; i < 4; ++i) { const int off = (w + 8 * i) * 1024 + ln * 16, row = off >> 8, cB = (off & 255) ^ ((row & 7) << 4); \
            __builtin_amdgcn_global_load_lds((const unsigned*)(sf_ + row * 128 + (cB >> 1)), (LAS unsigned*)(SF + (w + 8 * i) * 1024), 16, 0, 0); \
            __builtin_amdgcn_global_load_lds((const unsigned*)(sf_ + 16384 + row * 128 + (cB >> 1)), (LAS unsigned*)(SB + (w + 8 * i) * 1024), 16, 0, 0); } } while (0)
    { int ln = lane; asm volatile("" : "+v"(ln)); if (X.bid < 1024) RP2_DMA_A(X.bid); }
    bf16x8 qr[8];
#define RP2_LDQ(U) do { const int u_ = (U); const bf16_t* Qw = Qb + (size_t)((u_ >> 3) * 128 + 32 * rq + r32) * 1024 + (u_ & 7) * 128 + hi * 8; \
        _Pragma("unroll") for (int d0 = 0; d0 < 8; ++d0) qr[d0] = *(const bf16x8*)(Qw + d0 * 16); } while (0)
    if (X.bid < 1024) RP2_LDQ(X.bid);
    asm volatile("s_waitcnt vmcnt(0)" ::: "memory"); __syncthreads();
    for (int u = X.bid; u < 1024; u += X.G) {
        const int ci = u >> 3, h = u & 7, r0 = ci * 128;
        const float lgf = ret_lg(X, l, 0, h), lgb = ret_lg(X, l, 1, h);
        int ln = lane; asm volatile("" : "+v"(ln));
        RP2_DMA_B(u);
        unsigned gq[16][2];
#pragma unroll
        for (int r = 0; r < 16; ++r)
#pragma unroll
            for (int dd = 0; dd < 2; ++dd) gq[r][dd] = Gb[(size_t)(r0 + 32 * rq + crow(r, hi)) * 1024 + h * 128 + 32 * (2 * ch + dd) + r32];
        __builtin_amdgcn_sched_barrier(0);
        bf16x8 pa[8];
        { int i = 32 * rq + r32, hq = hi; asm volatile("" : "+v"(i), "+v"(hq));
#pragma unroll
          for (int kb = 0; kb < 4; ++kb) { f32x16 p = {};
#pragma unroll
            for (int d0 = 0; d0 < 8; ++d0) { const bf16x8 kf = *(const bf16x8*)(KL + KS256(32 * kb + r32, (d0 * 16 + hi * 8) * 2)); p = __builtin_amdgcn_mfma_f32_32x32x16_bf16(kf, qr[d0], p, 0, 0, 0); }
#pragma unroll
            for (int r = 0; r < 16; ++r) { const int dl = i - (32 * kb + crow(r, hq)); const float ex = __builtin_amdgcn_exp2f(dl >= 0 ? lgf * (float)dl : -lgb * (float)dl); p[r] *= (dl == 0 ? 2.f * RET_SC : RET_SC) * ex; }
#define RPK4(P, BASE, OUT) do { unsigned a0 = cvt_pk_bf16(P[BASE + 0], P[BASE + 1]), a1 = cvt_pk_bf16(P[BASE + 2], P[BASE + 3]), b0 = cvt_pk_bf16(P[BASE + 4], P[BASE + 5]), b1 = cvt_pk_bf16(P[BASE + 6], P[BASE + 7]); \
            auto x0 = __builtin_amdgcn_permlane32_swap(a0, b0, false, false); auto x1 = __builtin_amdgcn_permlane32_swap(a1, b1, false, false); u32x4 wv = {x0[0], x1[0], x0[1], x1[1]}; OUT = __builtin_bit_cast(bf16x8, wv); } while (0)
            RPK4(p, 0, pa[2 * kb]); RPK4(p, 8, pa[2 * kb + 1]);
            asm volatile("" ::: "memory"); __builtin_amdgcn_sched_barrier(0);
#undef RPK4
          } }
        f32x16 o[2] = {};
        if (ch == 0) { pv128<0>(o[0], vb, pa); pv128<1>(o[1], vb, pa); } else { pv128<2>(o[0], vb, pa); pv128<3>(o[1], vb, pa); }
        asm volatile("s_waitcnt vmcnt(0)" ::: "memory"); __syncthreads();
        if (u + X.G < 1024) RP2_DMA_A(u + X.G);
        { const int i = 32 * rq + r32; const float scf = exp2f(lgf * (float)(i + 1)), scb = exp2f(lgb * (float)(128 - i));
#pragma unroll
          for (int ks = 0; ks < 8; ++ks) { const bf16x8 qf = scale_frag(qr[ks], scf), qb = scale_frag(qr[ks], scb);
#pragma unroll
            for (int dd = 0; dd < 2; ++dd) { const int row = 32 * (2 * ch + dd) + r32, cb = (ks * 16 + hi * 8) * 2;
                const bf16x8 sfv = *(const bf16x8*)(SF + KS256(row, cb)), sbv = *(const bf16x8*)(SB + KS256(row, cb));
                o[dd] = __builtin_amdgcn_mfma_f32_32x32x16_bf16(qf, sfv, o[dd], 0, 0, 0); o[dd] = __builtin_amdgcn_mfma_f32_32x32x16_bf16(qb, sbv, o[dd], 0, 0, 0); }
            asm volatile("" ::: "memory"); __builtin_amdgcn_sched_barrier(0); } }
        if (u + X.G < 1024) RP2_LDQ(u + X.G);
        __builtin_amdgcn_sched_barrier(0);
        float s1[16], s2[16];
#pragma unroll
        for (int r = 0; r < 16; ++r) { float a = o[0][r] + o[1][r], b = o[0][r] * o[0][r] + o[1][r] * o[1][r];
#pragma unroll
            for (int m = 1; m < 32; m <<= 1) { a += __shfl_xor(a, m); b += __shfl_xor(b, m); }
            s1[r] = a; s2[r] = b; }
        if (r32 == 0) {
#pragma unroll
            for (int r = 0; r < 16; ++r) { ST[(w * 32 + crow(r, hi)) * 2] = s1[r]; ST[(w * 32 + crow(r, hi)) * 2 + 1] = s2[r]; } }
        __syncthreads();
#pragma unroll
        for (int r = 0; r < 16; ++r) { const int row = crow(r, hi); const float a = s1[r] + ST[((w ^ 4) * 32 + row) * 2], b = s2[r] + ST[((w ^ 4) * 32 + row) * 2 + 1];
            const float mu = a * (1.f / 128.f), var = b * (1.f / 128.f) - mu * mu, rstd = rsqrtf(fmaxf(var, 0.f) + EPS);
            const size_t ro = (size_t)(r0 + 32 * rq + row) * 1024 + h * 128;
#pragma unroll
            for (int dd = 0; dd < 2; ++dd) { const int c = 32 * (2 * ch + dd) + r32; const float gv = __uint_as_float(gq[r][dd] << 16);
                YB[(size_t)(r0 + 32 * rq + row) * LDY3 + h * 128 + c] = f2bf(gv * sigm(gv) * ((o[dd][r] - mu) * rstd) * gain[h * 128 + c]); } }
        asm volatile("s_waitcnt vmcnt(32)" ::: "memory"); __syncthreads();
    }
#undef RP2_DMA_A
#undef RP2_DMA_B
#undef RP2_LDQ
}
}

#ifndef GA
#define GA true
#endif
#ifndef GS
#define GS true
#endif
#ifndef MK_PER_PHASE
#define MK_PER_PHASE 0
#endif
constexpr int NPH = 14, NPHASES = 2 * NPH;
struct Args { const float* in[37]; float* out; unsigned char* ws; int ph_lo, ph_hi, li, pad; };
template <int l> __device__ __forceinline__ void run_layer(const Args& args, unsigned char* lds, const XcdBarrier& bar, const int lo, const int hi, PG8_LAS unsigned char* ring) {
#define PHASE_CTX Ctx X; { unsigned char* w_ = args.ws; float* o_ = args.out; const float* const* i_ = args.in; w_ = (unsigned char*)opaque_uniform(w_); o_ = (float*)opaque_uniform(o_); \
        X.ws = w_; X.out = o_; X.in = i_; X.lds = lds; X.G = gridDim.x; X.bid = blockIdx.x; } unsigned char* ws = X.ws; const int G = X.G, bid = X.bid; (void)ws; (void)G; (void)bid;
        const int pb = l * NPH;
#ifndef SUBMASK
#define SUBMASK 0xFF
#endif
#define SUB(j) (((SUBMASK) >> (j)) & 1)
#ifndef PHMASK
#define PHMASK 0xFFFF
#endif
#define IN(k) ((((PHMASK) >> (k)) & 1) && lo <= pb + (k) && pb + (k) < hi)
#ifndef PROBE_MASK
#define PROBE_MASK 0
#endif
#define REP(id) for (int rep_ = 0; rep_ < ((((PROBE_MASK) >> (id)) & 1) ? 2 : 1); ++rep_)
#define SEAM(k) do { if (pb + (k) + 1 < hi) xcd_barrier(bar); } while (0)
        if (l == 0 && IN(0)) { PHASE_CTX  phase_pre(X, 0); SEAM(0); }
        if (l == 0 && IN(1)) { PHASE_CTX  phase_norm<0>(X, 0, nullptr); SEAM(1); }
        if (IN(2)) { PHASE_CTX
            Gemm g{(const bf16_t*)(ws + WS_H), (const bf16_t*)(ws + WS_WIN), 2048, 2048, 2048}; StaticOrder S; S.init(M, NP2 + 512, G, bid);
            EpiP2 E{(bf16_t*)(ws + WS_UG), (bf16_t*)(ws + WS_Q), (bf16_t*)(ws + WS_K), (bf16_t*)(ws + WS_V), (bf16_t*)(ws + WS_G), (bf16_t*)(ws + WS_CQ), (bf16_t*)(ws + WS_CKV), (bf16_t*)(ws + WS_KR), (bf16_t*)(ws + WS_G2)};
            REP(2) gemm_phase<EpiP2, StaticOrder, GA, GS>(ring, g, S, E); SEAM(2); }
        if (IN(3)) { PHASE_CTX
            { Gemm g{(const bf16_t*)(ws + WS_UG), (const bf16_t*)(ws + WS_BTE), 768, 512, 512}; OrderS5E S{G, bid}; EpiS5E E{(float*)(ws + WS_ELOC)};
              REP(3) gemm_phase<EpiS5E, OrderS5E, GA, GS>(ring, g, S, E); }
            __syncthreads();
            REP(4) ret::phase_ret_pass1(X, l);
            phase_mla_norm(X, l); SEAM(3); }
        if (IN(4)) { PHASE_CTX
            { Gemm g{(const bf16_t*)(ws + WS_CQ), (const bf16_t*)(ws + WS_WUQ), 768, 768, 768}; StaticOrder S; S.init(M, 1536, G, bid); EpiBf16Plain E{(bf16_t*)(ws + WS_QMLA), 1536};
              REP(5) gemm_phase<EpiBf16Plain, StaticOrder, GA, GS>(ring, g, S, E); }
            { Gemm g{(const bf16_t*)(ws + WS_CKV), (const bf16_t*)(ws + WS_WKV), 512, 512, 512}; StaticOrder S; S.init(MK, 2048, G, (bid + G / 2) % G); EpiBf16Plain E{(bf16_t*)(ws + WS_KVMLA), 2048};
              REP(5) gemm_phase<EpiBf16Plain, StaticOrder, GA, GS>(ring, g, S, E); }
            REP(6) phase_s5_carry(X, l);
            REP(7) phase_ret_prefix(X, l); SEAM(4); }
        if (IN(5)) { PHASE_CTX
            { Gemm g{(const bf16_t*)(ws + WS_UG), (const bf16_t*)(ws + WS_BTY), 768, 768, 768}; OrderS5Y S{G, bid}; EpiS5Y E{(const bf16_t*)(ws + WS_UG), X.in[21] + l * 1024, (bf16_t*)(ws + WS_YAP)};
              REP(8) gemm_phase<EpiS5Y, OrderS5Y, GA, GS>(ring, g, S, E); }
            __syncthreads();
            REP(9) att::phase_attn(X);
            REP(10) ret::phase_ret_pass2(X, l); SEAM(5); }
        if (IN(6)) { PHASE_CTX
            const bool up = bid >= G / 2;
            Gemm gg{(const bf16_t*)(ws + WS_YAP), (const bf16_t*)(ws + WS_WGLU), 1024, 1024, 1024}; StaticOrder SG; SG.init(M, 1024, G - G / 2, up ? bid - G / 2 : 0);
            EpiGlu EG{(const bf16_t*)(ws + WS_YAP), X.in[23] + l * 1024, (bf16_t*)(ws + WS_Y3), LDY3};
            if (up) { OrderSlice S0{SG, 0, 1}; gemm_phase<EpiGlu, OrderSlice, GA, GS>(ring, gg, S0, EG); }
            { Gemm g{(const bf16_t*)(ws + WS_H), (const bf16_t*)(ws + WS_WIN) + (size_t)(NP2 + 512) * 2048, 2048, 2048, 2048}; StaticOrder S; S.init(M, NGATE - 512, G, bid); EpiBf16Plain E{(bf16_t*)(ws + WS_GATES) + 512, NGATE};
              gemm_phase<EpiBf16Plain, StaticOrder, GA, GS>(ring, g, S, E); }
            if (up) { OrderSlice S1{SG, 1, 1}; gemm_phase<EpiGlu, OrderSlice, GA, GS>(ring, gg, S1, EG); }
            SEAM(6); }
        if (IN(7)) { PHASE_CTX
            Gemm g{(const bf16_t*)(ws + WS_Y3), (const bf16_t*)(ws + WS_WBR), LDY3, 3072, 3072}; StaticOrder S; S.init(M, 2048, G, bid);
            EpiBranch3 E{(const bf16_t*)(ws + WS_GATES), (const bf16_t*)(ws + WS_G2), (bf16_t*)(ws + WS_MERGED)};
            REP(13) gemm_phase<EpiBranch3, StaticOrder, GA, GS>(ring, g, S, E); SEAM(7); }
        if (IN(8)) { PHASE_CTX
            Gemm g{(const bf16_t*)(ws + WS_MERGED), (const bf16_t*)(ws + WS_WOUT), 2048, 2048, 2048}; StaticOrder S; S.init(M, 2048, G, bid); EpiBf16Plain E{(bf16_t*)(ws + WS_MO), 2048};
            REP(14) gemm_phase<EpiBf16Plain, StaticOrder, GA, GS>(ring, g, S, E); SEAM(8); }
        if (IN(9)) { PHASE_CTX  phase_norm<1>(X, l, (const bf16_t*)(ws + WS_MO)); SEAM(9); }
        if (IN(10)) { PHASE_CTX
            Gemm g{(const bf16_t*)(ws + WS_H), (const bf16_t*)(ws + WS_WUP), 2048, 2048, 2048}; StaticOrder S; S.init(M, DFF2, G, bid); EpiUpConv E{X.in[34] + (size_t)l * 3 * DFF2, X.in[35] + (size_t)l * DFF2, (bf16_t*)(ws + WS_AF), (float*)(ws + WS_HALO), (PG8_LAS float*)(ring + XCH_OFF)};
            REP(15) gemm_phase<EpiUpConv, StaticOrder, true, true>(ring, g, S, E); SEAM(10); }
        if (IN(11)) { PHASE_CTX  phase_convfix(X, l); SEAM(11); }
        if (IN(12)) { PHASE_CTX
            Gemm g{(const bf16_t*)(ws + WS_AF), (const bf16_t*)(ws + WS_WDN), DFF, DFF, DFF}; StaticOrder S; S.init(M, 2048, G, bid); EpiBf16Plain E{(bf16_t*)(ws + WS_DN), 2048};
            REP(17) gemm_phase<EpiBf16Plain, StaticOrder, GA, GS>(ring, g, S, E); SEAM(12); }
        if (IN(13)) { PHASE_CTX  phase_norm<2>(X, l, (const bf16_t*)(ws + WS_DN)); if (l == 0) phase_pre(X, 1); if (l == 0 && pb + 16 < hi) xcd_barrier(bar); }
#undef IN
#undef SEAM
#undef PHASE_CTX
}
__global__ void __launch_bounds__(512, 2) mk_fwd(Args args) {
    extern __shared__ __attribute__((aligned(16))) unsigned char lds[];
    volatile LAS unsigned* MISC = (volatile LAS unsigned*)((LAS unsigned char*)lds + MISC_OFF);
    if (threadIdx.x < 32) MISC[threadIdx.x] = 0u;
    __syncthreads();
    XcdBarrier bar = xcd_barrier_post((unsigned*)(args.ws + WS_CTL) + CW_BAR + args.li * XCD_BAR_WORDS, MISC + 8);
    const int lo = args.ph_lo, hi = args.ph_hi;
    PG8_LAS unsigned char* ring = (PG8_LAS unsigned char*)lds;
    run_layer<0>(args, lds, bar, lo, hi, ring);
    run_layer<1>(args, lds, bar, lo, hi, ring);
}

extern "C" void kernel_launch(void* const* d_in, const int* in_sizes, int n_in, void* d_out, int out_size, void* d_ws, size_t ws_size, hipStream_t stream) {
    static int grid = 0;
    if (grid == 0) {
        if (n_in != 37 || (size_t)out_size != O_END || ws_size < WS_END) { fprintf(stderr, "kernel_launch: unexpected shapes: n_in %d out %d ws %zu (need %zu)\n", n_in, out_size, ws_size, (size_t)WS_END); grid = -1; return; }
        int dev = 0, cus = 0;
        if (hipGetDevice(&dev) != hipSuccess || hipDeviceGetAttribute(&cus, hipDeviceAttributeMultiprocessorCount, dev) != hipSuccess) { grid = -1; return; }
        if (hipFuncSetAttribute((const void*)mk_fwd, hipFuncAttributeMaxDynamicSharedMemorySize, LDS_BYTES) != hipSuccess) { fprintf(stderr, "kernel_launch: hipFuncSetAttribute failed\n"); grid = -1; return; }
        int per_cu = 0;
        if (hipOccupancyMaxActiveBlocksPerMultiprocessor(&per_cu, (const void*)mk_fwd, 512, LDS_BYTES) != hipSuccess || per_cu < 1) fprintf(stderr, "kernel_launch: occupancy query reports %d\n", per_cu);
        (void)hipGetLastError();
        grid = cus;
    }
    if (grid < 0) return;
    (void)hipMemsetAsync((char*)d_ws + WS_CTL, 0, MK_PER_PHASE ? 1 * MiB : 32 * 1024, stream);
    Args a{};
    for (int i = 0; i < 37; ++i) a.in[i] = (const float*)d_in[i];
    a.out = (float*)d_out; a.ws = (unsigned char*)d_ws; a.pad = 0;
#if MK_PER_PHASE
    for (int p = 0; p < NPHASES; ++p) { a.ph_lo = p; a.ph_hi = p + 1; a.li = p; hipLaunchKernelGGL(mk_fwd, dim3(grid), dim3(512), LDS_BYTES, stream, a); }
#else
    a.ph_lo = 0; a.ph_hi = NPHASES; a.li = 0; hipLaunchKernelGGL(mk_fwd, dim3(grid), dim3(512), LDS_BYTES, stream, a);
#endif
    const hipError_t le = hipPeekAtLastError();
    if (le != hipSuccess) fprintf(stderr, "kernel_launch: launch failed: %s\n", hipGetErrorName(le));
}
```
